# Optimizing an MI355X kernel written in HIP

```python
import math
import jax, jax.numpy as jnp
from jax import lax
import numpy as np

D_MODEL = 2048
BATCH = 4
SEQ = 2048
DEPTH = 1
DEC_BATCH = 128
DEC_SEQ = 1
PAST_LEN = 16384
PAGE_SIZE = 128

W_LRU = D_MODEL // 2
LRU_HEADS = 8
LRU_HEAD_DIM = W_LRU // LRU_HEADS
CONV_W = 4
LRU_C = 8.0
W_SSM = D_MODEL // 2
SSM_GROUP = 16
SSM_GROUPS = W_SSM // SSM_GROUP
SSM_STATE = 64
D_FF = 4 * D_MODEL
N_MOD = 6
EPS = 1e-6

kernel_name = "hawk_s5_gated_hybrid_step"

F32 = jnp.float32


def rmsnorm(x, g):
    xf = x.astype(F32)
    y = xf * lax.rsqrt(jnp.mean(xf * xf, axis=-1, keepdims=True) + EPS)
    return (y * g.astype(F32)).astype(x.dtype)


def causal_conv(u, buf, w, b):
    L = u.shape[1]
    up = jnp.concatenate([buf.astype(u.dtype), u], axis=1)
    out = b + up[:, 0:L] * w[0]
    for k in range(1, CONV_W):
        out = out + up[:, k:k + L] * w[k]
    return out, up[:, -(CONV_W - 1):]


def _lin_combine(e1, e2):
    a1, b1 = e1
    a2, b2 = e2
    return a2 * a1, a2 * b1 + b2


def _cplx_combine(e1, e2):
    a1r, a1i, b1r, b1i = e1
    a2r, a2i, b2r, b2i = e2
    return (a2r * a1r - a2i * a1i,
            a2r * a1i + a2i * a1r,
            a2r * b1r - a2i * b1i + b2r,
            a2r * b1i + a2i * b1r + b2i)


def rg_lru(u, h0, w_a, b_a, w_x, b_x, lam):
    B, L, W = u.shape
    uf = u.astype(F32)
    uh = uf.reshape(B, L, LRU_HEADS, LRU_HEAD_DIM)
    r = jax.nn.sigmoid(jnp.einsum('blhi,hij->blhj', uh, w_a.astype(F32)).reshape(B, L, W) + b_a.astype(F32))
    i = jax.nn.sigmoid(jnp.einsum('blhi,hij->blhj', uh, w_x.astype(F32)).reshape(B, L, W) + b_x.astype(F32))
    log_a = -LRU_C * r * jax.nn.softplus(-lam.astype(F32))
    a = jnp.exp(log_a)
    mult = jnp.sqrt(-jnp.expm1(2.0 * log_a))
    bx = mult * i * uf
    a_cum, h = lax.associative_scan(_lin_combine, (a, bx), axis=1)
    h = h + a_cum * h0.astype(F32)[:, None]
    return h, h[:, -1]


def s5(u, h0_re, h0_im, a_re, a_im, log_dt, b_re, b_im, c_re, c_im, d):
    Bsz, L, _ = u.shape
    uf = u.astype(F32).reshape(Bsz, L, SSM_GROUPS, SSM_GROUP)
    ar, ai = a_re.astype(F32), a_im.astype(F32)
    dt = jnp.exp(log_dt.astype(F32))[:, None]
    mag = jnp.exp(dt * ar)
    ang = dt * ai
    abar_re, abar_im = mag * jnp.cos(ang), mag * jnp.sin(ang)
    den = ar * ar + ai * ai
    nr, ni = abar_re - 1.0, abar_im
    q_re = (nr * ar + ni * ai) / den
    q_im = (ni * ar - nr * ai) / den
    br, bi = b_re.astype(F32), b_im.astype(F32)
    bb_re = q_re[..., None] * br - q_im[..., None] * bi
    bb_im = q_re[..., None] * bi + q_im[..., None] * br
    bu_re = jnp.einsum('gpk,blgk->blgp', bb_re, uf)
    bu_im = jnp.einsum('gpk,blgk->blgp', bb_im, uf)
    shp = bu_re.shape
    a_r = jnp.broadcast_to(abar_re, shp)
    a_i = jnp.broadcast_to(abar_im, shp)
    cr, ci, hr, hi = lax.associative_scan(_cplx_combine, (a_r, a_i, bu_re, bu_im), axis=1)
    h0r = h0_re.astype(F32)[:, None]
    h0i = h0_im.astype(F32)[:, None]
    h_re = hr + cr * h0r - ci * h0i
    h_im = hi + cr * h0i + ci * h0r
    y = (jnp.einsum('gkp,blgp->blgk', c_re.astype(F32), h_re)
         - jnp.einsum('gkp,blgp->blgk', c_im.astype(F32), h_im))
    y = y.reshape(Bsz, L, W_SSM) + d.astype(F32) * u.astype(F32)
    return y, h_re[:, -1], h_im[:, -1]


def block(x, c, conv_buf, h_lru, h_re, h_im,
          w_ada, b_ada, g1, g2, w_in, conv_w, conv_b,
          w_rg_a, b_rg_a, w_rg_x, b_rg_x, lru_lambda, w_proj_a,
          a_re, a_im, log_dt, b_re, b_im, c_re, c_im, ssm_d, w_glu,
          w_out, w_up, w_down):
    mod = jax.nn.silu(c) @ w_ada + b_ada
    sh1, sc1, gt1, sh2, sc2, gt2 = jnp.split(mod[:, None, :], N_MOD, axis=-1)
    h = rmsnorm(x, g1) * (1.0 + sc1) + sh1
    proj = h @ w_in
    u_a, u_b, z_a, z_b = jnp.split(proj, [W_LRU, W_LRU + W_SSM, W_LRU + W_SSM + D_MODEL], axis=-1)
    u_conv, new_conv = causal_conv(u_a, conv_buf, conv_w, conv_b)
    h_seq, new_lru = rg_lru(u_conv, h_lru, w_rg_a, b_rg_a, w_rg_x, b_rg_x, lru_lambda)
    y_a = h_seq.astype(x.dtype) @ w_proj_a
    y_s, new_re, new_im = s5(u_b, h_re, h_im, a_re, a_im, log_dt, b_re, b_im, c_re, c_im, ssm_d)
    glu = jax.nn.gelu(y_s).astype(x.dtype) @ w_glu
    y_b = glu[..., :D_MODEL] * jax.nn.sigmoid(glu[..., D_MODEL:])
    merged = jax.nn.sigmoid(z_a) * y_a + jax.nn.sigmoid(z_b) * y_b
    x = x + gt1 * (merged @ w_out)
    h2 = rmsnorm(x, g2) * (1.0 + sc2) + sh2
    x = x + gt2 * (jnp.square(jax.nn.relu(h2 @ w_up)) @ w_down)
    return x, new_conv, new_lru, new_re, new_im


def setup_inputs(seed: int = 0) -> dict:
    key = jax.random.key(seed)
    ks = iter(jax.random.split(key, 40))
    nrm = lambda shape, s: jax.random.normal(next(ks), shape, F32) * s
    Lr = DEPTH
    n = jnp.arange(SSM_STATE, dtype=F32)
    a_pow = jax.random.uniform(next(ks), (Lr, W_LRU), F32, 0.9, 0.999)
    s = a_pow ** (1.0 / LRU_C)
    lru_lambda = jnp.log(s) - jnp.log1p(-s)
    log_dt = jax.random.uniform(next(ks), (Lr, SSM_GROUPS), F32, math.log(1e-3), math.log(1e-1))
    return {
        "x_prompt": nrm((BATCH, SEQ, D_MODEL), 1.0),
        "x_sample": nrm((DEC_BATCH, DEC_SEQ, D_MODEL), 1.0),
        "state_conv": nrm((Lr, DEC_BATCH, CONV_W - 1, W_LRU), 1.0),
        "state_lru": nrm((Lr, DEC_BATCH, W_LRU), 0.5),
        "state_ssm_re": nrm((Lr, DEC_BATCH, SSM_GROUPS, SSM_STATE), 0.5),
        "state_ssm_im": nrm((Lr, DEC_BATCH, SSM_GROUPS, SSM_STATE), 0.5),
        "c_prompt": nrm((BATCH, D_MODEL), 1.0),
        "c_sample": nrm((DEC_BATCH, D_MODEL), 1.0),
        "w_ada": nrm((Lr, D_MODEL, N_MOD * D_MODEL), D_MODEL ** -0.5),
        "b_ada": nrm((Lr, N_MOD * D_MODEL), 0.01),
        "g_norm1": 1.0 + nrm((Lr, D_MODEL), 0.01),
        "g_norm2": 1.0 + nrm((Lr, D_MODEL), 0.01),
        "w_in": nrm((Lr, D_MODEL, W_LRU + W_SSM + 2 * D_MODEL), D_MODEL ** -0.5),
        "conv_w": nrm((Lr, CONV_W, W_LRU), CONV_W ** -0.5),
        "conv_b": nrm((Lr, W_LRU), 0.01),
        "w_rg_a": nrm((Lr, LRU_HEADS, LRU_HEAD_DIM, LRU_HEAD_DIM), LRU_HEAD_DIM ** -0.5),
        "b_rg_a": nrm((Lr, W_LRU), 0.1),
        "w_rg_x": nrm((Lr, LRU_HEADS, LRU_HEAD_DIM, LRU_HEAD_DIM), LRU_HEAD_DIM ** -0.5),
        "b_rg_x": nrm((Lr, W_LRU), 0.1),
        "lru_lambda": lru_lambda,
        "w_proj_a": nrm((Lr, W_LRU, D_MODEL), W_LRU ** -0.5),
        "ssm_a_re": -0.5 + nrm((Lr, SSM_GROUPS, SSM_STATE), 0.01),
        "ssm_a_im": math.pi * n + nrm((Lr, SSM_GROUPS, SSM_STATE), 0.01),
        "ssm_log_dt": log_dt,
        "ssm_b_re": nrm((Lr, SSM_GROUPS, SSM_STATE, SSM_GROUP), (2 * SSM_GROUP) ** -0.5),
        "ssm_b_im": nrm((Lr, SSM_GROUPS, SSM_STATE, SSM_GROUP), (2 * SSM_GROUP) ** -0.5),
        "ssm_c_re": nrm((Lr, SSM_GROUPS, SSM_GROUP, SSM_STATE), (2 * SSM_STATE) ** -0.5),
        "ssm_c_im": nrm((Lr, SSM_GROUPS, SSM_GROUP, SSM_STATE), (2 * SSM_STATE) ** -0.5),
        "ssm_d": nrm((Lr, W_SSM), 1.0),
        "w_glu": nrm((Lr, W_SSM, 2 * D_MODEL), W_SSM ** -0.5),
        "w_out": nrm((Lr, D_MODEL, D_MODEL), D_MODEL ** -0.5),
        "w_up": nrm((Lr, D_MODEL, D_FF), D_MODEL ** -0.5),
        "w_down": nrm((Lr, D_FF, D_MODEL), D_FF ** -0.5),
        "g_final": 1.0 + nrm((D_MODEL,), 0.01),
    }


def reference(x_prompt, x_sample, state_conv, state_lru, state_ssm_re, state_ssm_im,
              c_prompt, c_sample, w_ada, b_ada, g_norm1, g_norm2, w_in, conv_w, conv_b,
              w_rg_a, b_rg_a, w_rg_x, b_rg_x, lru_lambda, w_proj_a,
              ssm_a_re, ssm_a_im, ssm_log_dt, ssm_b_re, ssm_b_im, ssm_c_re, ssm_c_im, ssm_d,
              w_glu, w_out, w_up, w_down, g_final):
    nb = x_prompt.shape[0]
    xp, xs = x_prompt, x_sample
    pc, pl, pr, pi_ = [], [], [], []
    sc, sl, sr, si = [], [], [], []
    for l in range(DEPTH):
        w = (w_ada[l], b_ada[l], g_norm1[l], g_norm2[l], w_in[l], conv_w[l], conv_b[l],
             w_rg_a[l], b_rg_a[l], w_rg_x[l], b_rg_x[l], lru_lambda[l], w_proj_a[l],
             ssm_a_re[l], ssm_a_im[l], ssm_log_dt[l], ssm_b_re[l], ssm_b_im[l],
             ssm_c_re[l], ssm_c_im[l], ssm_d[l], w_glu[l], w_out[l], w_up[l], w_down[l])
        z_conv = jnp.zeros((nb, CONV_W - 1, W_LRU), xp.dtype)
        z_lru = jnp.zeros((nb, W_LRU), F32)
        z_ssm = jnp.zeros((nb, SSM_GROUPS, SSM_STATE), F32)
        xp, c1, l1, r1, i1 = block(xp, c_prompt, z_conv, z_lru, z_ssm, z_ssm, *w)
        xs, c2, l2, r2, i2 = block(xs, c_sample, state_conv[l], state_lru[l],
                                   state_ssm_re[l], state_ssm_im[l], *w)
        pc.append(c1); pl.append(l1); pr.append(r1); pi_.append(i1)
        sc.append(c2); sl.append(l2); sr.append(r2); si.append(i2)
    y_prompt = rmsnorm(xp, g_final)
    y_sample = rmsnorm(xs, g_final)
    return (y_prompt, y_sample,
            jnp.stack(pc), jnp.stack(pl), jnp.stack(pr), jnp.stack(pi_),
            jnp.stack(sc), jnp.stack(sl), jnp.stack(sr), jnp.stack(si))
```

```cpp
#include <hip/hip_runtime.h>
#include <cstdio>
#include <cstdint>
namespace pg8 {
#define PG8_LAS __attribute__((address_space(3)))
typedef unsigned short bf16_t;
typedef short bf16x8 __attribute__((ext_vector_type(8)));
typedef float f32x4 __attribute__((ext_vector_type(4)));
typedef unsigned u32x4 __attribute__((ext_vector_type(4)));
constexpr int BM = 256, BK = 64, HALF = 128, HTB = HALF * BK * 2  , STAGE_BYTES = 8 * HTB, NXCD = 8, WGM = 8;

__host__ __device__ __forceinline__ int lds_byte(int r, int c) { const int st = (r >> 4) * 2 + (c >> 5), rr = r & 15, cc = c & 31, ob = rr * 64 + cc * 2; return st * 1024 + (ob ^ (((ob >> 9) & 1) << 5)); }
__host__ __device__ __forceinline__ void stage_rc(int b, int& R, int& C) { const int st = b / 1024, sb = b % 1024, swz = sb ^ (((sb >> 9) & 1) << 5); R = (st >> 1) * 16 + swz / 64; C = (st & 1) * 32 + (swz % 64) / 2; }
__host__ __device__ __forceinline__ int perm32(int rho) { const int n = rho >> 4, i = rho & 15; return 8 * (i >> 2) + 4 * n + (i & 3); }

struct Unit { int pm, pn; };
struct Gemm { const bf16_t* A; const bf16_t* Bt; int M, N, K; };

struct StaticOrder {
    int nM, nN, nwg, G, c;
    __host__ __device__ void init(int M, int N, int G_, int c_) { nM = M / BM; nN = N / BM; nwg = nM * nN; G = G_; c = c_; }
    __host__ __device__ bool next(int i, Unit& u) const {
        const long L = (long)i * G + c; if (L >= nwg) return false;
        int wgid = (int)L; { const int q = nwg / NXCD, r = nwg % NXCD, xcd = wgid % NXCD, off = wgid / NXCD; wgid = (xcd < r ? xcd * (q + 1) : r * (q + 1) + (xcd - r) * q) + off; }
        const int nig = WGM * nN, gid = wgid / nig, fm = gid * WGM, gsz = (nM - fm) < WGM ? (nM - fm) : WGM;
        u.pm = fm + ((wgid % nig) % gsz); u.pn = (wgid % nig) / gsz; return true;
    }
    __device__ __forceinline__ void a_ready(const Unit&) const {}
    __device__ __forceinline__ void done(const Unit&) const {}
};

__device__ __forceinline__ unsigned cvt_pk_bf16(float lo, float hi) { unsigned r; asm volatile("v_cvt_pk_bf16_f32 %0, %1, %2" : "=v"(r) : "v"(lo), "v"(hi)); return r; }
constexpr int D_MODEL = 2048, MP = 8192  , MS = 128  , MR = MP + MS  , MODN = 6 * D_MODEL, NPROJ = 6144, D_FF = 8192;
__device__ __forceinline__ float bflo(unsigned w) { return __uint_as_float(w << 16); }
__device__ __forceinline__ float bfhi(unsigned w) { return __uint_as_float(w & 0xffff0000u); }
__device__ __forceinline__ float sigm(float x) { return __builtin_amdgcn_rcpf(1.0f + __builtin_amdgcn_exp2f(-1.44269504f * x)); }
__device__ __forceinline__ int mod_row(int row) { int r = row < MP ? (row >> 11) : (4 + row - MP); return r > 143 ? 143 : r; }

struct EpiProj {
    static constexpr bool PERM = true, AFTER_DRAIN = false;
    bf16_t* O;
    __device__ __forceinline__ void operator()(const f32x4 (&acc)[2][2][4][2], const Unit& u, int wr, int wc, int fr, int fq) const {
        const int row0 = u.pm * BM + wr * 64 + fr, col0 = u.pn * BM + wc * 32 + 8 * fq; const bool sg = u.pn >= 8;
#pragma unroll
        for (int ai = 0; ai < 2; ++ai)
#pragma unroll
            for (int m = 0; m < 4; ++m) { bf16_t* rowp = O + (size_t)(row0 + ai * HALF + m * 16) * NPROJ + col0;
#pragma unroll
                for (int bj = 0; bj < 2; ++bj) { f32x4 v0 = acc[ai][bj][m][0], v1 = acc[ai][bj][m][1];
                    if (sg) {
#pragma unroll
                        for (int i = 0; i < 4; ++i) { v0[i] = sigm(v0[i]); v1[i] = sigm(v1[i]); } }
                    u32x4 w; w.x = cvt_pk_bf16(v0[0], v0[1]); w.y = cvt_pk_bf16(v0[2], v0[3]); w.z = cvt_pk_bf16(v1[0], v1[1]); w.w = cvt_pk_bf16(v1[2], v1[3]);
                    *(u32x4*)(rowp + bj * HALF) = w; } }
    }
};
struct EpiGateA {
    static constexpr bool PERM = true, AFTER_DRAIN = false;
    bf16_t* T; const bf16_t* P;
    __device__ __forceinline__ void operator()(const f32x4 (&acc)[2][2][4][2], const Unit& u, int wr, int wc, int fr, int fq) const {
        const int row0 = u.pm * BM + wr * 64 + fr, col0 = u.pn * BM + wc * 32 + 8 * fq;
#pragma unroll
        for (int ai = 0; ai < 2; ++ai)
#pragma unroll
            for (int m = 0; m < 4; ++m) { const size_t row = (size_t)(row0 + ai * HALF + m * 16);
#pragma unroll
                for (int bj = 0; bj < 2; ++bj) { const int col = col0 + bj * HALF;
                    const u32x4 g = *(const u32x4*)(P + row * NPROJ + 2048 + col);
                    f32x4 v0 = acc[ai][bj][m][0], v1 = acc[ai][bj][m][1];
                    v0[0] *= bflo(g.x); v0[1] *= bfhi(g.x); v0[2] *= bflo(g.y); v0[3] *= bfhi(g.y); v1[0] *= bflo(g.z); v1[1] *= bfhi(g.z); v1[2] *= bflo(g.w); v1[3] *= bfhi(g.w);
                    u32x4 w; w.x = cvt_pk_bf16(v0[0], v0[1]); w.y = cvt_pk_bf16(v0[2], v0[3]); w.z = cvt_pk_bf16(v1[0], v1[1]); w.w = cvt_pk_bf16(v1[2], v1[3]);
                    *(u32x4*)(T + row * D_MODEL + col) = w; } }
    }
};
struct EpiGlu {
    static constexpr bool PERM = true, AFTER_DRAIN = false;
    bf16_t* MG; const bf16_t* T; const bf16_t* P;
    __device__ __forceinline__ void operator()(const f32x4 (&acc)[2][2][4][2], const Unit& u, int wr, int wc, int fr, int fq) const {
        const int row0 = u.pm * BM + wr * 64 + fr, vcol = u.pn * HALF + wc * 32 + 8 * fq;
#pragma unroll
        for (int ai = 0; ai < 2; ++ai)
#pragma unroll
            for (int m = 0; m < 4; ++m) { const size_t row = (size_t)(row0 + ai * HALF + m * 16);
                const u32x4 t = *(const u32x4*)(T + row * D_MODEL + vcol);
                const u32x4 z = *(const u32x4*)(P + row * NPROJ + 4096 + vcol);
                const f32x4 a0 = acc[ai][0][m][0], a1 = acc[ai][0][m][1], g0 = acc[ai][1][m][0], g1 = acc[ai][1][m][1];
                float o[8];
                o[0] = bflo(t.x) + bflo(z.x) * (a0[0] * sigm(g0[0])); o[1] = bfhi(t.x) + bfhi(z.x) * (a0[1] * sigm(g0[1]));
                o[2] = bflo(t.y) + bflo(z.y) * (a0[2] * sigm(g0[2])); o[3] = bfhi(t.y) + bfhi(z.y) * (a0[3] * sigm(g0[3]));
                o[4] = bflo(t.z) + bflo(z.z) * (a1[0] * sigm(g1[0])); o[5] = bfhi(t.z) + bfhi(z.z) * (a1[1] * sigm(g1[1]));
                o[6] = bflo(t.w) + bflo(z.w) * (a1[2] * sigm(g1[2])); o[7] = bfhi(t.w) + bfhi(z.w) * (a1[3] * sigm(g1[3]));
                u32x4 w; w.x = cvt_pk_bf16(o[0], o[1]); w.y = cvt_pk_bf16(o[2], o[3]); w.z = cvt_pk_bf16(o[4], o[5]); w.w = cvt_pk_bf16(o[6], o[7]);
                *(u32x4*)(MG + row * D_MODEL + vcol) = w; }
    }
};
struct EpiRes {
    static constexpr bool PERM = false, AFTER_DRAIN = false;
    const float* xp; const float* xs; float* out; const float* modt; int goff;
    __device__ __forceinline__ void operator()(const f32x4 (&acc)[2][2][4][2], const Unit& u, int wr, int wc, int fr, int fq) const {
        const int row0 = u.pm * BM + wr * 64 + fr, col0 = u.pn * BM + wc * 32 + 4 * fq;
#pragma unroll
        for (int ai = 0; ai < 2; ++ai)
#pragma unroll
            for (int m = 0; m < 4; ++m) { const int row = row0 + ai * HALF + m * 16;
                if (row < MR) {
                    const float* xr = row < MP ? xp + (size_t)row * D_MODEL : xs + (size_t)(row - MP) * D_MODEL;
                    const float* gr = modt + (size_t)mod_row(row) * MODN + goff;
                    float* orow = out + (size_t)row * D_MODEL;
#pragma unroll
                    for (int bj = 0; bj < 2; ++bj)
#pragma unroll
                        for (int n = 0; n < 2; ++n) { const int col = col0 + bj * HALF + n * 16;
                            const f32x4 g = *(const f32x4*)(gr + col); const f32x4 xv = *(const f32x4*)(xr + col);
                            *(f32x4*)(orow + col) = xv + g * acc[ai][bj][m][n]; } } }
    }
};
struct EpiRelu2 {
    static constexpr bool PERM = true, AFTER_DRAIN = false;
    bf16_t* O;
    __device__ __forceinline__ void operator()(const f32x4 (&acc)[2][2][4][2], const Unit& u, int wr, int wc, int fr, int fq) const {
        const int row0 = u.pm * BM + wr * 64 + fr, col0 = u.pn * BM + wc * 32 + 8 * fq;
#pragma unroll
        for (int ai = 0; ai < 2; ++ai)
#pragma unroll
            for (int m = 0; m < 4; ++m) { bf16_t* rowp = O + (size_t)(row0 + ai * HALF + m * 16) * D_FF + col0;
#pragma unroll
                for (int bj = 0; bj < 2; ++bj) { f32x4 v0 = acc[ai][bj][m][0], v1 = acc[ai][bj][m][1];
#pragma unroll
                    for (int i = 0; i < 4; ++i) { const float a = fmaxf(v0[i], 0.f), b = fmaxf(v1[i], 0.f); v0[i] = a * a; v1[i] = b * b; }
                    u32x4 w; w.x = cvt_pk_bf16(v0[0], v0[1]); w.y = cvt_pk_bf16(v0[2], v0[3]); w.z = cvt_pk_bf16(v1[0], v1[1]); w.w = cvt_pk_bf16(v1[2], v1[3]);
                    *(u32x4*)(rowp + bj * HALF) = w; } }
    }
};

template <class Epi, class Sched, bool ALIGN_EPI = false, bool SP2 = false>
__device__ __forceinline__ void gemm_phase(PG8_LAS unsigned char* lds, const Gemm g, const Sched& S, const Epi& E) {
    const int tid = threadIdx.x, wid = __builtin_amdgcn_readfirstlane(tid >> 6), lane = tid & 63, wr = wid >> 2, wc = wid & 3, fr = lane & 15, fq = lane >> 4;
    const int K = g.K, nt = K / BK;
    unsigned voffA[2], voffB[2];
#pragma unroll
    for (int i = 0; i < 2; ++i) { int R, C; stage_rc(tid * 16 + i * 8192, R, C); const int Rb = Epi::PERM ? ((R & ~31) + perm32(R & 31)) : R;
        voffA[i] = (unsigned)(R * K + C) * 2u; voffB[i] = (unsigned)(Rb * K + C) * 2u; }
    const size_t kstep = (size_t)(BK * 2);
    const size_t hstep = (size_t)HALF * K * 2;
    const size_t tstep = 2 * hstep;
    const unsigned ldsw = (unsigned)wid * 1024u;
    const int aoff = lds_byte(wr * 64 + fr, fq * 8), boff = lds_byte(wc * 32 + fr, fq * 8);
#define PG8_SA(b, h) (((b) * 2 + (h)) * HTB)
#define PG8_SB(b, h) ((4 + (b) * 2 + (h)) * HTB)
#define PG8_STAGE(bufoff, gbase, voff) do { _Pragma("unroll") for (int _i = 0; _i < 2; ++_i) \
        __builtin_amdgcn_global_load_lds((const unsigned*)((const char*)(gbase) + (voff)[_i]), (PG8_LAS unsigned*)(lds + (bufoff) + ldsw + _i * 8192), 16, 0, 0); } while (0)
#define PG8_LDA(dst, b, h) do { _Pragma("unroll") for (int m = 0; m < 4; ++m) _Pragma("unroll") for (int k = 0; k < 2; ++k) dst[m][k] = *(const PG8_LAS bf16x8*)(lds + PG8_SA(b, h) + aoff + m * 2048 + k * 1024); } while (0)
#define PG8_LDB(dst, b, h) do { _Pragma("unroll") for (int n = 0; n < 2; ++n) _Pragma("unroll") for (int k = 0; k < 2; ++k) dst[n][k] = *(const PG8_LAS bf16x8*)(lds + PG8_SB(b, h) + boff + n * 2048 + k * 1024); } while (0)
#define PG8_MMA(ai, bj, At, Bt) do { __builtin_amdgcn_s_setprio(1); _Pragma("unroll") for (int m = 0; m < 4; ++m) _Pragma("unroll") for (int n = 0; n < 2; ++n) _Pragma("unroll") for (int k = 0; k < 2; ++k) \
        acc[ai][bj][m][n] = __builtin_amdgcn_mfma_f32_16x16x32_bf16(Bt[n][k], At[m][k], acc[ai][bj][m][n], 0, 0, 0); __builtin_amdgcn_s_setprio(0); } while (0)
#define PG8_WAIT_V(n) asm volatile("s_waitcnt vmcnt(" #n ")" ::: "memory")
#define PG8_WAIT_L(n) asm volatile("s_waitcnt lgkmcnt(" #n ")" ::: "memory")
#define PG8_BAR __builtin_amdgcn_s_barrier()
#define PG8_SCHED __builtin_amdgcn_sched_barrier(0)
    Unit cur, nxt; int ui = 0;
    if (!S.next(0, cur)) return;
    f32x4 acc[2][2][4][2];
#pragma unroll
    for (int a = 0; a < 2; ++a)
#pragma unroll
        for (int b = 0; b < 2; ++b)
#pragma unroll
            for (int m = 0; m < 4; ++m)
#pragma unroll
                for (int n = 0; n < 2; ++n) acc[a][b][m][n] = (f32x4){0.f, 0.f, 0.f, 0.f};
    bf16x8 At[4][2], B0[2][2], B1[2][2];
    const char* cA = (const char*)g.A + (size_t)cur.pm * tstep; const char* cB = (const char*)g.Bt + (size_t)cur.pn * tstep;
    S.a_ready(cur);
    if constexpr (SP2) {
        PG8_STAGE(PG8_SB(0, 0), cB, voffB); PG8_STAGE(PG8_SB(0, 1), cB + hstep, voffB); PG8_STAGE(PG8_SA(0, 0), cA, voffA); PG8_STAGE(PG8_SA(0, 1), cA + hstep, voffA);
        if (wr == 1) PG8_BAR;
        PG8_WAIT_V(2); PG8_BAR;
        PG8_STAGE(PG8_SB(1, 0), cB + kstep, voffB); PG8_STAGE(PG8_SA(1, 0), cA + kstep, voffA); PG8_STAGE(PG8_SB(1, 1), cB + hstep + kstep, voffB);
        PG8_WAIT_V(6); PG8_BAR;
    } else {
        PG8_STAGE(PG8_SB(0, 0), cB, voffB); PG8_STAGE(PG8_SA(0, 0), cA, voffA); PG8_STAGE(PG8_SB(0, 1), cB + hstep, voffB); PG8_STAGE(PG8_SA(0, 1), cA + hstep, voffA);
        if (wr == 1) PG8_BAR;
        PG8_WAIT_V(4); PG8_BAR;
        PG8_STAGE(PG8_SB(1, 0), cB + kstep, voffB); PG8_STAGE(PG8_SA(1, 0), cA + kstep, voffA); PG8_STAGE(PG8_SB(1, 1), cB + hstep + kstep, voffB);
        PG8_WAIT_V(6); PG8_BAR;
    }
    for (;;) {
        const bool has_next = S.next(ui + 1, nxt);
        const char* nA = has_next ? (const char*)g.A + (size_t)nxt.pm * tstep : cA; const char* nB = has_next ? (const char*)g.Bt + (size_t)nxt.pn * tstep : cB;
        for (int t = 0; t < nt; t += 2) {
            const bool last = (t == nt - 2);
            const char* a1 = cA + (size_t)(t + 1) * kstep;
            const char* a2 = last ? nA : cA + (size_t)(t + 2) * kstep; const char* b2 = last ? nB : cB + (size_t)(t + 2) * kstep;
            const char* a3 = a2 + kstep; const char* b3 = b2 + kstep;
            if (last && has_next) S.a_ready(nxt);
            if constexpr (SP2) {
            PG8_LDB(B0, 0, 0); PG8_LDB(B1, 0, 1); PG8_SCHED; PG8_LDA(At, 0, 0); PG8_STAGE(PG8_SA(1, 1), a1 + hstep, voffA);
            PG8_WAIT_V(8); PG8_WAIT_L(0); PG8_BAR; PG8_MMA(0, 0, At, B0); PG8_MMA(0, 1, At, B1); PG8_BAR; PG8_SCHED;
            PG8_LDA(At, 0, 1); PG8_STAGE(PG8_SB(0, 0), b2, voffB); PG8_STAGE(PG8_SB(0, 1), b2 + hstep, voffB); PG8_STAGE(PG8_SA(0, 0), a2, voffA);
            PG8_WAIT_V(8); PG8_WAIT_L(0); PG8_BAR; PG8_MMA(1, 0, At, B0); PG8_MMA(1, 1, At, B1); PG8_BAR; PG8_SCHED;
            PG8_LDB(B0, 1, 0); PG8_LDB(B1, 1, 1); PG8_SCHED; PG8_LDA(At, 1, 0); PG8_STAGE(PG8_SA(0, 1), a2 + hstep, voffA);
            PG8_WAIT_V(8); PG8_WAIT_L(0); PG8_BAR; PG8_MMA(0, 0, At, B0); PG8_MMA(0, 1, At, B1); PG8_BAR; PG8_SCHED;
            PG8_LDA(At, 1, 1); PG8_STAGE(PG8_SB(1, 0), b3, voffB); PG8_STAGE(PG8_SB(1, 1), b3 + hstep, voffB); PG8_STAGE(PG8_SA(1, 0), a3, voffA);
            PG8_WAIT_V(8); PG8_WAIT_L(0); PG8_BAR; PG8_MMA(1, 0, At, B0); PG8_MMA(1, 1, At, B1); PG8_BAR; PG8_SCHED;
            } else {
            PG8_LDB(B0, 0, 0); PG8_SCHED; PG8_LDA(At, 0, 0); PG8_STAGE(PG8_SA(1, 1), a1 + hstep, voffA);
            PG8_WAIT_L(8); PG8_BAR; PG8_WAIT_L(0); PG8_MMA(0, 0, At, B0); PG8_BAR; PG8_SCHED;
            PG8_LDB(B1, 0, 1); PG8_STAGE(PG8_SB(0, 0), b2, voffB);
            PG8_BAR; PG8_WAIT_L(0); PG8_MMA(0, 1, At, B1); PG8_BAR;
            PG8_LDA(At, 0, 1); PG8_STAGE(PG8_SA(0, 0), a2, voffA);
            PG8_BAR; PG8_WAIT_L(0); PG8_MMA(1, 0, At, B0); PG8_BAR; PG8_SCHED;
            PG8_STAGE(PG8_SB(0, 1), b2 + hstep, voffB);
            PG8_WAIT_V(6); PG8_BAR; PG8_MMA(1, 1, At, B1); PG8_BAR;
            PG8_LDB(B0, 1, 0); PG8_SCHED; PG8_LDA(At, 1, 0); PG8_STAGE(PG8_SA(0, 1), a2 + hstep, voffA);
            PG8_WAIT_L(8); PG8_BAR; PG8_WAIT_L(0); PG8_MMA(0, 0, At, B0); PG8_BAR; PG8_SCHED;
            PG8_LDB(B1, 1, 1); PG8_STAGE(PG8_SB(1, 0), b3, voffB);
            PG8_BAR; PG8_WAIT_L(0); PG8_MMA(0, 1, At, B1); PG8_BAR;
            PG8_LDA(At, 1, 1); PG8_STAGE(PG8_SA(1, 0), a3, voffA);
            PG8_BAR; PG8_WAIT_L(0); PG8_MMA(1, 0, At, B0); PG8_BAR; PG8_SCHED;
            PG8_STAGE(PG8_SB(1, 1), b3 + hstep, voffB);
            PG8_WAIT_V(6); PG8_BAR; PG8_MMA(1, 1, At, B1); PG8_BAR;
            }
        }
        if constexpr (ALIGN_EPI) { if (wr == 0) PG8_BAR; }
        if constexpr (!Epi::AFTER_DRAIN) { E(acc, cur, wr, wc, fr, fq); S.done(cur); }
        if (!has_next) break;
#pragma unroll
        for (int a = 0; a < 2; ++a)
#pragma unroll
            for (int b = 0; b < 2; ++b)
#pragma unroll
                for (int m = 0; m < 4; ++m)
#pragma unroll
                    for (int n = 0; n < 2; ++n) acc[a][b][m][n] = (f32x4){0.f, 0.f, 0.f, 0.f};
        cur = nxt; cA = nA; cB = nB; ++ui;
        if constexpr (ALIGN_EPI) { if (wr == 1) PG8_BAR; }
    }
    PG8_WAIT_V(0);
    if constexpr (!ALIGN_EPI) { if (wr == 0) PG8_BAR; }
    PG8_BAR;
    if constexpr (Epi::AFTER_DRAIN) { E.fused(acc, cur, wr, wc, fr, fq, lds, wid, lane); S.done(cur); }
#undef PG8_SA
#undef PG8_SB
#undef PG8_STAGE
#undef PG8_LDA
#undef PG8_LDB
#undef PG8_MMA
#undef PG8_WAIT_V
#undef PG8_WAIT_L
#undef PG8_BAR
#undef PG8_SCHED
}
}
#ifndef PG8_SP2
#define PG8_SP2 true
#endif
#ifndef PG8_ALIGN
#define PG8_ALIGN true
#endif
#ifndef MK_ONE_LAUNCH
#define MK_ONE_LAUNCH 1
#endif

using pg8::D_MODEL; using pg8::MP; using pg8::MS; using pg8::MR; using pg8::MODN; using pg8::NPROJ; using pg8::D_FF;
constexpr int MPAD = 8448;
constexpr int SEQ = 2048, NB = 4, W_LRU = 1024, W_SSM = 1024, NHEAD = 8, HDIM = 128, NGRP = 64, NST = 64, GSZ = 16;
constexpr int S5_TC = 128, S5_NCH = SEQ / S5_TC;
constexpr int LR_TC = 64,  LR_NCH = SEQ / LR_TC;
constexpr float EPS = 1e-6f;
constexpr size_t O_YP = 0, O_YS = 16777216, O_CP = 17039360, O_LP = 17051648, O_RP = 17055744, O_IP = 17072128, O_CS = 17088512, O_LS = 17481728, O_RS = 17612800, O_IS = 18137088, O_END = 18661376;

constexpr size_t MiB = 1u << 20;
constexpr size_t WS_CTL = 0, CTL_ZERO_BYTES = 1 * MiB;
constexpr size_t WS_MOD = 1 * MiB;
constexpr size_t WS_TAB = 8 * MiB;
constexpr size_t TB_SILU = 0;
constexpr size_t TB_ABR = 1 * MiB, TB_ABI = TB_ABR + 16384;
constexpr size_t TB_BBR = TB_ABI + 16384, TB_BBI = TB_BBR + 262144;
constexpr size_t TB_SSR = 2 * MiB, TB_SSI = 3 * MiB;
constexpr size_t TB_LRA = 4 * MiB, TB_LRE = 4 * MiB + 524288;
constexpr size_t WS_WIN = 16 * MiB, WS_WPA = 40 * MiB, WS_WGLU = 44 * MiB, WS_WOUT = 52 * MiB, WS_WUP = 60 * MiB, WS_WDN = 92 * MiB;
constexpr size_t WS_A = 124 * MiB;
constexpr size_t WS_PROJ = 157 * MiB;
constexpr size_t WS_HSEQ = 256 * MiB, WS_GY = 273 * MiB;
constexpr size_t WS_T = 290 * MiB, WS_UCONV = WS_T;
constexpr size_t WS_ACT = 157 * MiB;
constexpr size_t WS_END = 323 * MiB;
static_assert(WS_ACT + (size_t)MPAD * D_FF * 2 <= WS_T && WS_T + (size_t)MPAD * D_MODEL * 2 <= WS_END && WS_PROJ + (size_t)MPAD * NPROJ * 2 <= WS_HSEQ, "d_ws map");
constexpr int CW_BAR = 4096;

constexpr int RING_BYTES = 131072, LDSCTL_OFF = RING_BYTES, MISC_OFF = LDSCTL_OFF + 320, LDS_BYTES = 147456;
constexpr int NWAVES = 8;

#define GAS __attribute__((address_space(1)))
#define LAS __attribute__((address_space(3)))
typedef unsigned short bf16;
typedef unsigned v4u __attribute__((ext_vector_type(4)));
typedef unsigned v2u __attribute__((ext_vector_type(2)));
typedef float f32x4 __attribute__((ext_vector_type(4)));
typedef float f32x16 __attribute__((ext_vector_type(16)));
typedef short bf16x8 __attribute__((ext_vector_type(8)));
typedef GAS unsigned gu32;
#define RLX_AGENT __ATOMIC_RELAXED, __HIP_MEMORY_SCOPE_AGENT
#define LDS_WAIT() asm volatile("s_waitcnt lgkmcnt(0)" ::: "memory")
#define VM_WAIT() asm volatile("s_waitcnt vmcnt(0)" ::: "memory")
__device__ __forceinline__ unsigned f2bf(float f) { unsigned u = __builtin_bit_cast(unsigned, f); return (u + 0x7fffu + ((u >> 16) & 1u)) >> 16; }
__device__ __forceinline__ unsigned pk2(float lo, float hi) { return pg8::cvt_pk_bf16(lo, hi); }
__device__ __forceinline__ float bf2f(bf16 v) { return __uint_as_float((unsigned)v << 16); }
using pg8::bflo; using pg8::bfhi; using pg8::sigm;
__device__ __forceinline__ bf16x8 pack8(f32x4 a, f32x4 b) { v4u w; w.x = pk2(a[0], a[1]); w.y = pk2(a[2], a[3]); w.z = pk2(b[0], b[1]); w.w = pk2(b[2], b[3]); return __builtin_bit_cast(bf16x8, w); }
__device__ __forceinline__ float gelu_tanh(float v) {
    const float z = 0.7978845608f * (v + 0.044715f * v * v * v);
    const float t = __builtin_amdgcn_exp2f(2.885390082f * z);
    return v - v * __builtin_amdgcn_rcpf(1.0f + t);
}
__device__ __forceinline__ float wave_sum(float v) {
#pragma unroll
    for (int o = 1; o < 64; o <<= 1) v += __shfl_xor(v, o);
    return v;
}

#if MK_ONE_LAUNCH
#define XB_TMO      128
#define XB_XCNT(j)  (256  + 64 * (j))
#define XB_XSUB(j)  (1280 + 64 * (j))
#define XB_XGEN(j)  (2304 + 64 * (j))
#define XB_TOP      3328
#define XB_TOPGEN   3392
#define XCD_BAR_WORDS 3456
#define XB_SPIN_CAP (1u << 18)

__device__ __forceinline__ unsigned xb_ld(unsigned* p)              { return __hip_atomic_load(p, __ATOMIC_RELAXED, __HIP_MEMORY_SCOPE_AGENT); }
__device__ __forceinline__ unsigned xb_add(unsigned* p, unsigned v) { return __hip_atomic_fetch_add(p, v, __ATOMIC_RELAXED, __HIP_MEMORY_SCOPE_AGENT); }
__device__ __forceinline__ unsigned xb_xcc_id() { return (unsigned)__builtin_amdgcn_s_getreg((3 << 11) | 20) & 0xFu; }
#define XB_SPIN(cond, bar) do { unsigned _sp = 0; while (cond) { __builtin_amdgcn_s_sleep(1); \
    if ((++_sp & 255u) == 0u) { if (xb_ld(&(bar)[XB_TMO])) break; if (_sp > XB_SPIN_CAP) { atomicAdd(&(bar)[XB_TMO], 1u); break; } } } } while (0)

struct XcdBarrier {
    unsigned* bar; unsigned x;
    volatile LAS unsigned* st;
};

__device__ __forceinline__ XcdBarrier xcd_barrier_post(unsigned* bar, volatile LAS unsigned* st) {
    XcdBarrier b; b.bar = bar; b.x = xb_xcc_id(); b.st = st;
    if (threadIdx.x == 0) (void)xb_add(&bar[XB_XCNT(b.x)], 1u);
    return b;
}
__device__ __forceinline__ void xcd_barrier_complete(unsigned* bar, unsigned x, unsigned& nloc, unsigned& nx) {
    const unsigned G = gridDim.x * gridDim.y * gridDim.z;
    unsigned sum, cnt, mine, sp = 0u;
    for (;;) {
        sum = 0u; cnt = 0u; mine = 0u;
#pragma unroll
        for (unsigned j = 0; j < 16; ++j) { const unsigned c = xb_ld(&bar[XB_XCNT(j)]); sum += c; cnt += (c > 0u) ? 1u : 0u; mine = (j == x) ? c : mine; }
        if (sum == G) break;
        __builtin_amdgcn_s_sleep(1);
        if ((++sp & 255u) == 0u) { if (xb_ld(&bar[XB_TMO])) break; if (sp > XB_SPIN_CAP) { atomicAdd(&bar[XB_TMO], 1u); break; } }
    }
    nloc = mine > 0u ? mine : 1u; nx = cnt > 0u ? cnt : 1u;
}

__device__ __forceinline__ void xcd_barrier(const XcdBarrier& b) {
    asm volatile("s_waitcnt vmcnt(0)" ::: "memory");
    __syncthreads();
    if (threadIdx.x == 0) {
        unsigned* bar = b.bar;
        __builtin_amdgcn_s_waitcnt(0);
        unsigned nloc = b.st[0], nx = b.st[1];
        if (nloc == 0u) { xcd_barrier_complete(bar, b.x, nloc, nx); b.st[0] = nloc; b.st[1] = nx; }
        const unsigned old = xb_add(&bar[XB_XSUB(b.x)], 1u);
        const unsigned gen = old / nloc;
        if (old + 1u == (gen + 1u) * nloc) {
            __builtin_amdgcn_fence(__ATOMIC_RELEASE, "agent");
            asm volatile("s_waitcnt vmcnt(0)" ::: "memory");
            const unsigned og = xb_add(&bar[XB_TOP], 1u);
            const unsigned tg = og / nx;
            if (og + 1u == (tg + 1u) * nx) xb_add(&bar[XB_TOPGEN], 1u);
            else XB_SPIN(xb_ld(&bar[XB_TOPGEN]) == tg, bar);
            __builtin_amdgcn_fence(__ATOMIC_ACQUIRE, "agent");
            xb_add(&bar[XB_XGEN(b.x)], 1u);
            asm volatile("s_waitcnt vmcnt(0)" ::: "memory");
        } else {
            XB_SPIN(xb_ld(&bar[XB_XGEN(b.x)]) == gen, bar);
            __builtin_amdgcn_fence(__ATOMIC_ACQUIRE, "agent");
            asm volatile("s_waitcnt vmcnt(0)" ::: "memory");
        }
    }
    __syncthreads();
}

#endif

struct Args { const void* in[34]; float* out; unsigned char* ws; int ph_lo, ph_hi; };

struct Ctx {
    LAS unsigned char* lds; int tid, lane, wave, vcu, G, gw, NGW;
    const float *xp, *xs, *st_conv, *st_lru, *st_re, *st_im, *c_p, *c_s, *w_ada, *b_ada, *g1, *g2, *w_in, *conv_w, *conv_b, *w_rga, *b_rga, *w_rgx, *b_rgx, *lam, *w_pa;
    const float *a_re, *a_im, *log_dt, *b_re, *b_im, *c_re, *c_im, *ssm_d, *w_glu, *w_out, *w_up, *w_dn, *g_fin;
    float* out; unsigned char* ws;
    float* modt; bf16* silu; float *abr, *abi, *bbr, *bbi, *ssr, *ssi, *lra, *lre;
    bf16 *Win, *Wpa, *Wglu, *Wout, *Wup, *Wdn, *A, *P, *HS, *GY, *T, *UC, *ACT;
};

__device__ __forceinline__ void p0_transpose_item(const float* W, int K, int N, bf16* WT, int glu, LAS float* scr, int item, int lane) {
    const int nblk = N / 32, kb = item / nblk, nb = item % nblk, k0 = 64 * kb, n0 = 32 * nb;
#pragma unroll 8
    for (int i = 0; i < 32; ++i) { const int kk = 2 * i + (lane >> 5); scr[kk * 33 + (lane & 31)] = W[(size_t)(k0 + kk) * N + n0 + (lane & 31)]; }
    LDS_WAIT(); asm volatile("" ::: "memory");
    const int c = lane & 7;
    int d0 = n0; if (glu) d0 = n0 < 2048 ? ((n0 >> 7) * 256 + (n0 & 127)) : (((n0 - 2048) >> 7) * 256 + 128 + ((n0 - 2048) & 127));
#pragma unroll
    for (int j = 0; j < 4; ++j) { const int n = (lane >> 3) + 8 * j; const LAS float* s = scr + (8 * c) * 33 + n;
        v4u o; o.x = pk2(s[0 * 33], s[1 * 33]); o.y = pk2(s[2 * 33], s[3 * 33]); o.z = pk2(s[4 * 33], s[5 * 33]); o.w = pk2(s[6 * 33], s[7 * 33]);
        *(v4u*)(WT + (size_t)(d0 + n) * K + k0 + 8 * c) = o; }
    LDS_WAIT(); asm volatile("" ::: "memory");
}
__device__ __forceinline__ void p0_phase(const Ctx& C) {
    LAS float* scr = (LAS float*)(C.lds + C.wave * 16384);
    constexpr int I_IN = (2048 / 64) * (6144 / 32), I_PA = (1024 / 64) * (2048 / 32), I_GLU = (1024 / 64) * (4096 / 32), I_OUT = (2048 / 64) * (2048 / 32), I_UP = (2048 / 64) * (8192 / 32), I_DN = (8192 / 64) * (2048 / 32);
    constexpr int NIT = I_IN + I_PA + I_GLU + I_OUT + I_UP + I_DN;
    for (int it = C.gw; it < NIT; it += C.NGW) {
        int r = it;
        if (r < I_IN) { p0_transpose_item(C.w_in, 2048, 6144, C.Win, 0, scr, r, C.lane); continue; } r -= I_IN;
        if (r < I_PA) { p0_transpose_item(C.w_pa, 1024, 2048, C.Wpa, 0, scr, r, C.lane); continue; } r -= I_PA;
        if (r < I_GLU) { p0_transpose_item(C.w_glu, 1024, 4096, C.Wglu, 1, scr, r, C.lane); continue; } r -= I_GLU;
        if (r < I_OUT) { p0_transpose_item(C.w_out, 2048, 2048, C.Wout, 0, scr, r, C.lane); continue; } r -= I_OUT;
        if (r < I_UP) { p0_transpose_item(C.w_up, 2048, 8192, C.Wup, 0, scr, r, C.lane); continue; } r -= I_UP;
        p0_transpose_item(C.w_dn, 8192, 2048, C.Wdn, 0, scr, r, C.lane);
    }
    for (int r = C.gw; r < 144; r += C.NGW) {
        const float* src = r < 4 ? C.c_p + (size_t)r * D_MODEL : C.c_s + (size_t)(r < 132 ? r - 4 : 0) * D_MODEL;
#pragma unroll
        for (int j = 0; j < 4; ++j) { const int idx = j * 512 + C.lane * 8;
            f32x4 a = *(const f32x4*)(src + idx), b = *(const f32x4*)(src + idx + 4);
#pragma unroll
            for (int i = 0; i < 4; ++i) { a[i] = a[i] * sigm(a[i]); b[i] = b[i] * sigm(b[i]); }
            if (r >= 132) { a = (f32x4){0.f, 0.f, 0.f, 0.f}; b = a; }
            v4u o; o.x = pk2(a[0], a[1]); o.y = pk2(a[2], a[3]); o.z = pk2(b[0], b[1]); o.w = pk2(b[2], b[3]);
            *(v4u*)(C.silu + (size_t)r * D_MODEL + idx) = o; }
    }
    for (int g = C.gw; g < NGRP; g += C.NGW) {
        const int idx = g * NST + C.lane;
        const float ar = C.a_re[idx], ai = C.a_im[idx], dt = expf(C.log_dt[g]);
        const float mag = expf(dt * ar), ang = dt * ai;
        float sn, cs; sincosf(ang, &sn, &cs);
        const float abr = mag * cs, abi = mag * sn;
        const float den = ar * ar + ai * ai, nr = abr - 1.0f, ni = abi;
        const float qre = (nr * ar + ni * ai) / den, qim = (ni * ar - nr * ai) / den;
        C.abr[idx] = abr; C.abi[idx] = abi;
#pragma unroll
        for (int k4 = 0; k4 < 4; ++k4) { const f32x4 br = *(const f32x4*)(C.b_re + (size_t)idx * 16 + 4 * k4), bi = *(const f32x4*)(C.b_im + (size_t)idx * 16 + 4 * k4);
            *(f32x4*)(C.bbr + (size_t)idx * 16 + 4 * k4) = qre * br - qim * bi; *(f32x4*)(C.bbi + (size_t)idx * 16 + 4 * k4) = qre * bi + qim * br; }
    }
}

__device__ __forceinline__ void mod_phase(const Ctx& C) {
    const int n = C.lane & 15, kg = C.lane >> 4;
    LAS float* part = (LAS float*)C.lds;
    for (int u = blockIdx.x; u < MODN / 16; u += C.G) {
        const int n0 = u * 16;
        const float* Wp = C.w_ada + (size_t)(256 * C.wave + 8 * kg) * MODN + n0 + n;
        const bf16* Ap = C.silu + (size_t)n * D_MODEL + 256 * C.wave + 8 * kg;
        f32x4 acc[9];
#pragma unroll
        for (int i = 0; i < 9; ++i) acc[i] = (f32x4){0.f, 0.f, 0.f, 0.f};
        float w[8][8];
#pragma unroll
        for (int ks = 0; ks < 8; ++ks)
#pragma unroll
            for (int j = 0; j < 8; ++j) w[ks][j] = Wp[(size_t)(ks * 32 + j) * MODN];
#pragma unroll
        for (int ks = 0; ks < 8; ++ks) {
            const bf16x8 bfr = pack8((f32x4){w[ks][0], w[ks][1], w[ks][2], w[ks][3]}, (f32x4){w[ks][4], w[ks][5], w[ks][6], w[ks][7]});
#pragma unroll
            for (int mf = 0; mf < 9; ++mf) { const bf16x8 a = *(const bf16x8*)(Ap + (size_t)mf * 16 * D_MODEL + ks * 32);
                acc[mf] = __builtin_amdgcn_mfma_f32_16x16x32_bf16(a, bfr, acc[mf], 0, 0, 0); }
        }
#pragma unroll
        for (int mf = 0; mf < 9; ++mf)
#pragma unroll
            for (int r = 0; r < 4; ++r) part[((C.wave * 9 + mf) * 4 + r) * 64 + C.lane] = acc[mf][r];
        __syncthreads();
        for (int e = C.tid; e < 9 * 4 * 64; e += NWAVES * 64) {
            float s = 0.f;
#pragma unroll
            for (int wv = 0; wv < 8; ++wv) s += part[wv * 2304 + e];
            const int mf = e >> 8, r = (e >> 6) & 3, l64 = e & 63, row = mf * 16 + 4 * (l64 >> 4) + r, col = n0 + (l64 & 15);
            C.modt[(size_t)row * MODN + col] = s + C.b_ada[col];
        }
        __syncthreads();
    }
}

__device__ __forceinline__ void norm_mod_phase(const Ctx& C, const float* xp, const float* xs, const float* g, int sh_off, int sc_off, bf16* O) {
    for (int row = C.gw; row < MR; row += C.NGW) {
        const float* xr = row < MP ? xp + (size_t)row * D_MODEL : xs + (size_t)(row - MP) * D_MODEL;
        const float* mr = C.modt + (size_t)pg8::mod_row(row) * MODN;
        f32x4 v[8]; float ss = 0.f;
#pragma unroll
        for (int j = 0; j < 8; ++j) { v[j] = *(const f32x4*)(xr + 256 * j + 4 * C.lane); ss += (v[j][0] * v[j][0] + v[j][1] * v[j][1]) + (v[j][2] * v[j][2] + v[j][3] * v[j][3]); }
        const float rstd = 1.0f / sqrtf(wave_sum(ss) * (1.0f / D_MODEL) + EPS);
#pragma unroll
        for (int j = 0; j < 8; ++j) { const int col = 256 * j + 4 * C.lane;
            const f32x4 gg = *(const f32x4*)(g + col), sc = *(const f32x4*)(mr + sc_off + col), sh = *(const f32x4*)(mr + sh_off + col);
            const f32x4 o = v[j] * rstd * gg * (1.0f + sc) + sh;
            v2u w; w.x = pk2(o[0], o[1]); w.y = pk2(o[2], o[3]);
            *(v2u*)(O + (size_t)row * D_MODEL + col) = w; }
    }
}
__device__ __forceinline__ void final_norm_phase(const Ctx& C) {
    for (int row = C.gw; row < MR; row += C.NGW) {
        float* xr = C.out + (size_t)row * D_MODEL;
        f32x4 v[8]; float ss = 0.f;
#pragma unroll
        for (int j = 0; j < 8; ++j) { v[j] = *(const f32x4*)(xr + 256 * j + 4 * C.lane); ss += (v[j][0] * v[j][0] + v[j][1] * v[j][1]) + (v[j][2] * v[j][2] + v[j][3] * v[j][3]); }
        const float rstd = 1.0f / sqrtf(wave_sum(ss) * (1.0f / D_MODEL) + EPS);
#pragma unroll
        for (int j = 0; j < 8; ++j) { const int col = 256 * j + 4 * C.lane; *(f32x4*)(xr + col) = v[j] * rstd * *(const f32x4*)(C.g_fin + col); }
    }
}

__device__ __forceinline__ f32x16 zero16() { return f32x16{}; }

__device__ __forceinline__ void conv_phase(const Ctx& C) {
    const int nthr = C.G * NWAVES * 64;
    for (int idx = C.vcu * (NWAVES * 64) + C.tid; idx < MP * 128; idx += nthr) {
        const int row = idx >> 7, c0 = (idx & 127) * 8, t = row & (SEQ - 1);
        f32x4 a0 = *(const f32x4*)(C.conv_b + c0), a1 = *(const f32x4*)(C.conv_b + c0 + 4);
#pragma unroll
        for (int d = 0; d < 4; ++d) {
            if (t - d >= 0) {
                const v4u u = *(const v4u*)(C.P + (size_t)(row - d) * NPROJ + c0);
                const f32x4 w0 = *(const f32x4*)(C.conv_w + (3 - d) * W_LRU + c0), w1 = *(const f32x4*)(C.conv_w + (3 - d) * W_LRU + c0 + 4);
                a0[0] += w0[0] * bflo(u.x); a0[1] += w0[1] * bfhi(u.x); a0[2] += w0[2] * bflo(u.y); a0[3] += w0[3] * bfhi(u.y);
                a1[0] += w1[0] * bflo(u.z); a1[1] += w1[1] * bfhi(u.z); a1[2] += w1[2] * bflo(u.w); a1[3] += w1[3] * bfhi(u.w);
            }
        }
        v4u o; o.x = pk2(a0[0], a0[1]); o.y = pk2(a0[2], a0[3]); o.z = pk2(a1[0], a1[1]); o.w = pk2(a1[2], a1[3]);
        *(v4u*)(C.UC + (size_t)row * W_LRU + c0) = o;
    }
    for (int idx = C.vcu * (NWAVES * 64) + C.tid; idx < NB * 3 * W_LRU; idx += nthr) {
        const int ch = idx & (W_LRU - 1), k = (idx >> 10) % 3, b = idx / (3 * W_LRU);
        C.out[O_CP + idx] = bf2f(C.P[(size_t)(b * SEQ + SEQ - 3 + k) * NPROJ + ch]);
    }
}

template <bool APPLY>
__device__ __forceinline__ void s5_unit(const Ctx& C, int g, int q, LAS unsigned char* wl) {
    const int lane = C.lane, c31 = lane & 31, kh = lane >> 5;
    const int asel = (c31 >> 2) & 1, atok = (c31 & 3) + 4 * (c31 >> 3);
    const int b = q >> 3, cX = 2 * (q & 7), myc = cX + kh;
    const int rowX = b * SEQ + cX * S5_TC;
    bf16x8 bb[2][2]; float ar[2], ai[2], hr[2], hi[2];
#pragma unroll
    for (int ph = 0; ph < 2; ++ph) { const int idx = g * NST + ph * 32 + c31;
        ar[ph] = C.abr[idx]; ai[ph] = C.abi[idx]; hr[ph] = 0.f; hi[ph] = 0.f;
        const f32x4* sr = (const f32x4*)(C.bbr + (size_t)idx * 16 + 8 * kh); const f32x4* si = (const f32x4*)(C.bbi + (size_t)idx * 16 + 8 * kh);
        bb[0][ph] = pack8(sr[0], sr[1]); bb[1][ph] = pack8(si[0], si[1]); }
    bf16x8 cb[8];
    float dsk = 0.f;
    if (APPLY) {
#pragma unroll
        for (int ph = 0; ph < 2; ++ph) { float pr = ar[ph], pi = ai[ph];
#pragma unroll
            for (int s = 0; s < 7; ++s) { const float nr = pr * pr - pi * pi, ni = 2.0f * pr * pi; pr = nr; pi = ni; }
            const size_t sidx = (size_t)g * NST + ph * 32 + c31; float Hr = 0.f, Hi = 0.f;
            for (int j = 0; j < S5_NCH - 1; ++j) { const float sr = C.ssr[(size_t)(b * S5_NCH + j) * 4096 + sidx], si = C.ssi[(size_t)(b * S5_NCH + j) * 4096 + sidx];
                const float nr = pr * Hr - pi * Hi + sr, ni = pr * Hi + pi * Hr + si; if (j < myc) { Hr = nr; Hi = ni; } }
            hr[ph] = Hr; hi[ph] = Hi; }
#pragma unroll
        for (int s = 0; s < 8; ++s) { f32x4 a = (f32x4){0.f, 0.f, 0.f, 0.f}, bq = a;
            if (c31 < 16) { const float* src = (s < 4 ? C.c_re : C.c_im) + (size_t)(g * GSZ + c31) * NST + 16 * (s & 3) + 8 * kh; a = *(const f32x4*)src; bq = *(const f32x4*)(src + 4); if (s >= 4) { a = -a; bq = -bq; } }
            cb[s] = pack8(a, bq); }
        dsk = C.ssm_d[g * GSZ + (c31 & 15)];
    }
    const bf16* arow = C.P + (size_t)(rowX + asel * S5_TC + atok) * NPROJ + W_LRU + g * GSZ + 8 * kh;
    LAS bf16* hl = (LAS bf16*)wl;
    for (int st = 0; st < S5_TC / 16; ++st) {
        const bf16x8 af = *(const bf16x8*)(arow + (size_t)st * 16 * NPROJ);
        const f32x16 z = zero16();
        f32x16 re0 = __builtin_amdgcn_mfma_f32_32x32x16_bf16(af, bb[0][0], z, 0, 0, 0), re1 = __builtin_amdgcn_mfma_f32_32x32x16_bf16(af, bb[0][1], z, 0, 0, 0);
        f32x16 im0 = __builtin_amdgcn_mfma_f32_32x32x16_bf16(af, bb[1][0], z, 0, 0, 0), im1 = __builtin_amdgcn_mfma_f32_32x32x16_bf16(af, bb[1][1], z, 0, 0, 0);
#pragma unroll
        for (int r = 0; r < 16; ++r) {
            { const float nr = ar[0] * hr[0] - ai[0] * hi[0] + re0[r], ni = ar[0] * hi[0] + ai[0] * hr[0] + im0[r]; hr[0] = nr; hi[0] = ni; re0[r] = nr; im0[r] = ni; }
            { const float nr = ar[1] * hr[1] - ai[1] * hi[1] + re1[r], ni = ar[1] * hi[1] + ai[1] * hr[1] + im1[r]; hr[1] = nr; hi[1] = ni; re1[r] = nr; im1[r] = ni; }
        }
        if (APPLY) {
#pragma unroll
            for (int r = 0; r < 16; ++r) { const int rho = (r & 3) + 4 * kh + 8 * (r >> 2);
                hl[rho * 136 + c31] = (bf16)f2bf(re0[r]); hl[rho * 136 + 32 + c31] = (bf16)f2bf(re1[r]);
                hl[rho * 136 + 64 + c31] = (bf16)f2bf(im0[r]); hl[rho * 136 + 96 + c31] = (bf16)f2bf(im1[r]); }
            f32x16 y = zero16();
#pragma unroll
            for (int s = 0; s < 8; ++s) { const bf16x8 hA = *(const LAS bf16x8*)(hl + c31 * 136 + 16 * s + 8 * kh); y = __builtin_amdgcn_mfma_f32_32x32x16_bf16(hA, cb[s], y, 0, 0, 0); }
            if (c31 < 16) { const int ch = g * GSZ + c31;
#pragma unroll
                for (int r = 0; r < 16; ++r) { const size_t trow = (size_t)(rowX + kh * S5_TC + st * 16 + r);
                    const float u = bf2f(C.P[trow * NPROJ + W_LRU + ch]);
                    C.GY[trow * W_SSM + ch] = (bf16)f2bf(gelu_tanh(y[r] + dsk * u)); } }
        }
    }
#pragma unroll
    for (int ph = 0; ph < 2; ++ph) { const size_t sidx = (size_t)g * NST + ph * 32 + c31;
        if (!APPLY) { C.ssr[(size_t)(b * S5_NCH + myc) * 4096 + sidx] = hr[ph]; C.ssi[(size_t)(b * S5_NCH + myc) * 4096 + sidx] = hi[ph]; }
        else if (myc == S5_NCH - 1) { C.out[O_RP + (size_t)b * 4096 + sidx] = hr[ph]; C.out[O_IP + (size_t)b * 4096 + sidx] = hi[ph]; } }
}

template <bool APPLY>
__device__ __forceinline__ void lru_unit(const Ctx& C, int hd, int jt, int q) {
    const int lane = C.lane, c31 = lane & 31, kh = lane >> 5;
    const int asel = (c31 >> 2) & 1, atok = (c31 & 3) + 4 * (c31 >> 3);
    const int b = q >> 4, cX = 2 * (q & 15), myc = cX + kh;
    const int rowX = b * SEQ + cX * LR_TC;
    const int ch = hd * HDIM + jt * 32 + c31;
    bf16x8 wa[8], wx[8];
#pragma unroll
    for (int s = 0; s < 8; ++s) { float ta[8], tx[8];
#pragma unroll
        for (int j = 0; j < 8; ++j) { const size_t wi = (size_t)(hd * HDIM + 16 * s + 8 * kh + j) * HDIM + jt * 32 + c31; ta[j] = C.w_rga[wi]; tx[j] = C.w_rgx[wi]; }
        wa[s] = pack8((f32x4){ta[0], ta[1], ta[2], ta[3]}, (f32x4){ta[4], ta[5], ta[6], ta[7]}); wx[s] = pack8((f32x4){tx[0], tx[1], tx[2], tx[3]}, (f32x4){tx[4], tx[5], tx[6], tx[7]}); }
    const float ba = C.b_rga[ch], bx = C.b_rgx[ch];
    const float lm = C.lam[ch];
    const float sp8 = 8.0f * (fmaxf(-lm, 0.f) + log1pf(expf(-fabsf(lm))));
    float h = 0.f, aprod = 1.f;
    if (APPLY) { float H = 0.f;
        for (int j = 0; j < LR_NCH - 1; ++j) { const float A = C.lra[(size_t)(b * LR_NCH + j) * W_LRU + ch], E = C.lre[(size_t)(b * LR_NCH + j) * W_LRU + ch]; const float nh = A * H + E; if (j < myc) H = nh; }
        h = H; }
    const bf16* arow = C.UC + (size_t)(rowX + asel * LR_TC + atok) * W_LRU + hd * HDIM + 8 * kh;
    for (int st = 0; st < LR_TC / 16; ++st) {
        f32x16 pr = zero16(), pi = zero16();
#pragma unroll
        for (int s = 0; s < 8; ++s) { const bf16x8 af = *(const bf16x8*)(arow + (size_t)st * 16 * W_LRU + 16 * s);
            pr = __builtin_amdgcn_mfma_f32_32x32x16_bf16(af, wa[s], pr, 0, 0, 0); pi = __builtin_amdgcn_mfma_f32_32x32x16_bf16(af, wx[s], pi, 0, 0, 0); }
#pragma unroll
        for (int r = 0; r < 16; ++r) { const size_t orow = (size_t)(rowX + kh * LR_TC + st * 16 + r);
            const float uc = bf2f(C.UC[orow * W_LRU + ch]);
            const float rr = sigm(pr[r] + ba), ii = sigm(pi[r] + bx);
            const float la = -sp8 * rr, a = __expf(la), mult = sqrtf(fmaxf(-expm1f(2.0f * la), 0.f));
            h = a * h + mult * ii * uc; aprod *= a;
            if (APPLY) C.HS[orow * W_LRU + ch] = (bf16)f2bf(h); }
    }
    if (!APPLY) { C.lra[(size_t)(b * LR_NCH + myc) * W_LRU + ch] = aprod; C.lre[(size_t)(b * LR_NCH + myc) * W_LRU + ch] = h; }
    else if (myc == LR_NCH - 1) C.out[O_LP + (size_t)b * W_LRU + ch] = h;
}

__device__ __forceinline__ void lru_sample_unit(const Ctx& C, int s, int hd, int jh, LAS unsigned char* wl) {
    LAS float* ucl = (LAS float*)wl;
    const size_t row = (size_t)(MP + s);
#pragma unroll
    for (int t = 0; t < 2; ++t) { const int i = C.lane + 64 * t, ci = hd * HDIM + i;
        const float u = bf2f(C.P[row * NPROJ + ci]);
        const float s0 = C.st_conv[(size_t)(s * 3 + 0) * W_LRU + ci], s1 = C.st_conv[(size_t)(s * 3 + 1) * W_LRU + ci], s2 = C.st_conv[(size_t)(s * 3 + 2) * W_LRU + ci];
        ucl[i] = C.conv_b[ci] + C.conv_w[ci] * s0 + C.conv_w[W_LRU + ci] * s1 + C.conv_w[2 * W_LRU + ci] * s2 + C.conv_w[3 * W_LRU + ci] * u;
        if (t == jh) { C.out[O_CS + (size_t)(s * 3 + 0) * W_LRU + ci] = s1; C.out[O_CS + (size_t)(s * 3 + 1) * W_LRU + ci] = s2; C.out[O_CS + (size_t)(s * 3 + 2) * W_LRU + ci] = u; } }
    LDS_WAIT(); asm volatile("" ::: "memory");
    const int j = jh * 64 + C.lane, cj = hd * HDIM + j;
    float accr = 0.f, acci = 0.f;
#pragma unroll 8
    for (int i = 0; i < HDIM; ++i) { const float uv = ucl[i]; const size_t wi = (size_t)(hd * HDIM + i) * HDIM + j; accr += uv * C.w_rga[wi]; acci += uv * C.w_rgx[wi]; }
    const float lm = C.lam[cj];
    const float sp8 = 8.0f * (fmaxf(-lm, 0.f) + log1pf(expf(-fabsf(lm))));
    const float rr = sigm(accr + C.b_rga[cj]), ii = sigm(acci + C.b_rgx[cj]);
    const float la = -sp8 * rr, a = __expf(la), mult = sqrtf(fmaxf(-expm1f(2.0f * la), 0.f));
    const float h = a * C.st_lru[(size_t)s * W_LRU + cj] + mult * ii * ucl[j];
    C.out[O_LS + (size_t)s * W_LRU + cj] = h;
    C.HS[row * W_LRU + cj] = (bf16)f2bf(h);
    LDS_WAIT(); asm volatile("" ::: "memory");
}
__device__ __forceinline__ void s5_sample_unit(const Ctx& C, int s, int g) {
    const size_t row = (size_t)(MP + s); const int p = C.lane, idx = g * NST + p;
    const v4u u0 = *(const v4u*)(C.P + row * NPROJ + W_LRU + g * GSZ), u1 = *(const v4u*)(C.P + row * NPROJ + W_LRU + g * GSZ + 8);
    float u[16] = {bflo(u0.x), bfhi(u0.x), bflo(u0.y), bfhi(u0.y), bflo(u0.z), bfhi(u0.z), bflo(u0.w), bfhi(u0.w), bflo(u1.x), bfhi(u1.x), bflo(u1.y), bfhi(u1.y), bflo(u1.z), bfhi(u1.z), bflo(u1.w), bfhi(u1.w)};
    float bur = 0.f, bui = 0.f;
#pragma unroll
    for (int k4 = 0; k4 < 4; ++k4) { const f32x4 br = *(const f32x4*)(C.bbr + (size_t)idx * 16 + 4 * k4), bi = *(const f32x4*)(C.bbi + (size_t)idx * 16 + 4 * k4);
#pragma unroll
        for (int i = 0; i < 4; ++i) { bur += br[i] * u[4 * k4 + i]; bui += bi[i] * u[4 * k4 + i]; } }
    const float ar = C.abr[idx], ai = C.abi[idx];
    const float h0r = C.st_re[(size_t)s * 4096 + idx], h0i = C.st_im[(size_t)s * 4096 + idx];
    const float hr = ar * h0r - ai * h0i + bur, hi = ar * h0i + ai * h0r + bui;
    C.out[O_RS + (size_t)s * 4096 + idx] = hr; C.out[O_IS + (size_t)s * 4096 + idx] = hi;
    float yk = 0.f;
#pragma unroll
    for (int k = 0; k < 16; ++k) { const float v = wave_sum(C.c_re[(size_t)(g * GSZ + k) * NST + p] * hr - C.c_im[(size_t)(g * GSZ + k) * NST + p] * hi); if (p == k) yk = v; }
    if (p < 16) { const int ch = g * GSZ + p; const float ul = bf2f(C.P[row * NPROJ + W_LRU + ch]);
        C.GY[row * W_SSM + ch] = (bf16)f2bf(gelu_tanh(yk + C.ssm_d[ch] * ul)); }
}

enum { PH_P0 = 0, PH_MOD, PH_H1, PH_G1, PH_SA, PH_SB, PH_SC, PH_G3, PH_G4, PH_G5, PH_H2, PH_G6, PH_G7, PH_FIN, N_PHASES };

__global__ void __launch_bounds__(NWAVES * 64, 2) hybrid_fwd(Args args) {
    extern __shared__ __attribute__((aligned(16))) unsigned char lds[];
    Ctx C;
    C.lds = (LAS unsigned char*)lds;
    C.tid = threadIdx.x; C.lane = C.tid & 63; C.wave = __builtin_amdgcn_readfirstlane(C.tid >> 6);
    C.G = gridDim.x; { const int bx = blockIdx.x; C.vcu = (C.G % 8 == 0) ? (bx % 8) * (C.G / 8) + bx / 8 : bx; }
    C.gw = C.vcu * NWAVES + C.wave; C.NGW = C.G * NWAVES;
    C.xp = (const float*)args.in[0]; C.xs = (const float*)args.in[1]; C.st_conv = (const float*)args.in[2]; C.st_lru = (const float*)args.in[3]; C.st_re = (const float*)args.in[4]; C.st_im = (const float*)args.in[5];
    C.c_p = (const float*)args.in[6]; C.c_s = (const float*)args.in[7]; C.w_ada = (const float*)args.in[8]; C.b_ada = (const float*)args.in[9]; C.g1 = (const float*)args.in[10]; C.g2 = (const float*)args.in[11];
    C.w_in = (const float*)args.in[12]; C.conv_w = (const float*)args.in[13]; C.conv_b = (const float*)args.in[14]; C.w_rga = (const float*)args.in[15]; C.b_rga = (const float*)args.in[16]; C.w_rgx = (const float*)args.in[17];
    C.b_rgx = (const float*)args.in[18]; C.lam = (const float*)args.in[19]; C.w_pa = (const float*)args.in[20]; C.a_re = (const float*)args.in[21]; C.a_im = (const float*)args.in[22]; C.log_dt = (const float*)args.in[23];
    C.b_re = (const float*)args.in[24]; C.b_im = (const float*)args.in[25]; C.c_re = (const float*)args.in[26]; C.c_im = (const float*)args.in[27]; C.ssm_d = (const float*)args.in[28]; C.w_glu = (const float*)args.in[29];
    C.w_out = (const float*)args.in[30]; C.w_up = (const float*)args.in[31]; C.w_dn = (const float*)args.in[32]; C.g_fin = (const float*)args.in[33];
    C.out = args.out; C.ws = args.ws;
    unsigned char* ws = args.ws;
    C.modt = (float*)(ws + WS_MOD); C.silu = (bf16*)(ws + WS_TAB + TB_SILU);
    C.abr = (float*)(ws + WS_TAB + TB_ABR); C.abi = (float*)(ws + WS_TAB + TB_ABI); C.bbr = (float*)(ws + WS_TAB + TB_BBR); C.bbi = (float*)(ws + WS_TAB + TB_BBI);
    C.ssr = (float*)(ws + WS_TAB + TB_SSR); C.ssi = (float*)(ws + WS_TAB + TB_SSI); C.lra = (float*)(ws + WS_TAB + TB_LRA); C.lre = (float*)(ws + WS_TAB + TB_LRE);
    C.Win = (bf16*)(ws + WS_WIN); C.Wpa = (bf16*)(ws + WS_WPA); C.Wglu = (bf16*)(ws + WS_WGLU); C.Wout = (bf16*)(ws + WS_WOUT); C.Wup = (bf16*)(ws + WS_WUP); C.Wdn = (bf16*)(ws + WS_WDN);
    C.A = (bf16*)(ws + WS_A); C.P = (bf16*)(ws + WS_PROJ); C.HS = (bf16*)(ws + WS_HSEQ); C.GY = (bf16*)(ws + WS_GY); C.T = (bf16*)(ws + WS_T); C.UC = (bf16*)(ws + WS_UCONV); C.ACT = (bf16*)(ws + WS_ACT);

#if MK_ONE_LAUNCH
    for (int u = C.tid; u < (LDS_BYTES - LDSCTL_OFF) / 4; u += NWAVES * 64) ((LAS unsigned*)(C.lds + LDSCTL_OFF))[u] = 0u;
    __syncthreads();
    XcdBarrier bar = xcd_barrier_post((unsigned*)(ws + WS_CTL) + CW_BAR, (volatile LAS unsigned*)(C.lds + MISC_OFF) + 8);
#define GRID_BAR() xcd_barrier(bar)
#else
#define GRID_BAR() do {} while (0)
#endif
    const int lo = args.ph_lo, hi = args.ph_hi;
#define IN(k) (lo <= (k) && (k) < hi)
#define SEAM(k) do { if (IN(k) && IN((k) + 1)) GRID_BAR(); } while (0)
    LAS unsigned char* wl = C.lds + C.wave * 16384;

    if (IN(PH_P0)) { p0_phase(C); } SEAM(PH_P0);
    if (IN(PH_MOD)) { mod_phase(C); } SEAM(PH_MOD);
    if (IN(PH_H1)) { norm_mod_phase(C, C.xp, C.xs, C.g1, 0, 2048, C.A); } SEAM(PH_H1);
    if (IN(PH_G1)) {
        pg8::Gemm g{C.A, C.Win, MPAD, NPROJ, D_MODEL}; pg8::StaticOrder S; S.init(MPAD, NPROJ, C.G, (int)blockIdx.x);
        pg8::EpiProj E{C.P};
        pg8::gemm_phase<pg8::EpiProj, pg8::StaticOrder, PG8_ALIGN, PG8_SP2>(C.lds, g, S, E);
    } SEAM(PH_G1);
    if (IN(PH_SA)) {
        conv_phase(C);
        for (int u = C.gw; u < NGRP * 32; u += C.NGW) s5_unit<false>(C, u & 63, u >> 6, wl);
    } SEAM(PH_SA);
    if (IN(PH_SB)) {
        for (int u = C.gw; u < NGRP * 32; u += C.NGW) s5_unit<true>(C, u & 63, u >> 6, wl);
        for (int u = C.gw; u < NHEAD * 4 * 64; u += C.NGW) lru_unit<false>(C, (u >> 2) & 7, u & 3, u >> 5);
        for (int u = C.gw; u < MS * NHEAD * 2; u += C.NGW) lru_sample_unit(C, u >> 4, (u >> 1) & 7, u & 1, wl);
        for (int u = C.gw; u < MS * NGRP; u += C.NGW) s5_sample_unit(C, u >> 6, u & 63);
    } SEAM(PH_SB);
    if (IN(PH_SC)) {
        for (int u = C.gw; u < NHEAD * 4 * 64; u += C.NGW) lru_unit<true>(C, (u >> 2) & 7, u & 3, u >> 5);
    } SEAM(PH_SC);
    if (IN(PH_G3)) {
        pg8::Gemm g{C.HS, C.Wpa, MPAD, D_MODEL, W_LRU}; pg8::StaticOrder S; S.init(MPAD, D_MODEL, C.G, (int)blockIdx.x);
        pg8::EpiGateA E{C.T, C.P};
        pg8::gemm_phase<pg8::EpiGateA, pg8::StaticOrder, PG8_ALIGN, PG8_SP2>(C.lds, g, S, E);
    } SEAM(PH_G3);
    if (IN(PH_G4)) {
        pg8::Gemm g{C.GY, C.Wglu, MPAD, 2 * D_MODEL, W_SSM}; pg8::StaticOrder S; S.init(MPAD, 2 * D_MODEL, C.G, (int)blockIdx.x);
        pg8::EpiGlu E{C.A, C.T, C.P};
        pg8::gemm_phase<pg8::EpiGlu, pg8::StaticOrder, PG8_ALIGN, PG8_SP2>(C.lds, g, S, E);
    } SEAM(PH_G4);
    if (IN(PH_G5)) {
        pg8::Gemm g{C.A, C.Wout, MPAD, D_MODEL, D_MODEL}; pg8::StaticOrder S; S.init(MPAD, D_MODEL, C.G, (int)blockIdx.x);
        pg8::EpiRes E{C.xp, C.xs, C.out, C.modt, 2 * D_MODEL};
        pg8::gemm_phase<pg8::EpiRes, pg8::StaticOrder, PG8_ALIGN, PG8_SP2>(C.lds, g, S, E);
    } SEAM(PH_G5);
    if (IN(PH_H2)) { norm_mod_phase(C, C.out, C.out + (size_t)MP * D_MODEL, C.g2, 3 * D_MODEL, 4 * D_MODEL, C.A); } SEAM(PH_H2);
    if (IN(PH_G6)) {
        pg8::Gemm g{C.A, C.Wup, MPAD, D_FF, D_MODEL}; pg8::StaticOrder S; S.init(MPAD, D_FF, C.G, (int)blockIdx.x);
        pg8::EpiRelu2 E{C.ACT};
        pg8::gemm_phase<pg8::EpiRelu2, pg8::StaticOrder, PG8_ALIGN, PG8_SP2>(C.lds, g, S, E);
    } SEAM(PH_G6);
    if (IN(PH_G7)) {
        pg8::Gemm g{C.ACT, C.Wdn, MPAD, D_MODEL, D_FF}; pg8::StaticOrder S; S.init(MPAD, D_MODEL, C.G, (int)blockIdx.x);
        pg8::EpiRes E{C.out, C.out + (size_t)MP * D_MODEL, C.out, C.modt, 5 * D_MODEL};
        pg8::gemm_phase<pg8::EpiRes, pg8::StaticOrder, PG8_ALIGN, PG8_SP2>(C.lds, g, S, E);
    } SEAM(PH_G7);
    if (IN(PH_FIN)) { final_norm_phase(C); }
#undef IN
#undef SEAM
}

extern "C" void kernel_launch(void* const* d_in, const int* in_sizes, int n_in, void* d_out, int out_size, void* d_ws, size_t ws_size, hipStream_t stream) {
    static int grid = 0;
    if (grid == 0) {
        if (n_in != 34 || in_sizes[0] != MP * D_MODEL || (size_t)out_size != O_END || ws_size < WS_END) {
            fprintf(stderr, "kernel_launch: built for 34 inputs, out %zu floats, >= %zu bytes of workspace; got n_in %d, in0 %d, out %d, ws %zu; nothing launched\n", (size_t)O_END, (size_t)WS_END, n_in, n_in > 0 ? in_sizes[0] : -1, out_size, ws_size); grid = -1; return; }
        int dev = 0, cus = 0, per_cu = 0;
        if (hipGetDevice(&dev) != hipSuccess || hipDeviceGetAttribute(&cus, hipDeviceAttributeMultiprocessorCount, dev) != hipSuccess) { fprintf(stderr, "kernel_launch: device query failed\n"); grid = -1; return; }
        if (hipFuncSetAttribute((const void*)hybrid_fwd, hipFuncAttributeMaxDynamicSharedMemorySize, LDS_BYTES) != hipSuccess) { fprintf(stderr, "kernel_launch: hipFuncSetAttribute failed\n"); grid = -1; return; }
        if (hipOccupancyMaxActiveBlocksPerMultiprocessor(&per_cu, (const void*)hybrid_fwd, NWAVES * 64, LDS_BYTES) != hipSuccess || per_cu < 1) { fprintf(stderr, "kernel_launch: occupancy query says %d workgroups per CU\n", per_cu); per_cu = 1; }
        (void)hipGetLastError();
        grid = cus;
    }
    if (grid < 0) return;
    if (hipMemsetAsync((char*)d_ws + WS_CTL, 0, CTL_ZERO_BYTES, stream) != hipSuccess) { fprintf(stderr, "kernel_launch: memset failed\n"); return; }
    Args a{};
    for (int i = 0; i < 34; ++i) a.in[i] = d_in[i];
    a.out = (float*)d_out; a.ws = (unsigned char*)d_ws;
#if MK_ONE_LAUNCH
    a.ph_lo = 0; a.ph_hi = N_PHASES;
    hipLaunchKernelGGL(hybrid_fwd, dim3(grid), dim3(NWAVES * 64), LDS_BYTES, stream, a);
#else
    for (int p = 0; p < N_PHASES; ++p) { a.ph_lo = p; a.ph_hi = p + 1; hipLaunchKernelGGL(hybrid_fwd, dim3(grid), dim3(NWAVES * 64), LDS_BYTES, stream, a); }
#endif
    const hipError_t le = hipPeekAtLastError();
    if (le != hipSuccess) fprintf(stderr, "kernel_launch: launch failed: %s\n", hipGetErrorName(le));
}
```

```cpp
#include <hip/hip_runtime.h>
#include <cstdio>
#include <cstdint>
namespace pg8 {
#define PG8_LAS __attribute__((address_space(3)))
typedef unsigned short bf16_t;
typedef short bf16x8 __attribute__((ext_vector_type(8)));
typedef float f32x4 __attribute__((ext_vector_type(4)));
typedef unsigned u32x4 __attribute__((ext_vector_type(4)));
constexpr int BM = 256, BK = 64, HALF = 128, HTB = HALF * BK * 2  , STAGE_BYTES = 8 * HTB, NXCD = 8, WGM = 8;

__host__ __device__ __forceinline__ int lds_byte(int r, int c) { const int st = (r >> 4) * 2 + (c >> 5), rr = r & 15, cc = c & 31, ob = rr * 64 + cc * 2; return st * 1024 + (ob ^ (((ob >> 9) & 1) << 5)); }
__host__ __device__ __forceinline__ void stage_rc(int b, int& R, int& C) { const int st = b / 1024, sb = b % 1024, swz = sb ^ (((sb >> 9) & 1) << 5); R = (st >> 1) * 16 + swz / 64; C = (st & 1) * 32 + (swz % 64) / 2; }
__host__ __device__ __forceinline__ int perm32(int rho) { const int n = rho >> 4, i = rho & 15; return 8 * (i >> 2) + 4 * n + (i & 3); }

struct Unit { int pm, pn; };
struct Gemm { const bf16_t* A; const bf16_t* Bt; int M, N, K; };

struct StaticOrder {
    int nM, nN, nwg, G, c;
    __host__ __device__ void init(int M, int N, int G_, int c_) { nM = M / BM; nN = N / BM; nwg = nM * nN; G = G_; c = c_; }
    __host__ __device__ bool next(int i, Unit& u) const {
        const long L = (long)i * G + c; if (L >= nwg) return false;
        int wgid = (int)L; { const int q = nwg / NXCD, r = nwg % NXCD, xcd = wgid % NXCD, off = wgid / NXCD; wgid = (xcd < r ? xcd * (q + 1) : r * (q + 1) + (xcd - r) * q) + off; }
        const int nig = WGM * nN, gid = wgid / nig, fm = gid * WGM, gsz = (nM - fm) < WGM ? (nM - fm) : WGM;
        u.pm = fm + ((wgid % nig) % gsz); u.pn = (wgid % nig) / gsz; return true;
    }
    __device__ __forceinline__ void a_ready(const Unit&) const {}
    __device__ __forceinline__ void done(const Unit&) const {}
};

__device__ __forceinline__ unsigned cvt_pk_bf16(float lo, float hi) { unsigned r; asm volatile("v_cvt_pk_bf16_f32 %0, %1, %2" : "=v"(r) : "v"(lo), "v"(hi)); return r; }
constexpr int D_MODEL = 2048, MP = 8192  , MS = 128  , MR = MP + MS  , MODN = 6 * D_MODEL, NPROJ = 6144, D_FF = 8192;
__device__ __forceinline__ float bflo(unsigned w) { return __uint_as_float(w << 16); }
__device__ __forceinline__ float bfhi(unsigned w) { return __uint_as_float(w & 0xffff0000u); }
__device__ __forceinline__ float sigm(float x) { return __builtin_amdgcn_rcpf(1.0f + __builtin_amdgcn_exp2f(-1.44269504f * x)); }
__device__ __forceinline__ int mod_row(int row) { int r = row < MP ? (row >> 11) : (4 + row - MP); return r > 143 ? 143 : r; }

struct EpiProj {
    static constexpr bool PERM = true, AFTER_DRAIN = false;
    bf16_t* O;
    __device__ __forceinline__ void operator()(const f32x4 (&acc)[2][2][4][2], const Unit& u, int wr, int wc, int fr, int fq) const {
        const int row0 = u.pm * BM + wr * 64 + fr, col0 = u.pn * BM + wc * 32 + 8 * fq; const bool sg = u.pn >= 8;
#pragma unroll
        for (int ai = 0; ai < 2; ++ai)
#pragma unroll
            for (int m = 0; m < 4; ++m) { bf16_t* rowp = O + (size_t)(row0 + ai * HALF + m * 16) * NPROJ + col0;
#pragma unroll
                for (int bj = 0; bj < 2; ++bj) { f32x4 v0 = acc[ai][bj][m][0], v1 = acc[ai][bj][m][1];
                    if (sg) {
#pragma unroll
                        for (int i = 0; i < 4; ++i) { v0[i] = sigm(v0[i]); v1[i] = sigm(v1[i]); } }
                    u32x4 w; w.x = cvt_pk_bf16(v0[0], v0[1]); w.y = cvt_pk_bf16(v0[2], v0[3]); w.z = cvt_pk_bf16(v1[0], v1[1]); w.w = cvt_pk_bf16(v1[2], v1[3]);
                    *(u32x4*)(rowp + bj * HALF) = w; } }
    }
};
struct EpiGateA {
    static constexpr bool PERM = true, AFTER_DRAIN = false;
    bf16_t* T; const bf16_t* P;
    __device__ __forceinline__ void operator()(const f32x4 (&acc)[2][2][4][2], const Unit& u, int wr, int wc, int fr, int fq) const {
        const int row0 = u.pm * BM + wr * 64 + fr, col0 = u.pn * BM + wc * 32 + 8 * fq;
#pragma unroll
        for (int ai = 0; ai < 2; ++ai)
#pragma unroll
            for (int m = 0; m < 4; ++m) { const size_t row = (size_t)(row0 + ai * HALF + m * 16);
#pragma unroll
                for (int bj = 0; bj < 2; ++bj) { const int col = col0 + bj * HALF;
                    const u32x4 g = *(const u32x4*)(P + row * NPROJ + 2048 + col);
                    f32x4 v0 = acc[ai][bj][m][0], v1 = acc[ai][bj][m][1];
                    v0[0] *= bflo(g.x); v0[1] *= bfhi(g.x); v0[2] *= bflo(g.y); v0[3] *= bfhi(g.y); v1[0] *= bflo(g.z); v1[1] *= bfhi(g.z); v1[2] *= bflo(g.w); v1[3] *= bfhi(g.w);
                    u32x4 w; w.x = cvt_pk_bf16(v0[0], v0[1]); w.y = cvt_pk_bf16(v0[2], v0[3]); w.z = cvt_pk_bf16(v1[0], v1[1]); w.w = cvt_pk_bf16(v1[2], v1[3]);
                    *(u32x4*)(T + row * D_MODEL + col) = w; } }
    }
};
struct EpiGlu {
    static constexpr bool PERM = true, AFTER_DRAIN = false;
    bf16_t* MG; const bf16_t* T; const bf16_t* P;
    __device__ __forceinline__ void operator()(const f32x4 (&acc)[2][2][4][2], const Unit& u, int wr, int wc, int fr, int fq) const {
        const int row0 = u.pm * BM + wr * 64 + fr, vcol = u.pn * HALF + wc * 32 + 8 * fq;
#pragma unroll
        for (int ai = 0; ai < 2; ++ai)
#pragma unroll
            for (int m = 0; m < 4; ++m) { const size_t row = (size_t)(row0 + ai * HALF + m * 16);
                const u32x4 t = *(const u32x4*)(T + row * D_MODEL + vcol);
                const u32x4 z = *(const u32x4*)(P + row * NPROJ + 4096 + vcol);
                const f32x4 a0 = acc[ai][0][m][0], a1 = acc[ai][0][m][1], g0 = acc[ai][1][m][0], g1 = acc[ai][1][m][1];
                float o[8];
                o[0] = bflo(t.x) + bflo(z.x) * (a0[0] * sigm(g0[0])); o[1] = bfhi(t.x) + bfhi(z.x) * (a0[1] * sigm(g0[1]));
                o[2] = bflo(t.y) + bflo(z.y) * (a0[2] * sigm(g0[2])); o[3] = bfhi(t.y) + bfhi(z.y) * (a0[3] * sigm(g0[3]));
                o[4] = bflo(t.z) + bflo(z.z) * (a1[0] * sigm(g1[0])); o[5] = bfhi(t.z) + bfhi(z.z) * (a1[1] * sigm(g1[1]));
                o[6] = bflo(t.w) + bflo(z.w) * (a1[2] * sigm(g1[2])); o[7] = bfhi(t.w) + bfhi(z.w) * (a1[3] * sigm(g1[3]));
                u32x4 w; w.x = cvt_pk_bf16(o[0], o[1]); w.y = cvt_pk_bf16(o[2], o[3]); w.z = cvt_pk_bf16(o[4], o[5]); w.w = cvt_pk_bf16(o[6], o[7]);
                *(u32x4*)(MG + row * D_MODEL + vcol) = w; }
    }
};
struct EpiRes {
    static constexpr bool PERM = false, AFTER_DRAIN = false;
    const float* xp; const float* xs; float* out; const float* modt; int goff;
    __device__ __forceinline__ void operator()(const f32x4 (&acc)[2][2][4][2], const Unit& u, int wr, int wc, int fr, int fq) const {
        const int row0 = u.pm * BM + wr * 64 + fr, col0 = u.pn * BM + wc * 32 + 4 * fq;
#pragma unroll
        for (int ai = 0; ai < 2; ++ai)
#pragma unroll
            for (int m = 0; m < 4; ++m) { const int row = row0 + ai * HALF + m * 16;
                if (row < MR) {
                    const float* xr = row < MP ? xp + (size_t)row * D_MODEL : xs + (size_t)(row - MP) * D_MODEL;
                    const float* gr = modt + (size_t)mod_row(row) * MODN + goff;
                    float* orow = out + (size_t)row * D_MODEL;
#pragma unroll
                    for (int bj = 0; bj < 2; ++bj)
#pragma unroll
                        for (int n = 0; n < 2; ++n) { const int col = col0 + bj * HALF + n * 16;
                            const f32x4 g = *(const f32x4*)(gr + col); const f32x4 xv = *(const f32x4*)(xr + col);
                            *(f32x4*)(orow + col) = xv + g * acc[ai][bj][m][n]; } } }
    }
};
struct EpiRelu2 {
    static constexpr bool PERM = true, AFTER_DRAIN = false;
    bf16_t* O;
    __device__ __forceinline__ void operator()(const f32x4 (&acc)[2][2][4][2], const Unit& u, int wr, int wc, int fr, int fq) const {
        const int row0 = u.pm * BM + wr * 64 + fr, col0 = u.pn * BM + wc * 32 + 8 * fq;
#pragma unroll
        for (int ai = 0; ai < 2; ++ai)
#pragma unroll
            for (int m = 0; m < 4; ++m) { bf16_t* rowp = O + (size_t)(row0 + ai * HALF + m * 16) * D_FF + col0;
#pragma unroll
                for (int bj = 0; bj < 2; ++bj) { f32x4 v0 = acc[ai][bj][m][0], v1 = acc[ai][bj][m][1];
#pragma unroll
                    for (int i = 0; i < 4; ++i) { const float a = fmaxf(v0[i], 0.f), b = fmaxf(v1[i], 0.f); v0[i] = a * a; v1[i] = b * b; }
                    u32x4 w; w.x = cvt_pk_bf16(v0[0], v0[1]); w.y = cvt_pk_bf16(v0[2], v0[3]); w.z = cvt_pk_bf16(v1[0], v1[1]); w.w = cvt_pk_bf16(v1[2], v1[3]);
                    *(u32x4*)(rowp + bj * HALF) = w; } }
    }
};

template <class Epi, class Sched, bool ALIGN_EPI = false, bool SP2 = false>
__device__ __forceinline__ void gemm_phase(PG8_LAS unsigned char* lds, const Gemm g, const Sched& S, const Epi& E) {
    const int tid = threadIdx.x, wid = __builtin_amdgcn_readfirstlane(tid >> 6), lane = tid & 63, wr = wid >> 2, wc = wid & 3, fr = lane & 15, fq = lane >> 4;
    const int K = g.K, nt = K / BK;
    unsigned voffA[2], voffB[2];
#pragma unroll
    for (int i = 0; i < 2; ++i) { int R, C; stage_rc(tid * 16 + i * 8192, R, C); const int Rb = Epi::PERM ? ((R & ~31) + perm32(R & 31)) : R;
        voffA[i] = (unsigned)(R * K + C) * 2u; voffB[i] = (unsigned)(Rb * K + C) * 2u; }
    const size_t kstep = (size_t)(BK * 2);
    const size_t hstep = (size_t)HALF * K * 2;
    const size_t tstep = 2 * hstep;
    const unsigned ldsw = (unsigned)wid * 1024u;
    const int aoff = lds_byte(wr * 64 + fr, fq * 8), boff = lds_byte(wc * 32 + fr, fq * 8);
#define PG8_SA(b, h) (((b) * 2 + (h)) * HTB)
#define PG8_SB(b, h) ((4 + (b) * 2 + (h)) * HTB)
#define PG8_STAGE(bufoff, gbase, voff) do { _Pragma("unroll") for (int _i = 0; _i < 2; ++_i) \
        __builtin_amdgcn_global_load_lds((const unsigned*)((const char*)(gbase) + (voff)[_i]), (PG8_LAS unsigned*)(lds + (bufoff) + ldsw + _i * 8192), 16, 0, 0); } while (0)
#define PG8_LDA(dst, b, h) do { _Pragma("unroll") for (int m = 0; m < 4; ++m) _Pragma("unroll") for (int k = 0; k < 2; ++k) dst[m][k] = *(const PG8_LAS bf16x8*)(lds + PG8_SA(b, h) + aoff + m * 2048 + k * 1024); } while (0)
#define PG8_LDB(dst, b, h) do { _Pragma("unroll") for (int n = 0; n < 2; ++n) _Pragma("unroll") for (int k = 0; k < 2; ++k) dst[n][k] = *(const PG8_LAS bf16x8*)(lds + PG8_SB(b, h) + boff + n * 2048 + k * 1024); } while (0)
#define PG8_MMA(ai, bj, At, Bt) do { __builtin_amdgcn_s_setprio(1); _Pragma("unroll") for (int m = 0; m < 4; ++m) _Pragma("unroll") for (int n = 0; n < 2; ++n) _Pragma("unroll") for (int k = 0; k < 2; ++k) \
        acc[ai][bj][m][n] = __builtin_amdgcn_mfma_f32_16x16x32_bf16(Bt[n][k], At[m][k], acc[ai][bj][m][n], 0, 0, 0); __builtin_amdgcn_s_setprio(0); } while (0)
#define PG8_WAIT_V(n) asm volatile("s_waitcnt vmcnt(" #n ")" ::: "memory")
#define PG8_WAIT_L(n) asm volatile("s_waitcnt lgkmcnt(" #n ")" ::: "memory")
#define PG8_BAR __builtin_amdgcn_s_barrier()
#define PG8_SCHED __builtin_amdgcn_sched_barrier(0)
    Unit cur, nxt; int ui = 0;
    if (!S.next(0, cur)) return;
    f32x4 acc[2][2][4][2];
#pragma unroll
    for (int a = 0; a < 2; ++a)
#pragma unroll
        for (int b = 0; b < 2; ++b)
#pragma unroll
            for (int m = 0; m < 4; ++m)
#pragma unroll
                for (int n = 0; n < 2; ++n) acc[a][b][m][n] = (f32x4){0.f, 0.f, 0.f, 0.f};
    bf16x8 At[4][2], B0[2][2], B1[2][2];
    const char* cA = (const char*)g.A + (size_t)cur.pm * tstep; const char* cB = (const char*)g.Bt + (size_t)cur.pn * tstep;
    S.a_ready(cur);
    if constexpr (SP2) {
        PG8_STAGE(PG8_SB(0, 0), cB, voffB); PG8_STAGE(PG8_SB(0, 1), cB + hstep, voffB); PG8_STAGE(PG8_SA(0, 0), cA, voffA); PG8_STAGE(PG8_SA(0, 1), cA + hstep, voffA);
        if (wr == 1) PG8_BAR;
        PG8_WAIT_V(2); PG8_BAR;
        PG8_STAGE(PG8_SB(1, 0), cB + kstep, voffB); PG8_STAGE(PG8_SA(1, 0), cA + kstep, voffA); PG8_STAGE(PG8_SB(1, 1), cB + hstep + kstep, voffB);
        PG8_WAIT_V(6); PG8_BAR;
    } else {
        PG8_STAGE(PG8_SB(0, 0), cB, voffB); PG8_STAGE(PG8_SA(0, 0), cA, voffA); PG8_STAGE(PG8_SB(0, 1), cB + hstep, voffB); PG8_STAGE(PG8_SA(0, 1), cA + hstep, voffA);
        if (wr == 1) PG8_BAR;
        PG8_WAIT_V(4); PG8_BAR;
        PG8_STAGE(PG8_SB(1, 0), cB + kstep, voffB); PG8_STAGE(PG8_SA(1, 0), cA + kstep, voffA); PG8_STAGE(PG8_SB(1, 1), cB + hstep + kstep, voffB);
        PG8_WAIT_V(6); PG8_BAR;
    }
    for (;;) {
        const bool has_next = S.next(ui + 1, nxt);
        const char* nA = has_next ? (const char*)g.A + (size_t)nxt.pm * tstep : cA; const char* nB = has_next ? (const char*)g.Bt + (size_t)nxt.pn * tstep : cB;
        for (int t = 0; t < nt; t += 2) {
            const bool last = (t == nt - 2);
            const char* a1 = cA + (size_t)(t + 1) * kstep;
            const char* a2 = last ? nA : cA + (size_t)(t + 2) * kstep; const char* b2 = last ? nB : cB + (size_t)(t + 2) * kstep;
            const char* a3 = a2 + kstep; const char* b3 = b2 + kstep;
            if (last && has_next) S.a_ready(nxt);
            if constexpr (SP2) {
            PG8_LDB(B0, 0, 0); PG8_LDB(B1, 0, 1); PG8_SCHED; PG8_LDA(At, 0, 0); PG8_STAGE(PG8_SA(1, 1), a1 + hstep, voffA);
            PG8_WAIT_V(8); PG8_WAIT_L(0); PG8_BAR; PG8_MMA(0, 0, At, B0); PG8_MMA(0, 1, At, B1); PG8_BAR; PG8_SCHED;
            PG8_LDA(At, 0, 1); PG8_STAGE(PG8_SB(0, 0), b2, voffB); PG8_STAGE(PG8_SB(0, 1), b2 + hstep, voffB); PG8_STAGE(PG8_SA(0, 0), a2, voffA);
            PG8_WAIT_V(8); PG8_WAIT_L(0); PG8_BAR; PG8_MMA(1, 0, At, B0); PG8_MMA(1, 1, At, B1); PG8_BAR; PG8_SCHED;
            PG8_LDB(B0, 1, 0); PG8_LDB(B1, 1, 1); PG8_SCHED; PG8_LDA(At, 1, 0); PG8_STAGE(PG8_SA(0, 1), a2 + hstep, voffA);
            PG8_WAIT_V(8); PG8_WAIT_L(0); PG8_BAR; PG8_MMA(0, 0, At, B0); PG8_MMA(0, 1, At, B1); PG8_BAR; PG8_SCHED;
            PG8_LDA(At, 1, 1); PG8_STAGE(PG8_SB(1, 0), b3, voffB); PG8_STAGE(PG8_SB(1, 1), b3 + hstep, voffB); PG8_STAGE(PG8_SA(1, 0), a3, voffA);
            PG8_WAIT_V(8); PG8_WAIT_L(0); PG8_BAR; PG8_MMA(1, 0, At, B0); PG8_MMA(1, 1, At, B1); PG8_BAR; PG8_SCHED;
            } else {
            PG8_LDB(B0, 0, 0); PG8_SCHED; PG8_LDA(At, 0, 0); PG8_STAGE(PG8_SA(1, 1), a1 + hstep, voffA);
            PG8_WAIT_L(8); PG8_BAR; PG8_WAIT_L(0); PG8_MMA(0, 0, At, B0); PG8_BAR; PG8_SCHED;
            PG8_LDB(B1, 0, 1); PG8_STAGE(PG8_SB(0, 0), b2, voffB);
            PG8_BAR; PG8_WAIT_L(0); PG8_MMA(0, 1, At, B1); PG8_BAR;
            PG8_LDA(At, 0, 1); PG8_STAGE(PG8_SA(0, 0), a2, voffA);
            PG8_BAR; PG8_WAIT_L(0); PG8_MMA(1, 0, At, B0); PG8_BAR; PG8_SCHED;
            PG8_STAGE(PG8_SB(0, 1), b2 + hstep, voffB);
            PG8_WAIT_V(6); PG8_BAR; PG8_MMA(1, 1, At, B1); PG8_BAR;
            PG8_LDB(B0, 1, 0); PG8_SCHED; PG8_LDA(At, 1, 0); PG8_STAGE(PG8_SA(0, 1), a2 + hstep, voffA);
            PG8_WAIT_L(8); PG8_BAR; PG8_WAIT_L(0); PG8_MMA(0, 0, At, B0); PG8_BAR; PG8_SCHED;
            PG8_LDB(B1, 1, 1); PG8_STAGE(PG8_SB(1, 0), b3, voffB);
            PG8_BAR; PG8_WAIT_L(0); PG8_MMA(0, 1, At, B1); PG8_BAR;
            PG8_LDA(At, 1, 1); PG8_STAGE(PG8_SA(1, 0), a3, voffA);
            PG8_BAR; PG8_WAIT_L(0); PG8_MMA(1, 0, At, B0); PG8_BAR; PG8_SCHED;
            PG8_STAGE(PG8_SB(1, 1), b3 + hstep, voffB);
            PG8_WAIT_V(6); PG8_BAR; PG8_MMA(1, 1, At, B1); PG8_BAR;
            }
        }
        if constexpr (ALIGN_EPI) { if (wr == 0) PG8_BAR; }
        if constexpr (!Epi::AFTER_DRAIN) { E(acc, cur, wr, wc, fr, fq); S.done(cur); }
        if (!has_next) break;
#pragma unroll
        for (int a = 0; a < 2; ++a)
#pragma unroll
            for (int b = 0; b < 2; ++b)
#pragma unroll
                for (int m = 0; m < 4; ++m)
#pragma unroll
                    for (int n = 0; n < 2; ++n) acc[a][b][m][n] = (f32x4){0.f, 0.f, 0.f, 0.f};
        cur = nxt; cA = nA; cB = nB; ++ui;
        if constexpr (ALIGN_EPI) { if (wr == 1) PG8_BAR; }
    }
    PG8_WAIT_V(0);
    if constexpr (!ALIGN_EPI) { if (wr == 0) PG8_BAR; }
    PG8_BAR;
    if constexpr (Epi::AFTER_DRAIN) { E.fused(acc, cur, wr, wc, fr, fq, lds, wid, lane); S.done(cur); }
#undef PG8_SA
#undef PG8_SB
#undef PG8_STAGE
#undef PG8_LDA
#undef PG8_LDB
#undef PG8_MMA
#undef PG8_WAIT_V
#undef PG8_WAIT_L
#undef PG8_BAR
#undef PG8_SCHED
}
}
#ifndef PG8_SP2
#define PG8_SP2 true
#endif
#ifndef PG8_ALIGN
#define PG8_ALIGN true
#endif
#ifndef MK_ONE_LAUNCH
#define MK_ONE_LAUNCH 1
#endif

using pg8::D_MODEL; using pg8::MP; using pg8::MS; using pg8::MR; using pg8::MODN; using pg8::NPROJ; using pg8::D_FF;
constexpr int MPAD = 8448;
constexpr int SEQ = 2048, NB = 4, W_LRU = 1024, W_SSM = 1024, NHEAD = 8, HDIM = 128, NGRP = 64, NST = 64, GSZ = 16;
constexpr int S5_TC = 128, S5_NCH = SEQ / S5_TC;
constexpr int LR_TC = 64,  LR_NCH = SEQ / LR_TC;
constexpr float EPS = 1e-6f;
constexpr size_t O_YP = 0, O_YS = 16777216, O_CP = 17039360, O_LP = 17051648, O_RP = 17055744, O_IP = 17072128, O_CS = 17088512, O_LS = 17481728, O_RS = 17612800, O_IS = 18137088, O_END = 18661376;

constexpr size_t MiB = 1u << 20;
constexpr size_t WS_CTL = 0, CTL_ZERO_BYTES = 1 * MiB;
constexpr size_t WS_MOD = 1 * MiB;
constexpr size_t WS_TAB = 8 * MiB;
constexpr size_t TB_SILU = 0;
constexpr size_t TB_ABR = 1 * MiB, TB_ABI = TB_ABR + 16384;
constexpr size_t TB_BBR = TB_ABI + 16384, TB_BBI = TB_BBR + 262144;
constexpr size_t TB_SSR = 2 * MiB, TB_SSI = 3 * MiB;
constexpr size_t TB_LRA = 4 * MiB, TB_LRE = 4 * MiB + 524288;
constexpr size_t WS_WIN = 16 * MiB, WS_WPA = 40 * MiB, WS_WGLU = 44 * MiB, WS_WOUT = 52 * MiB, WS_WUP = 60 * MiB, WS_WDN = 92 * MiB;
constexpr size_t WS_A = 124 * MiB;
constexpr size_t WS_PROJ = 157 * MiB;
constexpr size_t WS_HSEQ = 256 * MiB, WS_GY = 273 * MiB;
constexpr size_t WS_T = 290 * MiB, WS_UCONV = WS_T;
constexpr size_t WS_ACT = 157 * MiB;
constexpr size_t WS_END = 323 * MiB;
static_assert(WS_ACT + (size_t)MPAD * D_FF * 2 <= WS_T && WS_T + (size_t)MPAD * D_MODEL * 2 <= WS_END && WS_PROJ + (size_t)MPAD * NPROJ * 2 <= WS_HSEQ, "d_ws map");
constexpr int CW_BAR = 4096;

constexpr int RING_BYTES = 131072, LDSCTL_OFF = RING_BYTES, MISC_OFF = LDSCTL_OFF + 320, LDS_BYTES = 147456;
constexpr int NWAVES = 8;

#define GAS __attribute__((address_space(1)))
#define LAS __attribute__((address_space(3)))
typedef unsigned short bf16;
typedef unsigned v4u __attribute__((ext_vector_type(4)));
typedef unsigned v2u __attribute__((ext_vector_type(2)));
typedef float f32x4 __attribute__((ext_vector_type(4)));
typedef float f32x16 __attribute__((ext_vector_type(16)));
typedef short bf16x8 __attribute__((ext_vector_type(8)));
typedef GAS unsigned gu32;
#define RLX_AGENT __ATOMIC_RELAXED, __HIP_MEMORY_SCOPE_AGENT
#define LDS_WAIT() asm volatile("s_waitcnt lgkmcnt(0)" ::: "memory")
#define VM_WAIT() asm volatile("s_waitcnt vmcnt(0)" ::: "memory")
__device__ __forceinline__ unsigned f2bf(float f) { unsigned u = __builtin_bit_cast(unsigned, f); return (u + 0x7fffu + ((u >> 16) & 1u)) >> 16; }
__device__ __forceinline__ unsigned pk2(float lo, float hi) { return pg8::cvt_pk_bf16(lo, hi); }
__device__ __forceinline__ float bf2f(bf16 v) { return __uint_as_float((unsigned)v << 16); }
using pg8::bflo; using pg8::bfhi; using pg8::sigm;
__device__ __forceinline__ bf16x8 pack8(f32x4 a, f32x4 b) { v4u w; w.x = pk2(a[0], a[1]); w.y = pk2(a[2], a[3]); w.z = pk2(b[0], b[1]); w.w = pk2(b[2], b[3]); return __builtin_bit_cast(bf16x8, w); }
__device__ __forceinline__ float gelu_tanh(float v) {
    const float z = 0.7978845608f * (v + 0.044715f * v * v * v);
    const float t = __builtin_amdgcn_exp2f(2.885390082f * z);
    return v - v * __builtin_amdgcn_rcpf(1.0f + t);
}
__device__ __forceinline__ float wave_sum(float v) {
#pragma unroll
    for (int o = 1; o < 64; o <<= 1) v += __shfl_xor(v, o);
    return v;
}

#if MK_ONE_LAUNCH
#define XB_TMO      128
#define XB_XCNT(j)  (256  + 64 * (j))
#define XB_XSUB(j)  (1280 + 64 * (j))
#define XB_XGEN(j)  (2304 + 64 * (j))
#define XB_TOP      3328
#define XB_TOPGEN   3392
#define XCD_BAR_WORDS 3456
#define XB_SPIN_CAP (1u << 18)

__device__ __forceinline__ unsigned xb_ld(unsigned* p)              { return __hip_atomic_load(p, __ATOMIC_RELAXED, __HIP_MEMORY_SCOPE_AGENT); }
__device__ __forceinline__ unsigned xb_add(unsigned* p, unsigned v) { return __hip_atomic_fetch_add(p, v, __ATOMIC_RELAXED, __HIP_MEMORY_SCOPE_AGENT); }
__device__ __forceinline__ unsigned xb_xcc_id() { return (unsigned)__builtin_amdgcn_s_getreg((3 << 11) | 20) & 0xFu; }
#define XB_SPIN(cond, bar) do { unsigned _sp = 0; while (cond) { __builtin_amdgcn_s_sleep(1); \
    if ((++_sp & 255u) == 0u) { if (xb_ld(&(bar)[XB_TMO])) break; if (_sp > XB_SPIN_CAP) { atomicAdd(&(bar)[XB_TMO], 1u); break; } } } } while (0)

struct XcdBarrier {
    unsigned* bar; unsigned x;
    volatile LAS unsigned* st;
};

__device__ __forceinline__ XcdBarrier xcd_barrier_post(unsigned* bar, volatile LAS unsigned* st) {
    XcdBarrier b; b.bar = bar; b.x = xb_xcc_id(); b.st = st;
    if (threadIdx.x == 0) (void)xb_add(&bar[XB_XCNT(b.x)], 1u);
    return b;
}
__device__ __forceinline__ void xcd_barrier_complete(unsigned* bar, unsigned x, unsigned& nloc, unsigned& nx) {
    const unsigned G = gridDim.x * gridDim.y * gridDim.z;
    unsigned sum, cnt, mine, sp = 0u;
    for (;;) {
        sum = 0u; cnt = 0u; mine = 0u;
#pragma unroll
        for (unsigned j = 0; j < 16; ++j) { const unsigned c = xb_ld(&bar[XB_XCNT(j)]); sum += c; cnt += (c > 0u) ? 1u : 0u; mine = (j == x) ? c : mine; }
        if (sum == G) break;
        __builtin_amdgcn_s_sleep(1);
        if ((++sp & 255u) == 0u) { if (xb_ld(&bar[XB_TMO])) break; if (sp > XB_SPIN_CAP) { atomicAdd(&bar[XB_TMO], 1u); break; } }
    }
    nloc = mine > 0u ? mine : 1u; nx = cnt > 0u ? cnt : 1u;
}

__device__ __forceinline__ void xcd_barrier(const XcdBarrier& b) {
    asm volatile("s_waitcnt vmcnt(0)" ::: "memory");
    __syncthreads();
    if (threadIdx.x == 0) {
        unsigned* bar = b.bar;
        __builtin_amdgcn_s_waitcnt(0);
        unsigned nloc = b.st[0], nx = b.st[1];
        if (nloc == 0u) { xcd_barrier_complete(bar, b.x, nloc, nx); b.st[0] = nloc; b.st[1] = nx; }
        const unsigned old = xb_add(&bar[XB_XSUB(b.x)], 1u);
        const unsigned gen = old / nloc;
        if (old + 1u == (gen + 1u) * nloc) {
            __builtin_amdgcn_fence(__ATOMIC_RELEASE, "agent");
            asm volatile("s_waitcnt vmcnt(0)" ::: "memory");
            const unsigned og = xb_add(&bar[XB_TOP], 1u);
            const unsigned tg = og / nx;
            if (og + 1u == (tg + 1u) * nx) xb_add(&bar[XB_TOPGEN], 1u);
            else XB_SPIN(xb_ld(&bar[XB_TOPGEN]) == tg, bar);
            __builtin_amdgcn_fence(__ATOMIC_ACQUIRE, "agent");
            xb_add(&bar[XB_XGEN(b.x)], 1u);
            asm volatile("s_waitcnt vmcnt(0)" ::: "memory");
        } else {
            XB_SPIN(xb_ld(&bar[XB_XGEN(b.x)]) == gen, bar);
            __builtin_amdgcn_fence(__ATOMIC_ACQUIRE, "agent");
            asm volatile("s_waitcnt vmcnt(0)" ::: "memory");
        }
    }
    __syncthreads();
}

#endif

struct Args { const void* in[34]; float* out; unsigned char* ws; int ph_lo, ph_hi; };

struct Ctx {
    LAS unsigned char* lds; int tid, lane, wave, vcu, G, gw, NGW;
    const float *xp, *xs, *st_conv, *st_lru, *st_re, *st_im, *c_p, *c_s, *w_ada, *b_ada, *g1, *g2, *w_in, *conv_w, *conv_b, *w_rga, *b_rga, *w_rgx, *b_rgx, *lam, *w_pa;
    const float *a_re, *a_im, *log_dt, *b_re, *b_im, *c_re, *c_im, *ssm_d, *w_glu, *w_out, *w_up, *w_dn, *g_fin;
    float* out; unsigned char* ws;
    float* modt; bf16* silu; float *abr, *abi, *bbr, *bbi, *ssr, *ssi, *lra, *lre;
    bf16 *Win, *Wpa, *Wglu, *Wout, *Wup, *Wdn, *A, *P, *HS, *GY, *T, *UC, *ACT;
};

__device__ __forceinline__ void p0_transpose_item(const float* W, int K, int N, bf16* WT, int glu, LAS float* scr, int item, int lane) {
    const int nblk = N / 32, kb = item / nblk, nb = item % nblk, k0 = 64 * kb, n0 = 32 * nb;
#pragma unroll 8
    for (int i = 0; i < 32; ++i) { const int kk = 2 * i + (lane >> 5); scr[kk * 33 + (lane & 31)] = W[(size_t)(k0 + kk) * N + n0 + (lane & 31)]; }
    LDS_WAIT(); asm volatile("" ::: "memory");
    const int c = lane & 7;
    int d0 = n0; if (glu) d0 = n0 < 2048 ? ((n0 >> 7) * 256 + (n0 & 127)) : (((n0 - 2048) >> 7) * 256 + 128 + ((n0 - 2048) & 127));
#pragma unroll
    for (int j = 0; j < 4; ++j) { const int n = (lane >> 3) + 8 * j; const LAS float* s = scr + (8 * c) * 33 + n;
        v4u o; o.x = pk2(s[0 * 33], s[1 * 33]); o.y = pk2(s[2 * 33], s[3 * 33]); o.z = pk2(s[4 * 33], s[5 * 33]); o.w = pk2(s[6 * 33], s[7 * 33]);
        *(v4u*)(WT + (size_t)(d0 + n) * K + k0 + 8 * c) = o; }
    LDS_WAIT(); asm volatile("" ::: "memory");
}
__device__ __forceinline__ void p0_phase(const Ctx& C) {
    LAS float* scr = (LAS float*)(C.lds + C.wave * 16384);
    constexpr int I_IN = (2048 / 64) * (6144 / 32), I_PA = (1024 / 64) * (2048 / 32), I_GLU = (1024 / 64) * (4096 / 32), I_OUT = (2048 / 64) * (2048 / 32), I_UP = (2048 / 64) * (8192 / 32), I_DN = (8192 / 64) * (2048 / 32);
    constexpr int NIT = I_IN + I_PA + I_GLU + I_OUT + I_UP + I_DN;
    for (int it = C.gw; it < NIT; it += C.NGW) {
        int r = it;
        if (r < I_IN) { p0_transpose_item(C.w_in, 2048, 6144, C.Win, 0, scr, r, C.lane); continue; } r -= I_IN;
        if (r < I_PA) { p0_transpose_item(C.w_pa, 1024, 2048, C.Wpa, 0, scr, r, C.lane); continue; } r -= I_PA;
        if (r < I_GLU) { p0_transpose_item(C.w_glu, 1024, 4096, C.Wglu, 1, scr, r, C.lane); continue; } r -= I_GLU;
        if (r < I_OUT) { p0_transpose_item(C.w_out, 2048, 2048, C.Wout, 0, scr, r, C.lane); continue; } r -= I_OUT;
        if (r < I_UP) { p0_transpose_item(C.w_up, 2048, 8192, C.Wup, 0, scr, r, C.lane); continue; } r -= I_UP;
        p0_transpose_item(C.w_dn, 8192, 2048, C.Wdn, 0, scr, r, C.lane);
    }
    for (int r = C.gw; r < 144; r += C.NGW) {
        const float* src = r < 4 ? C.c_p + (size_t)r * D_MODEL : C.c_s + (size_t)(r < 132 ? r - 4 : 0) * D_MODEL;
#pragma unroll
        for (int j = 0; j < 4; ++j) { const int idx = j * 512 + C.lane * 8;
            f32x4 a = *(const f32x4*)(src + idx), b = *(const f32x4*)(src + idx + 4);
#pragma unroll
            for (int i = 0; i < 4; ++i) { a[i] = a[i] * sigm(a[i]); b[i] = b[i] * sigm(b[i]); }
            if (r >= 132) { a = (f32x4){0.f, 0.f, 0.f, 0.f}; b = a; }
            v4u o; o.x = pk2(a[0], a[1]); o.y = pk2(a[2], a[3]); o.z = pk2(b[0], b[1]); o.w = pk2(b[2], b[3]);
            *(v4u*)(C.silu + (size_t)r * D_MODEL + idx) = o; }
    }
    for (int g = C.gw; g < NGRP; g += C.NGW) {
        const int idx = g * NST + C.lane;
        const float ar = C.a_re[idx], ai = C.a_im[idx], dt = expf(C.log_dt[g]);
        const float mag = expf(dt * ar), ang = dt * ai;
        float sn, cs; sincosf(ang, &sn, &cs);
        const float abr = mag * cs, abi = mag * sn;
        const float den = ar * ar + ai * ai, nr = abr - 1.0f, ni = abi;
        const float qre = (nr * ar + ni * ai) / den, qim = (ni * ar - nr * ai) / den;
        C.abr[idx] = abr; C.abi[idx] = abi;
#pragma unroll
        for (int k4 = 0; k4 < 4; ++k4) { const f32x4 br = *(const f32x4*)(C.b_re + (size_t)idx * 16 + 4 * k4), bi = *(const f32x4*)(C.b_im + (size_t)idx * 16 + 4 * k4);
            *(f32x4*)(C.bbr + (size_t)idx * 16 + 4 * k4) = qre * br - qim * bi; *(f32x4*)(C.bbi + (size_t)idx * 16 + 4 * k4) = qre * bi + qim * br; }
    }
}

__device__ __forceinline__ void mod_phase(const Ctx& C) {
    const int n = C.lane & 15, kg = C.lane >> 4;
    LAS float* part = (LAS float*)C.lds;
    for (int u = blockIdx.x; u < MODN / 16; u += C.G) {
        const int n0 = u * 16;
        const float* Wp = C.w_ada + (size_t)(256 * C.wave + 8 * kg) * MODN + n0 + n;
        const bf16* Ap = C.silu + (size_t)n * D_MODEL + 256 * C.wave + 8 * kg;
        f32x4 acc[9];
#pragma unroll
        for (int i = 0; i < 9; ++i) acc[i] = (f32x4){0.f, 0.f, 0.f, 0.f};
        float w[8][8];
#pragma unroll
        for (int ks = 0; ks < 8; ++ks)
#pragma unroll
            for (int j = 0; j < 8; ++j) w[ks][j] = Wp[(size_t)(ks * 32 + j) * MODN];
#pragma unroll
        for (int ks = 0; ks < 8; ++ks) {
            const bf16x8 bfr = pack8((f32x4){w[ks][0], w[ks][1], w[ks][2], w[ks][3]}, (f32x4){w[ks][4], w[ks][5], w[ks][6], w[ks][7]});
#pragma unroll
            for (int mf = 0; mf < 9; ++mf) { const bf16x8 a = *(const bf16x8*)(Ap + (size_t)mf * 16 * D_MODEL + ks * 32);
                acc[mf] = __builtin_amdgcn_mfma_f32_16x16x32_bf16(a, bfr, acc[mf], 0, 0, 0); }
        }
#pragma unroll
        for (int mf = 0; mf < 9; ++mf)
#pragma unroll
            for (int r = 0; r < 4; ++r) part[((C.wave * 9 + mf) * 4 + r) * 64 + C.lane] = acc[mf][r];
        __syncthreads();
        for (int e = C.tid; e < 9 * 4 * 64; e += NWAVES * 64) {
            float s = 0.f;
#pragma unroll
            for (int wv = 0; wv < 8; ++wv) s += part[wv * 2304 + e];
            const int mf = e >> 8, r = (e >> 6) & 3, l64 = e & 63, row = mf * 16 + 4 * (l64 >> 4) + r, col = n0 + (l64 & 15);
            C.modt[(size_t)row * MODN + col] = s + C.b_ada[col];
        }
        __syncthreads();
    }
}

__device__ __forceinline__ void norm_mod_phase(const Ctx& C, const float* xp, const float* xs, const float* g, int sh_off, int sc_off, bf16* O) {
    for (int row = C.gw; row < MR; row += C.NGW) {
        const float* xr = row < MP ? xp + (size_t)row * D_MODEL : xs + (size_t)(row - MP) * D_MODEL;
        const float* mr = C.modt + (size_t)pg8::mod_row(row) * MODN;
        f32x4 v[8]; float ss = 0.f;
#pragma unroll
        for (int j = 0; j < 8; ++j) { v[j] = *(const f32x4*)(xr + 256 * j + 4 * C.lane); ss += (v[j][0] * v[j][0] + v[j][1] * v[j][1]) + (v[j][2] * v[j][2] + v[j][3] * v[j][3]); }
        const float rstd = 1.0f / sqrtf(wave_sum(ss) * (1.0f / D_MODEL) + EPS);
#pragma unroll
        for (int j = 0; j < 8; ++j) { const int col = 256 * j + 4 * C.lane;
            const f32x4 gg = *(const f32x4*)(g + col), sc = *(const f32x4*)(mr + sc_off + col), sh = *(const f32x4*)(mr + sh_off + col);
            const f32x4 o = v[j] * rstd * gg * (1.0f + sc) + sh;
            v2u w; w.x = pk2(o[0], o[1]); w.y = pk2(o[2], o[3]);
            *(v2u*)(O + (size_t)row * D_MODEL + col) = w; }
    }
}
__device__ __forceinline__ void final_norm_phase(const Ctx& C) {
    for (int row = C.gw; row < MR; row += C.NGW) {
        float* xr = C.out + (size_t)row * D_MODEL;
        f32x4 v[8]; float ss = 0.f;
#pragma unroll
        for (int j = 0; j < 8; ++j) { v[j] = *(const f32x4*)(xr + 256 * j + 4 * C.lane); ss += (v[j][0] * v[j][0] + v[j][1] * v[j][1]) + (v[j][2] * v[j][2] + v[j][3] * v[j][3]); }
        const float rstd = 1.0f / sqrtf(wave_sum(ss) * (1.0f / D_MODEL) + EPS);
#pragma unroll
        for (int j = 0; j < 8; ++j) { const int col = 256 * j + 4 * C.lane; *(f32x4*)(xr + col) = v[j] * rstd * *(const f32x4*)(C.g_fin + col); }
    }
}

__device__ __forceinline__ f32x16 zero16() { return f32x16{}; }

__device__ __forceinline__ void conv_phase(const Ctx& C) {
    const int nthr = C.G * NWAVES * 64;
    for (int idx = C.vcu * (NWAVES * 64) + C.tid; idx < MP * 128; idx += nthr) {
        const int row = idx >> 7, c0 = (idx & 127) * 8, t = row & (SEQ - 1);
        f32x4 a0 = *(const f32x4*)(C.conv_b + c0), a1 = *(const f32x4*)(C.conv_b + c0 + 4);
#pragma unroll
        for (int d = 0; d < 4; ++d) {
            if (t - d >= 0) {
                const v4u u = *(const v4u*)(C.P + (size_t)(row - d) * NPROJ + c0);
                const f32x4 w0 = *(const f32x4*)(C.conv_w + (3 - d) * W_LRU + c0), w1 = *(const f32x4*)(C.conv_w + (3 - d) * W_LRU + c0 + 4);
                a0[0] += w0[0] * bflo(u.x); a0[1] += w0[1] * bfhi(u.x); a0[2] += w0[2] * bflo(u.y); a0[3] += w0[3] * bfhi(u.y);
                a1[0] += w1[0] * bflo(u.z); a1[1] += w1[1] * bfhi(u.z); a1[2] += w1[2] * bflo(u.w); a1[3] += w1[3] * bfhi(u.w);
            }
        }
        v4u o; o.x = pk2(a0[0], a0[1]); o.y = pk2(a0[2], a0[3]); o.z = pk2(a1[0], a1[1]); o.w = pk2(a1[2], a1[3]);
        *(v4u*)(C.UC + (size_t)row * W_LRU + c0) = o;
    }
    for (int idx = C.vcu * (NWAVES * 64) + C.tid; idx < NB * 3 * W_LRU; idx += nthr) {
        const int ch = idx & (W_LRU - 1), k = (idx >> 10) % 3, b = idx / (3 * W_LRU);
        C.out[O_CP + idx] = bf2f(C.P[(size_t)(b * SEQ + SEQ - 3 + k) * NPROJ + ch]);
    }
}

template <bool APPLY>
__device__ __forceinline__ void s5_unit(const Ctx& C, int g, int q, LAS unsigned char* wl) {
    const int lane = C.lane, c31 = lane & 31, kh = lane >> 5;
    const int asel = (c31 >> 2) & 1, atok = (c31 & 3) + 4 * (c31 >> 3);
    const int b = q >> 3, cX = 2 * (q & 7), myc = cX + kh;
    const int rowX = b * SEQ + cX * S5_TC;
    bf16x8 bb[2][2]; float ar[2], ai[2], hr[2], hi[2];
#pragma unroll
    for (int ph = 0; ph < 2; ++ph) { const int idx = g * NST + ph * 32 + c31;
        ar[ph] = C.abr[idx]; ai[ph] = C.abi[idx]; hr[ph] = 0.f; hi[ph] = 0.f;
        const f32x4* sr = (const f32x4*)(C.bbr + (size_t)idx * 16 + 8 * kh); const f32x4* si = (const f32x4*)(C.bbi + (size_t)idx * 16 + 8 * kh);
        bb[0][ph] = pack8(sr[0], sr[1]); bb[1][ph] = pack8(si[0], si[1]); }
    bf16x8 cb[8];
    float dsk = 0.f;
    if (APPLY) {
#pragma unroll
        for (int ph = 0; ph < 2; ++ph) { float pr = ar[ph], pi = ai[ph];
#pragma unroll
            for (int s = 0; s < 7; ++s) { const float nr = pr * pr - pi * pi, ni = 2.0f * pr * pi; pr = nr; pi = ni; }
            const size_t sidx = (size_t)g * NST + ph * 32 + c31; float Hr = 0.f, Hi = 0.f;
            for (int j = 0; j < S5_NCH - 1; ++j) { const float sr = C.ssr[(size_t)(b * S5_NCH + j) * 4096 + sidx], si = C.ssi[(size_t)(b * S5_NCH + j) * 4096 + sidx];
                const float nr = pr * Hr - pi * Hi + sr, ni = pr * Hi + pi * Hr + si; if (j < myc) { Hr = nr; Hi = ni; } }
            hr[ph] = Hr; hi[ph] = Hi; }
#pragma unroll
        for (int s = 0; s < 8; ++s) { f32x4 a = (f32x4){0.f, 0.f, 0.f, 0.f}, bq = a;
            if (c31 < 16) { const float* src = (s < 4 ? C.c_re : C.c_im) + (size_t)(g * GSZ + c31) * NST + 16 * (s & 3) + 8 * kh; a = *(const f32x4*)src; bq = *(const f32x4*)(src + 4); if (s >= 4) { a = -a; bq = -bq; } }
            cb[s] = pack8(a, bq); }
        dsk = C.ssm_d[g * GSZ + (c31 & 15)];
    }
    const bf16* arow = C.P + (size_t)(rowX + asel * S5_TC + atok) * NPROJ + W_LRU + g * GSZ + 8 * kh;
    LAS bf16* hl = (LAS bf16*)wl;
    for (int st = 0; st < S5_TC / 16; ++st) {
        const bf16x8 af = *(const bf16x8*)(arow + (size_t)st * 16 * NPROJ);
        const f32x16 z = zero16();
        f32x16 re0 = __builtin_amdgcn_mfma_f32_32x32x16_bf16(af, bb[0][0], z, 0, 0, 0), re1 = __builtin_amdgcn_mfma_f32_32x32x16_bf16(af, bb[0][1], z, 0, 0, 0);
        f32x16 im0 = __builtin_amdgcn_mfma_f32_32x32x16_bf16(af, bb[1][0], z, 0, 0, 0), im1 = __builtin_amdgcn_mfma_f32_32x32x16_bf16(af, bb[1][1], z, 0, 0, 0);
#pragma unroll
        for (int r = 0; r < 16; ++r) {
            { const float nr = ar[0] * hr[0] - ai[0] * hi[0] + re0[r], ni = ar[0] * hi[0] + ai[0] * hr[0] + im0[r]; hr[0] = nr; hi[0] = ni; re0[r] = nr; im0[r] = ni; }
            { const float nr = ar[1] * hr[1] - ai[1] * hi[1] + re1[r], ni = ar[1] * hi[1] + ai[1] * hr[1] + im1[r]; hr[1] = nr; hi[1] = ni; re1[r] = nr; im1[r] = ni; }
        }
        if (APPLY) {
#pragma unroll
            for (int r = 0; r < 16; ++r) { const int rho = (r & 3) + 4 * kh + 8 * (r >> 2);
                hl[rho * 136 + c31] = (bf16)f2bf(re0[r]); hl[rho * 136 + 32 + c31] = (bf16)f2bf(re1[r]);
                hl[rho * 136 + 64 + c31] = (bf16)f2bf(im0[r]); hl[rho * 136 + 96 + c31] = (bf16)f2bf(im1[r]); }
            f32x16 y = zero16();
#pragma unroll
            for (int s = 0; s < 8; ++s) { const bf16x8 hA = *(const LAS bf16x8*)(hl + c31 * 136 + 16 * s + 8 * kh); y = __builtin_amdgcn_mfma_f32_32x32x16_bf16(hA, cb[s], y, 0, 0, 0); }
            if (c31 < 16) { const int ch = g * GSZ + c31;
#pragma unroll
                for (int r = 0; r < 16; ++r) { const size_t trow = (size_t)(rowX + kh * S5_TC + st * 16 + r);
                    const float u = bf2f(C.P[trow * NPROJ + W_LRU + ch]);
                    C.GY[trow * W_SSM + ch] = (bf16)f2bf(gelu_tanh(y[r] + dsk * u)); } }
        }
    }
#pragma unroll
    for (int ph = 0; ph < 2; ++ph) { const size_t sidx = (size_t)g * NST + ph * 32 + c31;
        if (!APPLY) { C.ssr[(size_t)(b * S5_NCH + myc) * 4096 + sidx] = hr[ph]; C.ssi[(size_t)(b * S5_NCH + myc) * 4096 + sidx] = hi[ph]; }
        else if (myc == S5_NCH - 1) { C.out[O_RP + (size_t)b * 4096 + sidx] = hr[ph]; C.out[O_IP + (size_t)b * 4096 + sidx] = hi[ph]; } }
}

template <bool APPLY>
__device__ __forceinline__ void lru_unit(const Ctx& C, int hd, int jt, int q) {
    const int lane = C.lane, c31 = lane & 31, kh = lane >> 5;
    const int asel = (c31 >> 2) & 1, atok = (c31 & 3) + 4 * (c31 >> 3);
    const int b = q >> 4, cX = 2 * (q & 15), myc = cX + kh;
    const int rowX = b * SEQ + cX * LR_TC;
    const int ch = hd * HDIM + jt * 32 + c31;
    bf16x8 wa[8], wx[8];
#pragma unroll
    for (int s = 0; s < 8; ++s) { float ta[8], tx[8];
#pragma unroll
        for (int j = 0; j < 8; ++j) { const size_t wi = (size_t)(hd * HDIM + 16 * s + 8 * kh + j) * HDIM + jt * 32 + c31; ta[j] = C.w_rga[wi]; tx[j] = C.w_rgx[wi]; }
        wa[s] = pack8((f32x4){ta[0], ta[1], ta[2], ta[3]}, (f32x4){ta[4], ta[5], ta[6], ta[7]}); wx[s] = pack8((f32x4){tx[0], tx[1], tx[2], tx[3]}, (f32x4){tx[4], tx[5], tx[6], tx[7]}); }
    const float ba = C.b_rga[ch], bx = C.b_rgx[ch];
    const float lm = C.lam[ch];
    const float sp8 = 8.0f * (fmaxf(-lm, 0.f) + log1pf(expf(-fabsf(lm))));
    float h = 0.f, aprod = 1.f;
    if (APPLY) { float H = 0.f;
        for (int j = 0; j < LR_NCH - 1; ++j) { const float A = C.lra[(size_t)(b * LR_NCH + j) * W_LRU + ch], E = C.lre[(size_t)(b * LR_NCH + j) * W_LRU + ch]; const float nh = A * H + E; if (j < myc) H = nh; }
        h = H; }
    const bf16* arow = C.UC + (size_t)(rowX + asel * LR_TC + atok) * W_LRU + hd * HDIM + 8 * kh;
    for (int st = 0; st < LR_TC / 16; ++st) {
        f32x16 pr = zero16(), pi = zero16();
#pragma unroll
        for (int s = 0; s < 8; ++s) { const bf16x8 af = *(const bf16x8*)(arow + (size_t)st * 16 * W_LRU + 16 * s);
            pr = __builtin_amdgcn_mfma_f32_32x32x16_bf16(af, wa[s], pr, 0, 0, 0); pi = __builtin_amdgcn_mfma_f32_32x32x16_bf16(af, wx[s], pi, 0, 0, 0); }
#pragma unroll
        for (int r = 0; r < 16; ++r) { const size_t orow = (size_t)(rowX + kh * LR_TC + st * 16 + r);
            const float uc = bf2f(C.UC[orow * W_LRU + ch]);
            const float rr = sigm(pr[r] + ba), ii = sigm(pi[r] + bx);
            const float la = -sp8 * rr, a = __expf(la), mult = sqrtf(fmaxf(-expm1f(2.0f * la), 0.f));
            h = a * h + mult * ii * uc; aprod *= a;
            if (APPLY) C.HS[orow * W_LRU + ch] = (bf16)f2bf(h); }
    }
    if (!APPLY) { C.lra[(size_t)(b * LR_NCH + myc) * W_LRU + ch] = aprod; C.lre[(size_t)(b * LR_NCH + myc) * W_LRU + ch] = h; }
    else if (myc == LR_NCH - 1) C.out[O_LP + (size_t)b * W_LRU + ch] = h;
}

__device__ __forceinline__ void lru_sample_unit(const Ctx& C, int s, int hd, int jh, LAS unsigned char* wl) {
    LAS float* ucl = (LAS float*)wl;
    const size_t row = (size_t)(MP + s);
#pragma unroll
    for (int t = 0; t < 2; ++t) { const int i = C.lane + 64 * t, ci = hd * HDIM + i;
        const float u = bf2f(C.P[row * NPROJ + ci]);
        const float s0 = C.st_conv[(size_t)(s * 3 + 0) * W_LRU + ci], s1 = C.st_conv[(size_t)(s * 3 + 1) * W_LRU + ci], s2 = C.st_conv[(size_t)(s * 3 + 2) * W_LRU + ci];
        ucl[i] = C.conv_b[ci] + C.conv_w[ci] * s0 + C.conv_w[W_LRU + ci] * s1 + C.conv_w[2 * W_LRU + ci] * s2 + C.conv_w[3 * W_LRU + ci] * u;
        if (t == jh) { C.out[O_CS + (size_t)(s * 3 + 0) * W_LRU + ci] = s1; C.out[O_CS + (size_t)(s * 3 + 1) * W_LRU + ci] = s2; C.out[O_CS + (size_t)(s * 3 + 2) * W_LRU + ci] = u; } }
    LDS_WAIT(); asm volatile("" ::: "memory");
    const int j = jh * 64 + C.lane, cj = hd * HDIM + j;
    float accr = 0.f, acci = 0.f;
#pragma unroll 8
    for (int i = 0; i < HDIM; ++i) { const float uv = ucl[i]; const size_t wi = (size_t)(hd * HDIM + i) * HDIM + j; accr += uv * C.w_rga[wi]; acci += uv * C.w_rgx[wi]; }
    const float lm = C.lam[cj];
    const float sp8 = 8.0f * (fmaxf(-lm, 0.f) + log1pf(expf(-fabsf(lm))));
    const float rr = sigm(accr + C.b_rga[cj]), ii = sigm(acci + C.b_rgx[cj]);
    const float la = -sp8 * rr, a = __expf(la), mult = sqrtf(fmaxf(-expm1f(2.0f * la), 0.f));
    const float h = a * C.st_lru[(size_t)s * W_LRU + cj] + mult * ii * ucl[j];
    C.out[O_LS + (size_t)s * W_LRU + cj] = h;
    C.HS[row * W_LRU + cj] = (bf16)f2bf(h);
    LDS_WAIT(); asm volatile("" ::: "memory");
}
__device__ __forceinline__ void s5_sample_unit(const Ctx& C, int s, int g) {
    const size_t row = (size_t)(MP + s); const int p = C.lane, idx = g * NST + p;
    const v4u u0 = *(const v4u*)(C.P + row * NPROJ + W_LRU + g * GSZ), u1 = *(const v4u*)(C.P + row * NPROJ + W_LRU + g * GSZ + 8);
    float u[16] = {bflo(u0.x), bfhi(u0.x), bflo(u0.y), bfhi(u0.y), bflo(u0.z), bfhi(u0.z), bflo(u0.w), bfhi(u0.w), bflo(u1.x), bfhi(u1.x), bflo(u1.y), bfhi(u1.y), bflo(u1.z), bfhi(u1.z), bflo(u1.w), bfhi(u1.w)};
    float bur = 0.f, bui = 0.f;
#pragma unroll
    for (int k4 = 0; k4 < 4; ++k4) { const f32x4 br = *(const f32x4*)(C.bbr + (size_t)idx * 16 + 4 * k4), bi = *(const f32x4*)(C.bbi + (size_t)idx * 16 + 4 * k4);
#pragma unroll
        for (int i = 0; i < 4; ++i) { bur += br[i] * u[4 * k4 + i]; bui += bi[i] * u[4 * k4 + i]; } }
    const float ar = C.abr[idx], ai = C.abi[idx];
    const float h0r = C.st_re[(size_t)s * 4096 + idx], h0i = C.st_im[(size_t)s * 4096 + idx];
    const float hr = ar * h0r - ai * h0i + bur, hi = ar * h0i + ai * h0r + bui;
    C.out[O_RS + (size_t)s * 4096 + idx] = hr; C.out[O_IS + (size_t)s * 4096 + idx] = hi;
    float yk = 0.f;
#pragma unroll
    for (int k = 0; k < 16; ++k) { const float v = wave_sum(C.c_re[(size_t)(g * GSZ + k) * NST + p] * hr - C.c_im[(size_t)(g * GSZ + k) * NST + p] * hi); if (p == k) yk = v; }
    if (p < 16) { const int ch = g * GSZ + p; const float ul = bf2f(C.P[row * NPROJ + W_LRU + ch]);
        C.GY[row * W_SSM + ch] = (bf16)f2bf(gelu_tanh(yk + C.ssm_d[ch] * ul)); }
}

template <int MF, int NF, int UNR, class Epi>
__device__ __forceinline__ void skinny_gemm(const Ctx& C, const bf16* A, const bf16* Wt, int K, int ncb, const Epi& E) {
    constexpr int RB = MF * 16, NRB = 128 / RB;
    const int ntiles = NRB * ncb, l15 = C.lane & 15, kg = C.lane >> 4, kw = K / NWAVES;
    LAS f32x4* part = (LAS f32x4*)C.lds;
    for (int t = blockIdx.x; t < ntiles; t += C.G) {
        const int rb = t % NRB, cb = t / NRB;
        f32x4 acc[MF][NF];
#pragma unroll
        for (int i = 0; i < MF; ++i)
#pragma unroll
            for (int j = 0; j < NF; ++j) acc[i][j] = (f32x4){0.f, 0.f, 0.f, 0.f};
        const bf16* Ap = A + (size_t)(rb * RB + l15) * K + C.wave * kw + 8 * kg;
        const bf16* Bp[NF];
#pragma unroll
        for (int j = 0; j < NF; ++j) Bp[j] = Wt + (size_t)(E.brow(cb, j) + l15) * K + C.wave * kw + 8 * kg;
#pragma unroll UNR
        for (int ks = 0; ks < kw / 32; ++ks) {
            bf16x8 a[MF], b[NF];
#pragma unroll
            for (int i = 0; i < MF; ++i) a[i] = *(const bf16x8*)(Ap + (size_t)i * 16 * K + ks * 32);
#pragma unroll
            for (int j = 0; j < NF; ++j) b[j] = *(const bf16x8*)(Bp[j] + ks * 32);
#pragma unroll
            for (int i = 0; i < MF; ++i)
#pragma unroll
                for (int j = 0; j < NF; ++j) acc[i][j] = __builtin_amdgcn_mfma_f32_16x16x32_bf16(b[j], a[i], acc[i][j], 0, 0, 0);
        }
#pragma unroll
        for (int i = 0; i < MF; ++i)
#pragma unroll
            for (int j = 0; j < NF; ++j) part[((C.wave * MF + i) * NF + j) * 64 + C.lane] = acc[i][j];
        __syncthreads();
        for (int q = C.tid; q < MF * 64; q += NWAVES * 64) { const int mf = q >> 6, l64 = q & 63;
            f32x4 v[NF];
#pragma unroll
            for (int j = 0; j < NF; ++j) { f32x4 s = part[((0 * MF + mf) * NF + j) * 64 + l64];
#pragma unroll
                for (int wv = 1; wv < NWAVES; ++wv) s += part[((wv * MF + mf) * NF + j) * 64 + l64];
                v[j] = s; }
            E(rb * RB + mf * 16 + (l64 & 15), cb, l64 >> 4, v); }
        __syncthreads();
    }
}
struct SEpiProj { bf16* P;
    __device__ __forceinline__ int brow(int cb, int nf) const { return cb * 32 + nf * 16; }
    __device__ __forceinline__ void operator()(int r, int cb, int cq, const f32x4 (&v)[2]) const {
#pragma unroll
        for (int nf = 0; nf < 2; ++nf) { const int col = cb * 32 + nf * 16 + 4 * cq; f32x4 x = v[nf];
            if (col >= 2048) {
#pragma unroll
                for (int i = 0; i < 4; ++i) x[i] = sigm(x[i]); }
            v2u w; w.x = pk2(x[0], x[1]); w.y = pk2(x[2], x[3]); *(v2u*)(P + (size_t)(MP + r) * NPROJ + col) = w; } } };
struct SEpiGateA { bf16* T; const bf16* P;
    __device__ __forceinline__ int brow(int cb, int nf) const { return cb * 32 + nf * 16; }
    __device__ __forceinline__ void operator()(int r, int cb, int cq, const f32x4 (&v)[2]) const {
#pragma unroll
        for (int nf = 0; nf < 2; ++nf) { const int col = cb * 32 + nf * 16 + 4 * cq; const f32x4 x = v[nf];
            const v2u g = *(const v2u*)(P + (size_t)(MP + r) * NPROJ + 2048 + col);
            v2u w; w.x = pk2(x[0] * bflo(g.x), x[1] * bfhi(g.x)); w.y = pk2(x[2] * bflo(g.y), x[3] * bfhi(g.y)); *(v2u*)(T + (size_t)(MP + r) * D_MODEL + col) = w; } } };
struct SEpiGlu { bf16* MG; const bf16* T; const bf16* P;
    __device__ __forceinline__ int brow(int cb, int nf) const { const int v0 = cb * 16; return (v0 >> 7) * 256 + (v0 & 127) + nf * 128; }
    __device__ __forceinline__ void operator()(int r, int cb, int cq, const f32x4 (&v)[2]) const {
        const int col = cb * 16 + 4 * cq; const f32x4 a = v[0], g = v[1];
        const v2u t = *(const v2u*)(T + (size_t)(MP + r) * D_MODEL + col), z = *(const v2u*)(P + (size_t)(MP + r) * NPROJ + 4096 + col);
        v2u w; w.x = pk2(bflo(t.x) + bflo(z.x) * (a[0] * sigm(g[0])), bfhi(t.x) + bfhi(z.x) * (a[1] * sigm(g[1])));
        w.y = pk2(bflo(t.y) + bflo(z.y) * (a[2] * sigm(g[2])), bfhi(t.y) + bfhi(z.y) * (a[3] * sigm(g[3])));
        *(v2u*)(MG + (size_t)(MP + r) * D_MODEL + col) = w; } };
struct SEpiRes { const float* xin; float* out; const float* modt; int goff;
    __device__ __forceinline__ int brow(int cb, int nf) const { return cb * 32 + nf * 16; }
    __device__ __forceinline__ void operator()(int r, int cb, int cq, const f32x4 (&v)[2]) const {
#pragma unroll
        for (int nf = 0; nf < 2; ++nf) { const int col = cb * 32 + nf * 16 + 4 * cq;
            const f32x4 g = *(const f32x4*)(modt + (size_t)(4 + r) * MODN + goff + col), xv = *(const f32x4*)(xin + (size_t)r * D_MODEL + col);
            *(f32x4*)(out + (size_t)r * D_MODEL + col) = xv + g * v[nf]; } } };
struct SEpiRelu2 { bf16* O;
    __device__ __forceinline__ int brow(int cb, int nf) const { return cb * 32 + nf * 16; }
    __device__ __forceinline__ void operator()(int r, int cb, int cq, const f32x4 (&v)[2]) const {
#pragma unroll
        for (int nf = 0; nf < 2; ++nf) { const int col = cb * 32 + nf * 16 + 4 * cq; f32x4 x = v[nf];
#pragma unroll
            for (int i = 0; i < 4; ++i) { const float a = fmaxf(x[i], 0.f); x[i] = a * a; }
            v2u w; w.x = pk2(x[0], x[1]); w.y = pk2(x[2], x[3]); *(v2u*)(O + (size_t)(MP + r) * D_FF + col) = w; } } };

enum { PH_P0 = 0, PH_MOD, PH_H1, PH_G1, PH_SA, PH_SB, PH_SC, PH_G3, PH_G4, PH_G5, PH_H2, PH_G6, PH_G7, PH_FIN, N_PHASES };

__global__ void __launch_bounds__(NWAVES * 64, 2) hybrid_fwd(Args args) {
    extern __shared__ __attribute__((aligned(16))) unsigned char lds[];
    Ctx C;
    C.lds = (LAS unsigned char*)lds;
    C.tid = threadIdx.x; C.lane = C.tid & 63; C.wave = __builtin_amdgcn_readfirstlane(C.tid >> 6);
    C.G = gridDim.x; { const int bx = blockIdx.x; C.vcu = (C.G % 8 == 0) ? (bx % 8) * (C.G / 8) + bx / 8 : bx; }
    C.gw = C.vcu * NWAVES + C.wave; C.NGW = C.G * NWAVES;
    C.xp = (const float*)args.in[0]; C.xs = (const float*)args.in[1]; C.st_conv = (const float*)args.in[2]; C.st_lru = (const float*)args.in[3]; C.st_re = (const float*)args.in[4]; C.st_im = (const float*)args.in[5];
    C.c_p = (const float*)args.in[6]; C.c_s = (const float*)args.in[7]; C.w_ada = (const float*)args.in[8]; C.b_ada = (const float*)args.in[9]; C.g1 = (const float*)args.in[10]; C.g2 = (const float*)args.in[11];
    C.w_in = (const float*)args.in[12]; C.conv_w = (const float*)args.in[13]; C.conv_b = (const float*)args.in[14]; C.w_rga = (const float*)args.in[15]; C.b_rga = (const float*)args.in[16]; C.w_rgx = (const float*)args.in[17];
    C.b_rgx = (const float*)args.in[18]; C.lam = (const float*)args.in[19]; C.w_pa = (const float*)args.in[20]; C.a_re = (const float*)args.in[21]; C.a_im = (const float*)args.in[22]; C.log_dt = (const float*)args.in[23];
    C.b_re = (const float*)args.in[24]; C.b_im = (const float*)args.in[25]; C.c_re = (const float*)args.in[26]; C.c_im = (const float*)args.in[27]; C.ssm_d = (const float*)args.in[28]; C.w_glu = (const float*)args.in[29];
    C.w_out = (const float*)args.in[30]; C.w_up = (const float*)args.in[31]; C.w_dn = (const float*)args.in[32]; C.g_fin = (const float*)args.in[33];
    C.out = args.out; C.ws = args.ws;
    unsigned char* ws = args.ws;
    C.modt = (float*)(ws + WS_MOD); C.silu = (bf16*)(ws + WS_TAB + TB_SILU);
    C.abr = (float*)(ws + WS_TAB + TB_ABR); C.abi = (float*)(ws + WS_TAB + TB_ABI); C.bbr = (float*)(ws + WS_TAB + TB_BBR); C.bbi = (float*)(ws + WS_TAB + TB_BBI);
    C.ssr = (float*)(ws + WS_TAB + TB_SSR); C.ssi = (float*)(ws + WS_TAB + TB_SSI); C.lra = (float*)(ws + WS_TAB + TB_LRA); C.lre = (float*)(ws + WS_TAB + TB_LRE);
    C.Win = (bf16*)(ws + WS_WIN); C.Wpa = (bf16*)(ws + WS_WPA); C.Wglu = (bf16*)(ws + WS_WGLU); C.Wout = (bf16*)(ws + WS_WOUT); C.Wup = (bf16*)(ws + WS_WUP); C.Wdn = (bf16*)(ws + WS_WDN);
    C.A = (bf16*)(ws + WS_A); C.P = (bf16*)(ws + WS_PROJ); C.HS = (bf16*)(ws + WS_HSEQ); C.GY = (bf16*)(ws + WS_GY); C.T = (bf16*)(ws + WS_T); C.UC = (bf16*)(ws + WS_UCONV); C.ACT = (bf16*)(ws + WS_ACT);

#if MK_ONE_LAUNCH
    for (int u = C.tid; u < (LDS_BYTES - LDSCTL_OFF) / 4; u += NWAVES * 64) ((LAS unsigned*)(C.lds + LDSCTL_OFF))[u] = 0u;
    __syncthreads();
    XcdBarrier bar = xcd_barrier_post((unsigned*)(ws + WS_CTL) + CW_BAR, (volatile LAS unsigned*)(C.lds + MISC_OFF) + 8);
#define GRID_BAR() xcd_barrier(bar)
#else
#define GRID_BAR() do {} while (0)
#endif
    const int lo = args.ph_lo, hi = args.ph_hi;
#define IN(k) (lo <= (k) && (k) < hi)
#define SEAM(k) do { if (IN(k) && IN((k) + 1)) GRID_BAR(); } while (0)
    LAS unsigned char* wl = C.lds + C.wave * 16384;

    if (IN(PH_P0)) { p0_phase(C); } SEAM(PH_P0);
    if (IN(PH_MOD)) { mod_phase(C); } SEAM(PH_MOD);
    if (IN(PH_H1)) { norm_mod_phase(C, C.xp, C.xs, C.g1, 0, 2048, C.A); } SEAM(PH_H1);
    if (IN(PH_G1)) {
        pg8::Gemm g{C.A, C.Win, MP, NPROJ, D_MODEL}; pg8::StaticOrder S; S.init(MP, NPROJ, C.G, (int)blockIdx.x);
        pg8::EpiProj E{C.P};
        pg8::gemm_phase<pg8::EpiProj, pg8::StaticOrder, PG8_ALIGN, PG8_SP2>(C.lds, g, S, E);
        skinny_gemm<2, 2, 4>(C, C.A + (size_t)MP * D_MODEL, C.Win, D_MODEL, NPROJ / 32, SEpiProj{C.P});
    } SEAM(PH_G1);
    if (IN(PH_SA)) {
        conv_phase(C);
        for (int u = C.gw; u < NGRP * 32; u += C.NGW) s5_unit<false>(C, u & 63, u >> 6, wl);
    } SEAM(PH_SA);
    if (IN(PH_SB)) {
        for (int u = C.gw; u < NGRP * 32; u += C.NGW) s5_unit<true>(C, u & 63, u >> 6, wl);
        for (int u = C.gw; u < NHEAD * 4 * 64; u += C.NGW) lru_unit<false>(C, (u >> 2) & 7, u & 3, u >> 5);
        for (int u = C.gw; u < MS * NHEAD * 2; u += C.NGW) lru_sample_unit(C, u >> 4, (u >> 1) & 7, u & 1, wl);
        for (int u = C.gw; u < MS * NGRP; u += C.NGW) s5_sample_unit(C, u >> 6, u & 63);
    } SEAM(PH_SB);
    if (IN(PH_SC)) {
        for (int u = C.gw; u < NHEAD * 4 * 64; u += C.NGW) lru_unit<true>(C, (u >> 2) & 7, u & 3, u >> 5);
    } SEAM(PH_SC);
    if (IN(PH_G3)) {
        pg8::Gemm g{C.HS, C.Wpa, MP, D_MODEL, W_LRU}; pg8::StaticOrder S; S.init(MP, D_MODEL, C.G, (int)blockIdx.x);
        pg8::EpiGateA E{C.T, C.P};
        pg8::gemm_phase<pg8::EpiGateA, pg8::StaticOrder, PG8_ALIGN, PG8_SP2>(C.lds, g, S, E);
        skinny_gemm<2, 2, 4>(C, C.HS + (size_t)MP * W_LRU, C.Wpa, W_LRU, D_MODEL / 32, SEpiGateA{C.T, C.P});
    } SEAM(PH_G3);
    if (IN(PH_G4)) {
        pg8::Gemm g{C.GY, C.Wglu, MP, 2 * D_MODEL, W_SSM}; pg8::StaticOrder S; S.init(MP, 2 * D_MODEL, C.G, (int)blockIdx.x);
        pg8::EpiGlu E{C.A, C.T, C.P};
        pg8::gemm_phase<pg8::EpiGlu, pg8::StaticOrder, PG8_ALIGN, PG8_SP2>(C.lds, g, S, E);
        skinny_gemm<2, 2, 4>(C, C.GY + (size_t)MP * W_SSM, C.Wglu, W_SSM, D_MODEL / 16, SEpiGlu{C.A, C.T, C.P});
    } SEAM(PH_G4);
    if (IN(PH_G5)) {
        pg8::Gemm g{C.A, C.Wout, MP, D_MODEL, D_MODEL}; pg8::StaticOrder S; S.init(MP, D_MODEL, C.G, (int)blockIdx.x);
        pg8::EpiRes E{C.xp, C.xs, C.out, C.modt, 2 * D_MODEL};
        pg8::gemm_phase<pg8::EpiRes, pg8::StaticOrder, PG8_ALIGN, PG8_SP2>(C.lds, g, S, E);
        skinny_gemm<2, 2, 4>(C, C.A + (size_t)MP * D_MODEL, C.Wout, D_MODEL, D_MODEL / 32, SEpiRes{C.xs, C.out + (size_t)MP * D_MODEL, C.modt, 2 * D_MODEL});
    } SEAM(PH_G5);
    if (IN(PH_H2)) { norm_mod_phase(C, C.out, C.out + (size_t)MP * D_MODEL, C.g2, 3 * D_MODEL, 4 * D_MODEL, C.A); } SEAM(PH_H2);
    if (IN(PH_G6)) {
        pg8::Gemm g{C.A, C.Wup, MP, D_FF, D_MODEL}; pg8::StaticOrder S; S.init(MP, D_FF, C.G, (int)blockIdx.x);
        pg8::EpiRelu2 E{C.ACT};
        pg8::gemm_phase<pg8::EpiRelu2, pg8::StaticOrder, PG8_ALIGN, PG8_SP2>(C.lds, g, S, E);
        skinny_gemm<8, 2, 2>(C, C.A + (size_t)MP * D_MODEL, C.Wup, D_MODEL, D_FF / 32, SEpiRelu2{C.ACT});
    } SEAM(PH_G6);
    if (IN(PH_G7)) {
        pg8::Gemm g{C.ACT, C.Wdn, MP, D_MODEL, D_FF}; pg8::StaticOrder S; S.init(MP, D_MODEL, C.G, (int)blockIdx.x);
        pg8::EpiRes E{C.out, C.out + (size_t)MP * D_MODEL, C.out, C.modt, 5 * D_MODEL};
        pg8::gemm_phase<pg8::EpiRes, pg8::StaticOrder, PG8_ALIGN, PG8_SP2>(C.lds, g, S, E);
        skinny_gemm<2, 2, 4>(C, C.ACT + (size_t)MP * D_FF, C.Wdn, D_FF, D_MODEL / 32, SEpiRes{C.out + (size_t)MP * D_MODEL, C.out + (size_t)MP * D_MODEL, C.modt, 5 * D_MODEL});
    } SEAM(PH_G7);
    if (IN(PH_FIN)) { final_norm_phase(C); }
#undef IN
#undef SEAM
}

extern "C" void kernel_launch(void* const* d_in, const int* in_sizes, int n_in, void* d_out, int out_size, void* d_ws, size_t ws_size, hipStream_t stream) {
    static int grid = 0;
    if (grid == 0) {
        if (n_in != 34 || in_sizes[0] != MP * D_MODEL || (size_t)out_size != O_END || ws_size < WS_END) {
            fprintf(stderr, "kernel_launch: built for 34 inputs, out %zu floats, >= %zu bytes of workspace; got n_in %d, in0 %d, out %d, ws %zu; nothing launched\n", (size_t)O_END, (size_t)WS_END, n_in, n_in > 0 ? in_sizes[0] : -1, out_size, ws_size); grid = -1; return; }
        int dev = 0, cus = 0, per_cu = 0;
        if (hipGetDevice(&dev) != hipSuccess || hipDeviceGetAttribute(&cus, hipDeviceAttributeMultiprocessorCount, dev) != hipSuccess) { fprintf(stderr, "kernel_launch: device query failed\n"); grid = -1; return; }
        if (hipFuncSetAttribute((const void*)hybrid_fwd, hipFuncAttributeMaxDynamicSharedMemorySize, LDS_BYTES) != hipSuccess) { fprintf(stderr, "kernel_launch: hipFuncSetAttribute failed\n"); grid = -1; return; }
        if (hipOccupancyMaxActiveBlocksPerMultiprocessor(&per_cu, (const void*)hybrid_fwd, NWAVES * 64, LDS_BYTES) != hipSuccess || per_cu < 1) { fprintf(stderr, "kernel_launch: occupancy query says %d workgroups per CU\n", per_cu); per_cu = 1; }
        (void)hipGetLastError();
        grid = cus;
    }
    if (grid < 0) return;
    if (hipMemsetAsync((char*)d_ws + WS_CTL, 0, CTL_ZERO_BYTES, stream) != hipSuccess) { fprintf(stderr, "kernel_launch: memset failed\n"); return; }
    Args a{};
    for (int i = 0; i < 34; ++i) a.in[i] = d_in[i];
    a.out = (float*)d_out; a.ws = (unsigned char*)d_ws;
#if MK_ONE_LAUNCH
    a.ph_lo = 0; a.ph_hi = N_PHASES;
    hipLaunchKernelGGL(hybrid_fwd, dim3(grid), dim3(NWAVES * 64), LDS_BYTES, stream, a);
#else
    for (int p = 0; p < N_PHASES; ++p) { a.ph_lo = p; a.ph_hi = p + 1; hipLaunchKernelGGL(hybrid_fwd, dim3(grid), dim3(NWAVES * 64), LDS_BYTES, stream, a); }
#endif
    const hipError_t le = hipPeekAtLastError();
    if (le != hipSuccess) fprintf(stderr, "kernel_launch: launch failed: %s\n", hipGetErrorName(le));
}
```

```cpp
#include <hip/hip_runtime.h>
#include <cstdio>
#include <cstdint>
namespace pg8 {
#define PG8_LAS __attribute__((address_space(3)))
typedef unsigned short bf16_t;
typedef short bf16x8 __attribute__((ext_vector_type(8)));
typedef float f32x4 __attribute__((ext_vector_type(4)));
typedef unsigned u32x4 __attribute__((ext_vector_type(4)));
constexpr int BM = 256, BK = 64, HALF = 128, HTB = HALF * BK * 2  , STAGE_BYTES = 8 * HTB, NXCD = 8, WGM = 8;

__host__ __device__ __forceinline__ int lds_byte(int r, int c) { const int st = (r >> 4) * 2 + (c >> 5), rr = r & 15, cc = c & 31, ob = rr * 64 + cc * 2; return st * 1024 + (ob ^ (((ob >> 9) & 1) << 5)); }
__host__ __device__ __forceinline__ void stage_rc(int b, int& R, int& C) { const int st = b / 1024, sb = b % 1024, swz = sb ^ (((sb >> 9) & 1) << 5); R = (st >> 1) * 16 + swz / 64; C = (st & 1) * 32 + (swz % 64) / 2; }
__host__ __device__ __forceinline__ int perm32(int rho) { const int n = rho >> 4, i = rho & 15; return 8 * (i >> 2) + 4 * n + (i & 3); }

struct Unit { int pm, pn; };
struct Gemm { const bf16_t* A; const bf16_t* Bt; int M, N, K; };

struct StaticOrder {
    int nM, nN, nwg, G, c;
    __host__ __device__ void init(int M, int N, int G_, int c_) { nM = M / BM; nN = N / BM; nwg = nM * nN; G = G_; c = c_; }
    __host__ __device__ bool next(int i, Unit& u) const {
        const long L = (long)i * G + c; if (L >= nwg) return false;
        int wgid = (int)L; { const int q = nwg / NXCD, r = nwg % NXCD, xcd = wgid % NXCD, off = wgid / NXCD; wgid = (xcd < r ? xcd * (q + 1) : r * (q + 1) + (xcd - r) * q) + off; }
        const int nig = WGM * nN, gid = wgid / nig, fm = gid * WGM, gsz = (nM - fm) < WGM ? (nM - fm) : WGM;
        u.pm = fm + ((wgid % nig) % gsz); u.pn = (wgid % nig) / gsz; return true;
    }
    __device__ __forceinline__ void a_ready(const Unit&) const {}
    __device__ __forceinline__ void done(const Unit&) const {}
};

__device__ __forceinline__ unsigned cvt_pk_bf16(float lo, float hi) { unsigned r; asm volatile("v_cvt_pk_bf16_f32 %0, %1, %2" : "=v"(r) : "v"(lo), "v"(hi)); return r; }
constexpr int D_MODEL = 2048, MP = 8192  , MS = 128  , MR = MP + MS  , MODN = 6 * D_MODEL, NPROJ = 6144, D_FF = 8192;
__device__ __forceinline__ float bflo(unsigned w) { return __uint_as_float(w << 16); }
__device__ __forceinline__ float bfhi(unsigned w) { return __uint_as_float(w & 0xffff0000u); }
__device__ __forceinline__ float sigm(float x) { return __builtin_amdgcn_rcpf(1.0f + __builtin_amdgcn_exp2f(-1.44269504f * x)); }
__device__ __forceinline__ int mod_row(int row) { int r = row < MP ? (row >> 11) : (4 + row - MP); return r > 143 ? 143 : r; }

struct EpiProj {
    static constexpr bool PERM = true, AFTER_DRAIN = false;
    bf16_t* O;
    __device__ __forceinline__ void operator()(const f32x4 (&acc)[2][2][4][2], const Unit& u, int wr, int wc, int fr, int fq) const {
        const int row0 = u.pm * BM + wr * 64 + fr, col0 = u.pn * BM + wc * 32 + 8 * fq; const bool sg = u.pn >= 8;
#pragma unroll
        for (int ai = 0; ai < 2; ++ai)
#pragma unroll
            for (int m = 0; m < 4; ++m) { bf16_t* rowp = O + (size_t)(row0 + ai * HALF + m * 16) * NPROJ + col0;
#pragma unroll
                for (int bj = 0; bj < 2; ++bj) { f32x4 v0 = acc[ai][bj][m][0], v1 = acc[ai][bj][m][1];
                    if (sg) {
#pragma unroll
                        for (int i = 0; i < 4; ++i) { v0[i] = sigm(v0[i]); v1[i] = sigm(v1[i]); } }
                    u32x4 w; w.x = cvt_pk_bf16(v0[0], v0[1]); w.y = cvt_pk_bf16(v0[2], v0[3]); w.z = cvt_pk_bf16(v1[0], v1[1]); w.w = cvt_pk_bf16(v1[2], v1[3]);
                    *(u32x4*)(rowp + bj * HALF) = w; } }
    }
};
struct EpiGateA {
    static constexpr bool PERM = true, AFTER_DRAIN = false;
    bf16_t* T; const bf16_t* P;
    __device__ __forceinline__ void operator()(const f32x4 (&acc)[2][2][4][2], const Unit& u, int wr, int wc, int fr, int fq) const {
        const int row0 = u.pm * BM + wr * 64 + fr, col0 = u.pn * BM + wc * 32 + 8 * fq;
#pragma unroll
        for (int ai = 0; ai < 2; ++ai)
#pragma unroll
            for (int m = 0; m < 4; ++m) { const size_t row = (size_t)(row0 + ai * HALF + m * 16);
#pragma unroll
                for (int bj = 0; bj < 2; ++bj) { const int col = col0 + bj * HALF;
                    const u32x4 g = *(const u32x4*)(P + row * NPROJ + 2048 + col);
                    f32x4 v0 = acc[ai][bj][m][0], v1 = acc[ai][bj][m][1];
                    v0[0] *= bflo(g.x); v0[1] *= bfhi(g.x); v0[2] *= bflo(g.y); v0[3] *= bfhi(g.y); v1[0] *= bflo(g.z); v1[1] *= bfhi(g.z); v1[2] *= bflo(g.w); v1[3] *= bfhi(g.w);
                    u32x4 w; w.x = cvt_pk_bf16(v0[0], v0[1]); w.y = cvt_pk_bf16(v0[2], v0[3]); w.z = cvt_pk_bf16(v1[0], v1[1]); w.w = cvt_pk_bf16(v1[2], v1[3]);
                    *(u32x4*)(T + row * D_MODEL + col) = w; } }
    }
};
struct EpiGlu {
    static constexpr bool PERM = true, AFTER_DRAIN = false;
    bf16_t* MG; const bf16_t* T; const bf16_t* P;
    __device__ __forceinline__ void operator()(const f32x4 (&acc)[2][2][4][2], const Unit& u, int wr, int wc, int fr, int fq) const {
        const int row0 = u.pm * BM + wr * 64 + fr, vcol = u.pn * HALF + wc * 32 + 8 * fq;
#pragma unroll
        for (int ai = 0; ai < 2; ++ai)
#pragma unroll
            for (int m = 0; m < 4; ++m) { const size_t row = (size_t)(row0 + ai * HALF + m * 16);
                const u32x4 t = *(const u32x4*)(T + row * D_MODEL + vcol);
                const u32x4 z = *(const u32x4*)(P + row * NPROJ + 4096 + vcol);
                const f32x4 a0 = acc[ai][0][m][0], a1 = acc[ai][0][m][1], g0 = acc[ai][1][m][0], g1 = acc[ai][1][m][1];
                float o[8];
                o[0] = bflo(t.x) + bflo(z.x) * (a0[0] * sigm(g0[0])); o[1] = bfhi(t.x) + bfhi(z.x) * (a0[1] * sigm(g0[1]));
                o[2] = bflo(t.y) + bflo(z.y) * (a0[2] * sigm(g0[2])); o[3] = bfhi(t.y) + bfhi(z.y) * (a0[3] * sigm(g0[3]));
                o[4] = bflo(t.z) + bflo(z.z) * (a1[0] * sigm(g1[0])); o[5] = bfhi(t.z) + bfhi(z.z) * (a1[1] * sigm(g1[1]));
                o[6] = bflo(t.w) + bflo(z.w) * (a1[2] * sigm(g1[2])); o[7] = bfhi(t.w) + bfhi(z.w) * (a1[3] * sigm(g1[3]));
                u32x4 w; w.x = cvt_pk_bf16(o[0], o[1]); w.y = cvt_pk_bf16(o[2], o[3]); w.z = cvt_pk_bf16(o[4], o[5]); w.w = cvt_pk_bf16(o[6], o[7]);
                *(u32x4*)(MG + row * D_MODEL + vcol) = w; }
    }
};
struct EpiRes {
    static constexpr bool PERM = false, AFTER_DRAIN = false;
    const float* xp; const float* xs; float* out; const float* modt; int goff;
    __device__ __forceinline__ void operator()(const f32x4 (&acc)[2][2][4][2], const Unit& u, int wr, int wc, int fr, int fq) const {
        const int row0 = u.pm * BM + wr * 64 + fr, col0 = u.pn * BM + wc * 32 + 4 * fq;
#pragma unroll
        for (int ai = 0; ai < 2; ++ai)
#pragma unroll
            for (int m = 0; m < 4; ++m) { const int row = row0 + ai * HALF + m * 16;
                if (row < MR) {
                    const float* xr = row < MP ? xp + (size_t)row * D_MODEL : xs + (size_t)(row - MP) * D_MODEL;
                    const float* gr = modt + (size_t)mod_row(row) * MODN + goff;
                    float* orow = out + (size_t)row * D_MODEL;
#pragma unroll
                    for (int bj = 0; bj < 2; ++bj)
#pragma unroll
                        for (int n = 0; n < 2; ++n) { const int col = col0 + bj * HALF + n * 16;
                            const f32x4 g = *(const f32x4*)(gr + col); const f32x4 xv = *(const f32x4*)(xr + col);
                            *(f32x4*)(orow + col) = xv + g * acc[ai][bj][m][n]; } } }
    }
};
struct EpiRelu2 {
    static constexpr bool PERM = true, AFTER_DRAIN = false;
    bf16_t* O;
    __device__ __forceinline__ void operator()(const f32x4 (&acc)[2][2][4][2], const Unit& u, int wr, int wc, int fr, int fq) const {
        const int row0 = u.pm * BM + wr * 64 + fr, col0 = u.pn * BM + wc * 32 + 8 * fq;
#pragma unroll
        for (int ai = 0; ai < 2; ++ai)
#pragma unroll
            for (int m = 0; m < 4; ++m) { bf16_t* rowp = O + (size_t)(row0 + ai * HALF + m * 16) * D_FF + col0;
#pragma unroll
                for (int bj = 0; bj < 2; ++bj) { f32x4 v0 = acc[ai][bj][m][0], v1 = acc[ai][bj][m][1];
#pragma unroll
                    for (int i = 0; i < 4; ++i) { const float a = fmaxf(v0[i], 0.f), b = fmaxf(v1[i], 0.f); v0[i] = a * a; v1[i] = b * b; }
                    u32x4 w; w.x = cvt_pk_bf16(v0[0], v0[1]); w.y = cvt_pk_bf16(v0[2], v0[3]); w.z = cvt_pk_bf16(v1[0], v1[1]); w.w = cvt_pk_bf16(v1[2], v1[3]);
                    *(u32x4*)(rowp + bj * HALF) = w; } }
    }
};

template <class Epi, class Sched, bool ALIGN_EPI = false, bool SP2 = false>
__device__ __forceinline__ void gemm_phase(PG8_LAS unsigned char* lds, const Gemm g, const Sched& S, const Epi& E) {
    const int tid = threadIdx.x, wid = __builtin_amdgcn_readfirstlane(tid >> 6), lane = tid & 63, wr = wid >> 2, wc = wid & 3, fr = lane & 15, fq = lane >> 4;
    const int K = g.K, nt = K / BK;
    unsigned voffA[2], voffB[2];
#pragma unroll
    for (int i = 0; i < 2; ++i) { int R, C; stage_rc(tid * 16 + i * 8192, R, C); const int Rb = Epi::PERM ? ((R & ~31) + perm32(R & 31)) : R;
        voffA[i] = (unsigned)(R * K + C) * 2u; voffB[i] = (unsigned)(Rb * K + C) * 2u; }
    const size_t kstep = (size_t)(BK * 2);
    const size_t hstep = (size_t)HALF * K * 2;
    const size_t tstep = 2 * hstep;
    const unsigned ldsw = (unsigned)wid * 1024u;
    const int aoff = lds_byte(wr * 64 + fr, fq * 8), boff = lds_byte(wc * 32 + fr, fq * 8);
#define PG8_SA(b, h) (((b) * 2 + (h)) * HTB)
#define PG8_SB(b, h) ((4 + (b) * 2 + (h)) * HTB)
#define PG8_STAGE(bufoff, gbase, voff) do { _Pragma("unroll") for (int _i = 0; _i < 2; ++_i) \
        __builtin_amdgcn_global_load_lds((const unsigned*)((const char*)(gbase) + (voff)[_i]), (PG8_LAS unsigned*)(lds + (bufoff) + ldsw + _i * 8192), 16, 0, 0); } while (0)
#define PG8_LDA(dst, b, h) do { _Pragma("unroll") for (int m = 0; m < 4; ++m) _Pragma("unroll") for (int k = 0; k < 2; ++k) dst[m][k] = *(const PG8_LAS bf16x8*)(lds + PG8_SA(b, h) + aoff + m * 2048 + k * 1024); } while (0)
#define PG8_LDB(dst, b, h) do { _Pragma("unroll") for (int n = 0; n < 2; ++n) _Pragma("unroll") for (int k = 0; k < 2; ++k) dst[n][k] = *(const PG8_LAS bf16x8*)(lds + PG8_SB(b, h) + boff + n * 2048 + k * 1024); } while (0)
#define PG8_MMA(ai, bj, At, Bt) do { __builtin_amdgcn_s_setprio(1); _Pragma("unroll") for (int m = 0; m < 4; ++m) _Pragma("unroll") for (int n = 0; n < 2; ++n) _Pragma("unroll") for (int k = 0; k < 2; ++k) \
        acc[ai][bj][m][n] = __builtin_amdgcn_mfma_f32_16x16x32_bf16(Bt[n][k], At[m][k], acc[ai][bj][m][n], 0, 0, 0); __builtin_amdgcn_s_setprio(0); } while (0)
#define PG8_WAIT_V(n) asm volatile("s_waitcnt vmcnt(" #n ")" ::: "memory")
#define PG8_WAIT_L(n) asm volatile("s_waitcnt lgkmcnt(" #n ")" ::: "memory")
#define PG8_BAR __builtin_amdgcn_s_barrier()
#define PG8_SCHED __builtin_amdgcn_sched_barrier(0)
    Unit cur, nxt; int ui = 0;
    if (!S.next(0, cur)) return;
    f32x4 acc[2][2][4][2];
#pragma unroll
    for (int a = 0; a < 2; ++a)
#pragma unroll
        for (int b = 0; b < 2; ++b)
#pragma unroll
            for (int m = 0; m < 4; ++m)
#pragma unroll
                for (int n = 0; n < 2; ++n) acc[a][b][m][n] = (f32x4){0.f, 0.f, 0.f, 0.f};
    bf16x8 At[4][2], B0[2][2], B1[2][2];
    const char* cA = (const char*)g.A + (size_t)cur.pm * tstep; const char* cB = (const char*)g.Bt + (size_t)cur.pn * tstep;
    S.a_ready(cur);
    if constexpr (SP2) {
        PG8_STAGE(PG8_SB(0, 0), cB, voffB); PG8_STAGE(PG8_SB(0, 1), cB + hstep, voffB); PG8_STAGE(PG8_SA(0, 0), cA, voffA); PG8_STAGE(PG8_SA(0, 1), cA + hstep, voffA);
        if (wr == 1) PG8_BAR;
        PG8_WAIT_V(2); PG8_BAR;
        PG8_STAGE(PG8_SB(1, 0), cB + kstep, voffB); PG8_STAGE(PG8_SA(1, 0), cA + kstep, voffA); PG8_STAGE(PG8_SB(1, 1), cB + hstep + kstep, voffB);
        PG8_WAIT_V(6); PG8_BAR;
    } else {
        PG8_STAGE(PG8_SB(0, 0), cB, voffB); PG8_STAGE(PG8_SA(0, 0), cA, voffA); PG8_STAGE(PG8_SB(0, 1), cB + hstep, voffB); PG8_STAGE(PG8_SA(0, 1), cA + hstep, voffA);
        if (wr == 1) PG8_BAR;
        PG8_WAIT_V(4); PG8_BAR;
        PG8_STAGE(PG8_SB(1, 0), cB + kstep, voffB); PG8_STAGE(PG8_SA(1, 0), cA + kstep, voffA); PG8_STAGE(PG8_SB(1, 1), cB + hstep + kstep, voffB);
        PG8_WAIT_V(6); PG8_BAR;
    }
    for (;;) {
        const bool has_next = S.next(ui + 1, nxt);
        const char* nA = has_next ? (const char*)g.A + (size_t)nxt.pm * tstep : cA; const char* nB = has_next ? (const char*)g.Bt + (size_t)nxt.pn * tstep : cB;
        for (int t = 0; t < nt; t += 2) {
            const bool last = (t == nt - 2);
            const char* a1 = cA + (size_t)(t + 1) * kstep;
            const char* a2 = last ? nA : cA + (size_t)(t + 2) * kstep; const char* b2 = last ? nB : cB + (size_t)(t + 2) * kstep;
            const char* a3 = a2 + kstep; const char* b3 = b2 + kstep;
            if (last && has_next) S.a_ready(nxt);
            if constexpr (SP2) {
            PG8_LDB(B0, 0, 0); PG8_LDB(B1, 0, 1); PG8_SCHED; PG8_LDA(At, 0, 0); PG8_STAGE(PG8_SA(1, 1), a1 + hstep, voffA);
            PG8_WAIT_V(8); PG8_WAIT_L(0); PG8_BAR; PG8_MMA(0, 0, At, B0); PG8_MMA(0, 1, At, B1); PG8_BAR; PG8_SCHED;
            PG8_LDA(At, 0, 1); PG8_STAGE(PG8_SB(0, 0), b2, voffB); PG8_STAGE(PG8_SB(0, 1), b2 + hstep, voffB); PG8_STAGE(PG8_SA(0, 0), a2, voffA);
            PG8_WAIT_V(8); PG8_WAIT_L(0); PG8_BAR; PG8_MMA(1, 0, At, B0); PG8_MMA(1, 1, At, B1); PG8_BAR; PG8_SCHED;
            PG8_LDB(B0, 1, 0); PG8_LDB(B1, 1, 1); PG8_SCHED; PG8_LDA(At, 1, 0); PG8_STAGE(PG8_SA(0, 1), a2 + hstep, voffA);
            PG8_WAIT_V(8); PG8_WAIT_L(0); PG8_BAR; PG8_MMA(0, 0, At, B0); PG8_MMA(0, 1, At, B1); PG8_BAR; PG8_SCHED;
            PG8_LDA(At, 1, 1); PG8_STAGE(PG8_SB(1, 0), b3, voffB); PG8_STAGE(PG8_SB(1, 1), b3 + hstep, voffB); PG8_STAGE(PG8_SA(1, 0), a3, voffA);
            PG8_WAIT_V(8); PG8_WAIT_L(0); PG8_BAR; PG8_MMA(1, 0, At, B0); PG8_MMA(1, 1, At, B1); PG8_BAR; PG8_SCHED;
            } else {
            PG8_LDB(B0, 0, 0); PG8_SCHED; PG8_LDA(At, 0, 0); PG8_STAGE(PG8_SA(1, 1), a1 + hstep, voffA);
            PG8_WAIT_L(8); PG8_BAR; PG8_WAIT_L(0); PG8_MMA(0, 0, At, B0); PG8_BAR; PG8_SCHED;
            PG8_LDB(B1, 0, 1); PG8_STAGE(PG8_SB(0, 0), b2, voffB);
            PG8_BAR; PG8_WAIT_L(0); PG8_MMA(0, 1, At, B1); PG8_BAR;
            PG8_LDA(At, 0, 1); PG8_STAGE(PG8_SA(0, 0), a2, voffA);
            PG8_BAR; PG8_WAIT_L(0); PG8_MMA(1, 0, At, B0); PG8_BAR; PG8_SCHED;
            PG8_STAGE(PG8_SB(0, 1), b2 + hstep, voffB);
            PG8_WAIT_V(6); PG8_BAR; PG8_MMA(1, 1, At, B1); PG8_BAR;
            PG8_LDB(B0, 1, 0); PG8_SCHED; PG8_LDA(At, 1, 0); PG8_STAGE(PG8_SA(0, 1), a2 + hstep, voffA);
            PG8_WAIT_L(8); PG8_BAR; PG8_WAIT_L(0); PG8_MMA(0, 0, At, B0); PG8_BAR; PG8_SCHED;
            PG8_LDB(B1, 1, 1); PG8_STAGE(PG8_SB(1, 0), b3, voffB);
            PG8_BAR; PG8_WAIT_L(0); PG8_MMA(0, 1, At, B1); PG8_BAR;
            PG8_LDA(At, 1, 1); PG8_STAGE(PG8_SA(1, 0), a3, voffA);
            PG8_BAR; PG8_WAIT_L(0); PG8_MMA(1, 0, At, B0); PG8_BAR; PG8_SCHED;
            PG8_STAGE(PG8_SB(1, 1), b3 + hstep, voffB);
            PG8_WAIT_V(6); PG8_BAR; PG8_MMA(1, 1, At, B1); PG8_BAR;
            }
        }
        if constexpr (ALIGN_EPI) { if (wr == 0) PG8_BAR; }
        if constexpr (!Epi::AFTER_DRAIN) { E(acc, cur, wr, wc, fr, fq); S.done(cur); }
        if (!has_next) break;
#pragma unroll
        for (int a = 0; a < 2; ++a)
#pragma unroll
            for (int b = 0; b < 2; ++b)
#pragma unroll
                for (int m = 0; m < 4; ++m)
#pragma unroll
                    for (int n = 0; n < 2; ++n) acc[a][b][m][n] = (f32x4){0.f, 0.f, 0.f, 0.f};
        cur = nxt; cA = nA; cB = nB; ++ui;
        if constexpr (ALIGN_EPI) { if (wr == 1) PG8_BAR; }
    }
    PG8_WAIT_V(0);
    if constexpr (!ALIGN_EPI) { if (wr == 0) PG8_BAR; }
    PG8_BAR;
    if constexpr (Epi::AFTER_DRAIN) { E.fused(acc, cur, wr, wc, fr, fq, lds, wid, lane); S.done(cur); }
#undef PG8_SA
#undef PG8_SB
#undef PG8_STAGE
#undef PG8_LDA
#undef PG8_LDB
#undef PG8_MMA
#undef PG8_WAIT_V
#undef PG8_WAIT_L
#undef PG8_BAR
#undef PG8_SCHED
}
}
#ifndef PG8_SP2
#define PG8_SP2 true
#endif
#ifndef PG8_ALIGN
#define PG8_ALIGN true
#endif
#ifndef MK_ONE_LAUNCH
#define MK_ONE_LAUNCH 1
#endif

using pg8::D_MODEL; using pg8::MP; using pg8::MS; using pg8::MR; using pg8::MODN; using pg8::NPROJ; using pg8::D_FF;
constexpr int MPAD = 8448;
constexpr int SEQ = 2048, NB = 4, W_LRU = 1024, W_SSM = 1024, NHEAD = 8, HDIM = 128, NGRP = 64, NST = 64, GSZ = 16;
constexpr int S5_TC = 128, S5_NCH = SEQ / S5_TC;
constexpr int LR_TC = 64,  LR_NCH = SEQ / LR_TC;
constexpr float EPS = 1e-6f;
constexpr size_t O_YP = 0, O_YS = 16777216, O_CP = 17039360, O_LP = 17051648, O_RP = 17055744, O_IP = 17072128, O_CS = 17088512, O_LS = 17481728, O_RS = 17612800, O_IS = 18137088, O_END = 18661376;

constexpr size_t MiB = 1u << 20;
constexpr size_t WS_CTL = 0, CTL_ZERO_BYTES = 1 * MiB;
constexpr size_t WS_MOD = 1 * MiB;
constexpr size_t WS_TAB = 8 * MiB;
constexpr size_t TB_SILU = 0;
constexpr size_t TB_ABR = 1 * MiB, TB_ABI = TB_ABR + 16384;
constexpr size_t TB_BBR = TB_ABI + 16384, TB_BBI = TB_BBR + 262144;
constexpr size_t TB_SSR = 2 * MiB, TB_SSI = 3 * MiB;
constexpr size_t TB_LRA = 4 * MiB, TB_LRE = 4 * MiB + 524288;
constexpr size_t WS_WIN = 16 * MiB, WS_WPA = 40 * MiB, WS_WGLU = 44 * MiB, WS_WOUT = 52 * MiB, WS_WUP = 60 * MiB, WS_WDN = 92 * MiB;
constexpr size_t WS_A = 124 * MiB;
constexpr size_t WS_PROJ = 157 * MiB;
constexpr size_t WS_HSEQ = 256 * MiB, WS_GY = 273 * MiB;
constexpr size_t WS_T = 290 * MiB, WS_UCONV = WS_T;
constexpr size_t WS_ACT = 157 * MiB;
constexpr size_t WS_END = 323 * MiB;
static_assert(WS_ACT + (size_t)MPAD * D_FF * 2 <= WS_T && WS_T + (size_t)MPAD * D_MODEL * 2 <= WS_END && WS_PROJ + (size_t)MPAD * NPROJ * 2 <= WS_HSEQ, "d_ws map");
constexpr int CW_BAR = 4096;

constexpr int RING_BYTES = 131072, LDS_BYTES = 147456, LDSCTL_OFF = LDS_BYTES - 1024, MISC_OFF = LDSCTL_OFF + 320;
constexpr int NWAVES = 8;

#define GAS __attribute__((address_space(1)))
#define LAS __attribute__((address_space(3)))
typedef unsigned short bf16;
typedef unsigned v4u __attribute__((ext_vector_type(4)));
typedef unsigned v2u __attribute__((ext_vector_type(2)));
typedef float f32x4 __attribute__((ext_vector_type(4)));
typedef float f32x16 __attribute__((ext_vector_type(16)));
typedef short bf16x8 __attribute__((ext_vector_type(8)));
typedef GAS unsigned gu32;
#define RLX_AGENT __ATOMIC_RELAXED, __HIP_MEMORY_SCOPE_AGENT
#define LDS_WAIT() asm volatile("s_waitcnt lgkmcnt(0)" ::: "memory")
#define VM_WAIT() asm volatile("s_waitcnt vmcnt(0)" ::: "memory")
__device__ __forceinline__ unsigned f2bf(float f) { unsigned u = __builtin_bit_cast(unsigned, f); return (u + 0x7fffu + ((u >> 16) & 1u)) >> 16; }
__device__ __forceinline__ unsigned pk2(float lo, float hi) { return pg8::cvt_pk_bf16(lo, hi); }
__device__ __forceinline__ float bf2f(bf16 v) { return __uint_as_float((unsigned)v << 16); }
using pg8::bflo; using pg8::bfhi; using pg8::sigm;
__device__ __forceinline__ bf16x8 pack8(f32x4 a, f32x4 b) { v4u w; w.x = pk2(a[0], a[1]); w.y = pk2(a[2], a[3]); w.z = pk2(b[0], b[1]); w.w = pk2(b[2], b[3]); return __builtin_bit_cast(bf16x8, w); }
__device__ __forceinline__ float gelu_tanh(float v) {
    const float z = 0.7978845608f * (v + 0.044715f * v * v * v);
    const float t = __builtin_amdgcn_exp2f(2.885390082f * z);
    return v - v * __builtin_amdgcn_rcpf(1.0f + t);
}
__device__ __forceinline__ float wave_sum(float v) {
#pragma unroll
    for (int o = 1; o < 64; o <<= 1) v += __shfl_xor(v, o);
    return v;
}

#if MK_ONE_LAUNCH
#define XB_TMO      128
#define XB_XCNT(j)  (256  + 64 * (j))
#define XB_XSUB(j)  (1280 + 64 * (j))
#define XB_XGEN(j)  (2304 + 64 * (j))
#define XB_TOP      3328
#define XB_TOPGEN   3392
#define XCD_BAR_WORDS 3456
#define XB_SPIN_CAP (1u << 18)

__device__ __forceinline__ unsigned xb_ld(unsigned* p)              { return __hip_atomic_load(p, __ATOMIC_RELAXED, __HIP_MEMORY_SCOPE_AGENT); }
__device__ __forceinline__ unsigned xb_add(unsigned* p, unsigned v) { return __hip_atomic_fetch_add(p, v, __ATOMIC_RELAXED, __HIP_MEMORY_SCOPE_AGENT); }
__device__ __forceinline__ unsigned xb_xcc_id() { return (unsigned)__builtin_amdgcn_s_getreg((3 << 11) | 20) & 0xFu; }
#define XB_SPIN(cond, bar) do { unsigned _sp = 0; while (cond) { __builtin_amdgcn_s_sleep(1); \
    if ((++_sp & 255u) == 0u) { if (xb_ld(&(bar)[XB_TMO])) break; if (_sp > XB_SPIN_CAP) { atomicAdd(&(bar)[XB_TMO], 1u); break; } } } } while (0)

struct XcdBarrier {
    unsigned* bar; unsigned x;
    volatile LAS unsigned* st;
};

__device__ __forceinline__ XcdBarrier xcd_barrier_post(unsigned* bar, volatile LAS unsigned* st) {
    XcdBarrier b; b.bar = bar; b.x = xb_xcc_id(); b.st = st;
    if (threadIdx.x == 0) (void)xb_add(&bar[XB_XCNT(b.x)], 1u);
    return b;
}
__device__ __forceinline__ void xcd_barrier_complete(unsigned* bar, unsigned x, unsigned& nloc, unsigned& nx) {
    const unsigned G = gridDim.x * gridDim.y * gridDim.z;
    unsigned sum, cnt, mine, sp = 0u;
    for (;;) {
        sum = 0u; cnt = 0u; mine = 0u;
#pragma unroll
        for (unsigned j = 0; j < 16; ++j) { const unsigned c = xb_ld(&bar[XB_XCNT(j)]); sum += c; cnt += (c > 0u) ? 1u : 0u; mine = (j == x) ? c : mine; }
        if (sum == G) break;
        __builtin_amdgcn_s_sleep(1);
        if ((++sp & 255u) == 0u) { if (xb_ld(&bar[XB_TMO])) break; if (sp > XB_SPIN_CAP) { atomicAdd(&bar[XB_TMO], 1u); break; } }
    }
    nloc = mine > 0u ? mine : 1u; nx = cnt > 0u ? cnt : 1u;
}

__device__ __forceinline__ void xcd_barrier(const XcdBarrier& b) {
    asm volatile("s_waitcnt vmcnt(0)" ::: "memory");
    __syncthreads();
    if (threadIdx.x == 0) {
        unsigned* bar = b.bar;
        __builtin_amdgcn_s_waitcnt(0);
        unsigned nloc = b.st[0], nx = b.st[1];
        if (nloc == 0u) { xcd_barrier_complete(bar, b.x, nloc, nx); b.st[0] = nloc; b.st[1] = nx; }
        const unsigned old = xb_add(&bar[XB_XSUB(b.x)], 1u);
        const unsigned gen = old / nloc;
        if (old + 1u == (gen + 1u) * nloc) {
            __builtin_amdgcn_fence(__ATOMIC_RELEASE, "agent");
            asm volatile("s_waitcnt vmcnt(0)" ::: "memory");
            const unsigned og = xb_add(&bar[XB_TOP], 1u);
            const unsigned tg = og / nx;
            if (og + 1u == (tg + 1u) * nx) xb_add(&bar[XB_TOPGEN], 1u);
            else XB_SPIN(xb_ld(&bar[XB_TOPGEN]) == tg, bar);
            __builtin_amdgcn_fence(__ATOMIC_ACQUIRE, "agent");
            xb_add(&bar[XB_XGEN(b.x)], 1u);
            asm volatile("s_waitcnt vmcnt(0)" ::: "memory");
        } else {
            XB_SPIN(xb_ld(&bar[XB_XGEN(b.x)]) == gen, bar);
            __builtin_amdgcn_fence(__ATOMIC_ACQUIRE, "agent");
            asm volatile("s_waitcnt vmcnt(0)" ::: "memory");
        }
    }
    __syncthreads();
}

#endif

struct Args { const void* in[34]; float* out; unsigned char* ws; int ph_lo, ph_hi; };

struct Ctx {
    LAS unsigned char* lds; int tid, lane, wave, vcu, G, gw, NGW;
    const float *xp, *xs, *st_conv, *st_lru, *st_re, *st_im, *c_p, *c_s, *w_ada, *b_ada, *g1, *g2, *w_in, *conv_w, *conv_b, *w_rga, *b_rga, *w_rgx, *b_rgx, *lam, *w_pa;
    const float *a_re, *a_im, *log_dt, *b_re, *b_im, *c_re, *c_im, *ssm_d, *w_glu, *w_out, *w_up, *w_dn, *g_fin;
    float* out; unsigned char* ws;
    float* modt; bf16* silu; float *abr, *abi, *bbr, *bbi, *ssr, *ssi, *lra, *lre;
    bf16 *Win, *Wpa, *Wglu, *Wout, *Wup, *Wdn, *A, *P, *HS, *GY, *T, *UC, *ACT;
};

__device__ __forceinline__ void p0_transpose_item(const float* W, int K, int N, bf16* WT, int glu, LAS float* scr, int item, int lane) {
    const int nblk = N / 32, kb = item / nblk, nb = item % nblk, k0 = 64 * kb, n0 = 32 * nb;
#pragma unroll 8
    for (int i = 0; i < 32; ++i) { const int kk = 2 * i + (lane >> 5); scr[kk * 33 + (lane & 31)] = W[(size_t)(k0 + kk) * N + n0 + (lane & 31)]; }
    LDS_WAIT(); asm volatile("" ::: "memory");
    const int c = lane & 7;
    int d0 = n0; if (glu) d0 = n0 < 2048 ? ((n0 >> 7) * 256 + (n0 & 127)) : (((n0 - 2048) >> 7) * 256 + 128 + ((n0 - 2048) & 127));
#pragma unroll
    for (int j = 0; j < 4; ++j) { const int n = (lane >> 3) + 8 * j; const LAS float* s = scr + (8 * c) * 33 + n;
        v4u o; o.x = pk2(s[0 * 33], s[1 * 33]); o.y = pk2(s[2 * 33], s[3 * 33]); o.z = pk2(s[4 * 33], s[5 * 33]); o.w = pk2(s[6 * 33], s[7 * 33]);
        *(v4u*)(WT + (size_t)(d0 + n) * K + k0 + 8 * c) = o; }
    LDS_WAIT(); asm volatile("" ::: "memory");
}
__device__ __forceinline__ void p0_phase(const Ctx& C) {
    LAS float* scr = (LAS float*)(C.lds + C.wave * 16384);
    constexpr int I_IN = (2048 / 64) * (6144 / 32), I_PA = (1024 / 64) * (2048 / 32), I_GLU = (1024 / 64) * (4096 / 32), I_OUT = (2048 / 64) * (2048 / 32), I_UP = (2048 / 64) * (8192 / 32), I_DN = (8192 / 64) * (2048 / 32);
    constexpr int NIT = I_IN + I_PA + I_GLU + I_OUT + I_UP + I_DN;
    for (int it = C.gw; it < NIT; it += C.NGW) {
        int r = it;
        if (r < I_IN) { p0_transpose_item(C.w_in, 2048, 6144, C.Win, 0, scr, r, C.lane); continue; } r -= I_IN;
        if (r < I_PA) { p0_transpose_item(C.w_pa, 1024, 2048, C.Wpa, 0, scr, r, C.lane); continue; } r -= I_PA;
        if (r < I_GLU) { p0_transpose_item(C.w_glu, 1024, 4096, C.Wglu, 1, scr, r, C.lane); continue; } r -= I_GLU;
        if (r < I_OUT) { p0_transpose_item(C.w_out, 2048, 2048, C.Wout, 0, scr, r, C.lane); continue; } r -= I_OUT;
        if (r < I_UP) { p0_transpose_item(C.w_up, 2048, 8192, C.Wup, 0, scr, r, C.lane); continue; } r -= I_UP;
        p0_transpose_item(C.w_dn, 8192, 2048, C.Wdn, 0, scr, r, C.lane);
    }
    for (int r = C.gw; r < 144; r += C.NGW) {
        const float* src = r < 4 ? C.c_p + (size_t)r * D_MODEL : C.c_s + (size_t)(r < 132 ? r - 4 : 0) * D_MODEL;
#pragma unroll
        for (int j = 0; j < 4; ++j) { const int idx = j * 512 + C.lane * 8;
            f32x4 a = *(const f32x4*)(src + idx), b = *(const f32x4*)(src + idx + 4);
#pragma unroll
            for (int i = 0; i < 4; ++i) { a[i] = a[i] * sigm(a[i]); b[i] = b[i] * sigm(b[i]); }
            if (r >= 132) { a = (f32x4){0.f, 0.f, 0.f, 0.f}; b = a; }
            v4u o; o.x = pk2(a[0], a[1]); o.y = pk2(a[2], a[3]); o.z = pk2(b[0], b[1]); o.w = pk2(b[2], b[3]);
            *(v4u*)(C.silu + (size_t)r * D_MODEL + idx) = o; }
    }
    for (int g = C.gw; g < NGRP; g += C.NGW) {
        const int idx = g * NST + C.lane;
        const float ar = C.a_re[idx], ai = C.a_im[idx], dt = expf(C.log_dt[g]);
        const float mag = expf(dt * ar), ang = dt * ai;
        float sn, cs; sincosf(ang, &sn, &cs);
        const float abr = mag * cs, abi = mag * sn;
        const float den = ar * ar + ai * ai, nr = abr - 1.0f, ni = abi;
        const float qre = (nr * ar + ni * ai) / den, qim = (ni * ar - nr * ai) / den;
        C.abr[idx] = abr; C.abi[idx] = abi;
#pragma unroll
        for (int k4 = 0; k4 < 4; ++k4) { const f32x4 br = *(const f32x4*)(C.b_re + (size_t)idx * 16 + 4 * k4), bi = *(const f32x4*)(C.b_im + (size_t)idx * 16 + 4 * k4);
            *(f32x4*)(C.bbr + (size_t)idx * 16 + 4 * k4) = qre * br - qim * bi; *(f32x4*)(C.bbi + (size_t)idx * 16 + 4 * k4) = qre * bi + qim * br; }
    }
}

__device__ __forceinline__ void mod_phase(const Ctx& C) {
    const int n = C.lane & 15, kg = C.lane >> 4;
    LAS float* part = (LAS float*)C.lds;
    for (int u = blockIdx.x; u < MODN / 16; u += C.G) {
        const int n0 = u * 16;
        const float* Wp = C.w_ada + (size_t)(256 * C.wave + 8 * kg) * MODN + n0 + n;
        const bf16* Ap = C.silu + (size_t)n * D_MODEL + 256 * C.wave + 8 * kg;
        f32x4 acc[9];
#pragma unroll
        for (int i = 0; i < 9; ++i) acc[i] = (f32x4){0.f, 0.f, 0.f, 0.f};
        float w[8][8];
#pragma unroll
        for (int ks = 0; ks < 8; ++ks)
#pragma unroll
            for (int j = 0; j < 8; ++j) w[ks][j] = Wp[(size_t)(ks * 32 + j) * MODN];
#pragma unroll
        for (int ks = 0; ks < 8; ++ks) {
            const bf16x8 bfr = pack8((f32x4){w[ks][0], w[ks][1], w[ks][2], w[ks][3]}, (f32x4){w[ks][4], w[ks][5], w[ks][6], w[ks][7]});
#pragma unroll
            for (int mf = 0; mf < 9; ++mf) { const bf16x8 a = *(const bf16x8*)(Ap + (size_t)mf * 16 * D_MODEL + ks * 32);
                acc[mf] = __builtin_amdgcn_mfma_f32_16x16x32_bf16(a, bfr, acc[mf], 0, 0, 0); }
        }
#pragma unroll
        for (int mf = 0; mf < 9; ++mf)
#pragma unroll
            for (int r = 0; r < 4; ++r) part[((C.wave * 9 + mf) * 4 + r) * 64 + C.lane] = acc[mf][r];
        __syncthreads();
        for (int e = C.tid; e < 9 * 4 * 64; e += NWAVES * 64) {
            float s = 0.f;
#pragma unroll
            for (int wv = 0; wv < 8; ++wv) s += part[wv * 2304 + e];
            const int mf = e >> 8, r = (e >> 6) & 3, l64 = e & 63, row = mf * 16 + 4 * (l64 >> 4) + r, col = n0 + (l64 & 15);
            C.modt[(size_t)row * MODN + col] = s + C.b_ada[col];
        }
        __syncthreads();
    }
}

__device__ __forceinline__ void norm_mod_phase(const Ctx& C, const float* xp, const float* xs, const float* g, int sh_off, int sc_off, bf16* O) {
    for (int row = C.gw; row < MR; row += C.NGW) {
        const float* xr = row < MP ? xp + (size_t)row * D_MODEL : xs + (size_t)(row - MP) * D_MODEL;
        const float* mr = C.modt + (size_t)pg8::mod_row(row) * MODN;
        f32x4 v[8]; float ss = 0.f;
#pragma unroll
        for (int j = 0; j < 8; ++j) { v[j] = *(const f32x4*)(xr + 256 * j + 4 * C.lane); ss += (v[j][0] * v[j][0] + v[j][1] * v[j][1]) + (v[j][2] * v[j][2] + v[j][3] * v[j][3]); }
        const float rstd = 1.0f / sqrtf(wave_sum(ss) * (1.0f / D_MODEL) + EPS);
#pragma unroll
        for (int j = 0; j < 8; ++j) { const int col = 256 * j + 4 * C.lane;
            const f32x4 gg = *(const f32x4*)(g + col), sc = *(const f32x4*)(mr + sc_off + col), sh = *(const f32x4*)(mr + sh_off + col);
            const f32x4 o = v[j] * rstd * gg * (1.0f + sc) + sh;
            v2u w; w.x = pk2(o[0], o[1]); w.y = pk2(o[2], o[3]);
            *(v2u*)(O + (size_t)row * D_MODEL + col) = w; }
    }
}
__device__ __forceinline__ void final_norm_phase(const Ctx& C) {
    for (int row = C.gw; row < MR; row += C.NGW) {
        float* xr = C.out + (size_t)row * D_MODEL;
        f32x4 v[8]; float ss = 0.f;
#pragma unroll
        for (int j = 0; j < 8; ++j) { v[j] = *(const f32x4*)(xr + 256 * j + 4 * C.lane); ss += (v[j][0] * v[j][0] + v[j][1] * v[j][1]) + (v[j][2] * v[j][2] + v[j][3] * v[j][3]); }
        const float rstd = 1.0f / sqrtf(wave_sum(ss) * (1.0f / D_MODEL) + EPS);
#pragma unroll
        for (int j = 0; j < 8; ++j) { const int col = 256 * j + 4 * C.lane; *(f32x4*)(xr + col) = v[j] * rstd * *(const f32x4*)(C.g_fin + col); }
    }
}

__device__ __forceinline__ f32x16 zero16() { return f32x16{}; }

constexpr int TROW = 272;
constexpr int TILE256 = 256 * TROW, TILE128 = 128 * TROW;
static_assert(TILE256 + NWAVES * 8704 <= LDSCTL_OFF && 4 * TILE128 <= LDSCTL_OFF, "scan LDS map");

__device__ __forceinline__ void new_conv_prompt(const Ctx& C) {
    const int nthr = C.G * NWAVES * 64;
    for (int idx = C.vcu * (NWAVES * 64) + C.tid; idx < NB * 3 * W_LRU; idx += nthr) {
        const int ch = idx & (W_LRU - 1), k = (idx >> 10) % 3, b = idx / (3 * W_LRU);
        C.out[O_CP + idx] = bf2f(C.P[(size_t)(b * SEQ + SEQ - 3 + k) * NPROJ + ch]);
    }
}

template <bool APPLY>
__device__ __forceinline__ void s5_block(const Ctx& C, int go, int q) {
    const int lane = C.lane, c31 = lane & 31, kh = lane >> 5, w = C.wave, g = go * 8 + w;
    const int asel = (c31 >> 2) & 1, atok = (c31 & 3) + 4 * (c31 >> 3);
    const int b = q >> 3, cX = 2 * (q & 7), myc = cX + kh;
    const int rowX = b * SEQ + cX * S5_TC;
    LAS unsigned char* tile = C.lds;
    {
        const int rr = C.tid >> 4, cc = (C.tid & 15) * 8;
        v4u tmp[8];
#pragma unroll
        for (int i = 0; i < 8; ++i) tmp[i] = *(const v4u*)(C.P + (size_t)(rowX + i * 32 + rr) * NPROJ + W_LRU + go * 128 + cc);
#pragma unroll
        for (int i = 0; i < 8; ++i) *(LAS v4u*)(tile + (i * 32 + rr) * TROW + cc * 2) = tmp[i];
    }
    bf16x8 bb[2][2]; float ar[2], ai[2], hr[2], hi[2];
#pragma unroll
    for (int ph = 0; ph < 2; ++ph) { const int idx = g * NST + ph * 32 + c31;
        ar[ph] = C.abr[idx]; ai[ph] = C.abi[idx]; hr[ph] = 0.f; hi[ph] = 0.f;
        const f32x4* sr = (const f32x4*)(C.bbr + (size_t)idx * 16 + 8 * kh); const f32x4* si = (const f32x4*)(C.bbi + (size_t)idx * 16 + 8 * kh);
        bb[0][ph] = pack8(sr[0], sr[1]); bb[1][ph] = pack8(si[0], si[1]); }
    bf16x8 cb[8];
    float dsk = 0.f;
    if (APPLY) {
#pragma unroll
        for (int ph = 0; ph < 2; ++ph) { float pr = ar[ph], pi = ai[ph];
#pragma unroll
            for (int s = 0; s < 7; ++s) { const float nr = pr * pr - pi * pi, ni = 2.0f * pr * pi; pr = nr; pi = ni; }
            const size_t sidx = (size_t)g * NST + ph * 32 + c31; float Hr = 0.f, Hi = 0.f;
#pragma unroll
            for (int j = 0; j < S5_NCH - 1; ++j) { const float sr = C.ssr[(size_t)(b * S5_NCH + j) * 4096 + sidx], si = C.ssi[(size_t)(b * S5_NCH + j) * 4096 + sidx];
                const float nr = pr * Hr - pi * Hi + sr, ni = pr * Hi + pi * Hr + si; if (j < myc) { Hr = nr; Hi = ni; } }
            hr[ph] = Hr; hi[ph] = Hi; }
#pragma unroll
        for (int s = 0; s < 8; ++s) { f32x4 a = (f32x4){0.f, 0.f, 0.f, 0.f}, bq = a;
            if (c31 < 16) { const float* src = (s < 4 ? C.c_re : C.c_im) + (size_t)(g * GSZ + c31) * NST + 16 * (s & 3) + 8 * kh; a = *(const f32x4*)src; bq = *(const f32x4*)(src + 4); if (s >= 4) { a = -a; bq = -bq; } }
            cb[s] = pack8(a, bq); }
        dsk = C.ssm_d[g * GSZ + (c31 & 15)];
    }
    __syncthreads();
    LAS bf16* hl = (LAS bf16*)(C.lds + TILE256 + w * 8704);
    const LAS unsigned char* abase = tile + (asel * S5_TC + atok) * TROW + (16 * w + 8 * kh) * 2;
    LAS bf16* ubase = (LAS bf16*)(tile + (kh * S5_TC) * TROW) + 16 * w + (c31 & 15);
    for (int st = 0; st < S5_TC / 16; ++st) {
        const bf16x8 af = *(const LAS bf16x8*)(abase + st * 16 * TROW);
        const f32x16 z = zero16();
        f32x16 re0 = __builtin_amdgcn_mfma_f32_32x32x16_bf16(af, bb[0][0], z, 0, 0, 0), re1 = __builtin_amdgcn_mfma_f32_32x32x16_bf16(af, bb[0][1], z, 0, 0, 0);
        f32x16 im0 = __builtin_amdgcn_mfma_f32_32x32x16_bf16(af, bb[1][0], z, 0, 0, 0), im1 = __builtin_amdgcn_mfma_f32_32x32x16_bf16(af, bb[1][1], z, 0, 0, 0);
#pragma unroll
        for (int r = 0; r < 16; ++r) {
            { const float nr = ar[0] * hr[0] - ai[0] * hi[0] + re0[r], ni = ar[0] * hi[0] + ai[0] * hr[0] + im0[r]; hr[0] = nr; hi[0] = ni; re0[r] = nr; im0[r] = ni; }
            { const float nr = ar[1] * hr[1] - ai[1] * hi[1] + re1[r], ni = ar[1] * hi[1] + ai[1] * hr[1] + im1[r]; hr[1] = nr; hi[1] = ni; re1[r] = nr; im1[r] = ni; }
        }
        if (APPLY) {
#pragma unroll
            for (int r = 0; r < 16; ++r) { const int rho = (r & 3) + 4 * kh + 8 * (r >> 2);
                hl[rho * 136 + c31] = (bf16)f2bf(re0[r]); hl[rho * 136 + 32 + c31] = (bf16)f2bf(re1[r]);
                hl[rho * 136 + 64 + c31] = (bf16)f2bf(im0[r]); hl[rho * 136 + 96 + c31] = (bf16)f2bf(im1[r]); }
            f32x16 y = zero16();
#pragma unroll
            for (int s = 0; s < 8; ++s) { const bf16x8 hA = *(const LAS bf16x8*)(hl + c31 * 136 + 16 * s + 8 * kh); y = __builtin_amdgcn_mfma_f32_32x32x16_bf16(hA, cb[s], y, 0, 0, 0); }
            if (c31 < 16) {
#pragma unroll
                for (int r = 0; r < 16; ++r) { LAS bf16* up = ubase + (st * 16 + r) * (TROW / 2);
                    const float u = bf2f(*up); *up = (bf16)f2bf(gelu_tanh(y[r] + dsk * u)); } }
        }
    }
#pragma unroll
    for (int ph = 0; ph < 2; ++ph) { const size_t sidx = (size_t)g * NST + ph * 32 + c31;
        if (!APPLY) { C.ssr[(size_t)(b * S5_NCH + myc) * 4096 + sidx] = hr[ph]; C.ssi[(size_t)(b * S5_NCH + myc) * 4096 + sidx] = hi[ph]; }
        else if (myc == S5_NCH - 1) { C.out[O_RP + (size_t)b * 4096 + sidx] = hr[ph]; C.out[O_IP + (size_t)b * 4096 + sidx] = hi[ph]; } }
    __syncthreads();
    if (APPLY) {
        const int rr = C.tid >> 4, cc = (C.tid & 15) * 8;
#pragma unroll
        for (int i = 0; i < 8; ++i) *(v4u*)(C.GY + (size_t)(rowX + i * 32 + rr) * W_SSM + go * 128 + cc) = *(const LAS v4u*)(tile + (i * 32 + rr) * TROW + cc * 2);
        __syncthreads();
    }
}

template <bool APPLY>
__device__ __forceinline__ void lru_block(const Ctx& C, int U) {
    const int lane = C.lane, c31 = lane & 31, kh = lane >> 5, sub = C.wave >> 2, jt = C.wave & 3;
    const int asel = (c31 >> 2) & 1, atok = (c31 & 3) + 4 * (c31 >> 3);
    const int cmb = 2 * U + sub, hd = cmb & 7, q = cmb >> 3;
    const int b = q >> 4, cX = 2 * (q & 15), myc = cX + kh;
    const int rowX = b * SEQ + cX * LR_TC;
    const int ch = hd * HDIM + jt * 32 + c31;
    LAS unsigned char* tin = C.lds + sub * TILE128;
    LAS unsigned char* tout = C.lds + 2 * TILE128 + sub * TILE128;
    {
        const int tt = C.tid & 255, rr = tt >> 4, c0 = hd * HDIM + (tt & 15) * 8;
        f32x4 cw0[4], cw1[4];
#pragma unroll
        for (int d = 0; d < 4; ++d) { cw0[d] = *(const f32x4*)(C.conv_w + (3 - d) * W_LRU + c0); cw1[d] = *(const f32x4*)(C.conv_w + (3 - d) * W_LRU + c0 + 4); }
        const f32x4 cb0 = *(const f32x4*)(C.conv_b + c0), cb1 = *(const f32x4*)(C.conv_b + c0 + 4);
#pragma unroll 2
        for (int i = 0; i < 8; ++i) { const int r = i * 16 + rr, row = rowX + r, t = row & (SEQ - 1);
            f32x4 a0 = cb0, a1 = cb1;
#pragma unroll
            for (int d = 0; d < 4; ++d) {
                if (t - d >= 0) { const v4u u = *(const v4u*)(C.P + (size_t)(row - d) * NPROJ + c0);
                    a0[0] += cw0[d][0] * bflo(u.x); a0[1] += cw0[d][1] * bfhi(u.x); a0[2] += cw0[d][2] * bflo(u.y); a0[3] += cw0[d][3] * bfhi(u.y);
                    a1[0] += cw1[d][0] * bflo(u.z); a1[1] += cw1[d][1] * bfhi(u.z); a1[2] += cw1[d][2] * bflo(u.w); a1[3] += cw1[d][3] * bfhi(u.w); } }
            v4u o; o.x = pk2(a0[0], a0[1]); o.y = pk2(a0[2], a0[3]); o.z = pk2(a1[0], a1[1]); o.w = pk2(a1[2], a1[3]);
            *(LAS v4u*)(tin + r * TROW + (tt & 15) * 16) = o; }
    }
    bf16x8 wa[8], wx[8];
#pragma unroll
    for (int s = 0; s < 8; ++s) { float ta[8], tx[8];
#pragma unroll
        for (int j = 0; j < 8; ++j) { const size_t wi = (size_t)(hd * HDIM + 16 * s + 8 * kh + j) * HDIM + jt * 32 + c31; ta[j] = C.w_rga[wi]; tx[j] = C.w_rgx[wi]; }
        wa[s] = pack8((f32x4){ta[0], ta[1], ta[2], ta[3]}, (f32x4){ta[4], ta[5], ta[6], ta[7]}); wx[s] = pack8((f32x4){tx[0], tx[1], tx[2], tx[3]}, (f32x4){tx[4], tx[5], tx[6], tx[7]}); }
    const float ba = C.b_rga[ch], bx = C.b_rgx[ch];
    const float lm = C.lam[ch];
    const float sp8 = 8.0f * (fmaxf(-lm, 0.f) + log1pf(expf(-fabsf(lm))));
    float h = 0.f, aprod = 1.f;
    if (APPLY) { float H = 0.f;
#pragma unroll
        for (int j = 0; j < LR_NCH - 1; ++j) { const float A = C.lra[(size_t)(b * LR_NCH + j) * W_LRU + ch], E = C.lre[(size_t)(b * LR_NCH + j) * W_LRU + ch]; const float nh = A * H + E; if (j < myc) H = nh; }
        h = H; }
    __syncthreads();
    const LAS unsigned char* abase = tin + (asel * LR_TC + atok) * TROW + 8 * kh * 2;
    const LAS bf16* ucb = (const LAS bf16*)(tin + (kh * LR_TC) * TROW) + jt * 32 + c31;
    LAS bf16* hob = (LAS bf16*)(tout + (kh * LR_TC) * TROW) + jt * 32 + c31;
    for (int st = 0; st < LR_TC / 16; ++st) {
        f32x16 pr = zero16(), pi = zero16();
#pragma unroll
        for (int s = 0; s < 8; ++s) { const bf16x8 af = *(const LAS bf16x8*)(abase + st * 16 * TROW + 32 * s);
            pr = __builtin_amdgcn_mfma_f32_32x32x16_bf16(af, wa[s], pr, 0, 0, 0); pi = __builtin_amdgcn_mfma_f32_32x32x16_bf16(af, wx[s], pi, 0, 0, 0); }
#pragma unroll
        for (int r = 0; r < 16; ++r) {
            const float uc = bf2f(ucb[(st * 16 + r) * (TROW / 2)]);
            const float rr = sigm(pr[r] + ba), ii = sigm(pi[r] + bx);
            const float la = -sp8 * rr, a = __builtin_amdgcn_exp2f(1.44269504f * la);
            const float t2 = 2.0f * la;
            const float om = t2 > -0.25f ? -t2 * (1.0f + t2 * (0.5f + t2 * (0.16666667f + t2 * (0.041666668f + t2 * (0.008333334f + t2 * 0.0013888889f))))) : 1.0f - a * a;
            const float mult = sqrtf(fmaxf(om, 0.f));
            h = a * h + mult * ii * uc; aprod *= a;
            if (APPLY) hob[(st * 16 + r) * (TROW / 2)] = (bf16)f2bf(h); }
    }
    if (!APPLY) { C.lra[(size_t)(b * LR_NCH + myc) * W_LRU + ch] = aprod; C.lre[(size_t)(b * LR_NCH + myc) * W_LRU + ch] = h; }
    else if (myc == LR_NCH - 1) C.out[O_LP + (size_t)b * W_LRU + ch] = h;
    __syncthreads();
    if (APPLY) {
        const int tt = C.tid & 255, rr = tt >> 4, cc = (tt & 15) * 8;
#pragma unroll
        for (int i = 0; i < 8; ++i) *(v4u*)(C.HS + (size_t)(rowX + i * 16 + rr) * W_LRU + hd * HDIM + cc) = *(const LAS v4u*)(tout + (i * 16 + rr) * TROW + cc * 2);
        __syncthreads();
    }
}

__device__ __forceinline__ void lru_sample_unit(const Ctx& C, int s, int hd, int jh, LAS unsigned char* wl) {
    LAS float* ucl = (LAS float*)wl;
    const size_t row = (size_t)(MP + s);
#pragma unroll
    for (int t = 0; t < 2; ++t) { const int i = C.lane + 64 * t, ci = hd * HDIM + i;
        const float u = bf2f(C.P[row * NPROJ + ci]);
        const float s0 = C.st_conv[(size_t)(s * 3 + 0) * W_LRU + ci], s1 = C.st_conv[(size_t)(s * 3 + 1) * W_LRU + ci], s2 = C.st_conv[(size_t)(s * 3 + 2) * W_LRU + ci];
        ucl[i] = C.conv_b[ci] + C.conv_w[ci] * s0 + C.conv_w[W_LRU + ci] * s1 + C.conv_w[2 * W_LRU + ci] * s2 + C.conv_w[3 * W_LRU + ci] * u;
        if (t == jh) { C.out[O_CS + (size_t)(s * 3 + 0) * W_LRU + ci] = s1; C.out[O_CS + (size_t)(s * 3 + 1) * W_LRU + ci] = s2; C.out[O_CS + (size_t)(s * 3 + 2) * W_LRU + ci] = u; } }
    LDS_WAIT(); asm volatile("" ::: "memory");
    const int j = jh * 64 + C.lane, cj = hd * HDIM + j;
    float accr = 0.f, acci = 0.f;
#pragma unroll 8
    for (int i = 0; i < HDIM; ++i) { const float uv = ucl[i]; const size_t wi = (size_t)(hd * HDIM + i) * HDIM + j; accr += uv * C.w_rga[wi]; acci += uv * C.w_rgx[wi]; }
    const float lm = C.lam[cj];
    const float sp8 = 8.0f * (fmaxf(-lm, 0.f) + log1pf(expf(-fabsf(lm))));
    const float rr = sigm(accr + C.b_rga[cj]), ii = sigm(acci + C.b_rgx[cj]);
    const float la = -sp8 * rr, a = __expf(la), mult = sqrtf(fmaxf(-expm1f(2.0f * la), 0.f));
    const float h = a * C.st_lru[(size_t)s * W_LRU + cj] + mult * ii * ucl[j];
    C.out[O_LS + (size_t)s * W_LRU + cj] = h;
    C.HS[row * W_LRU + cj] = (bf16)f2bf(h);
    LDS_WAIT(); asm volatile("" ::: "memory");
}
__device__ __forceinline__ void s5_sample_unit(const Ctx& C, int s, int g) {
    const size_t row = (size_t)(MP + s); const int p = C.lane, idx = g * NST + p;
    const v4u u0 = *(const v4u*)(C.P + row * NPROJ + W_LRU + g * GSZ), u1 = *(const v4u*)(C.P + row * NPROJ + W_LRU + g * GSZ + 8);
    float u[16] = {bflo(u0.x), bfhi(u0.x), bflo(u0.y), bfhi(u0.y), bflo(u0.z), bfhi(u0.z), bflo(u0.w), bfhi(u0.w), bflo(u1.x), bfhi(u1.x), bflo(u1.y), bfhi(u1.y), bflo(u1.z), bfhi(u1.z), bflo(u1.w), bfhi(u1.w)};
    float bur = 0.f, bui = 0.f;
#pragma unroll
    for (int k4 = 0; k4 < 4; ++k4) { const f32x4 br = *(const f32x4*)(C.bbr + (size_t)idx * 16 + 4 * k4), bi = *(const f32x4*)(C.bbi + (size_t)idx * 16 + 4 * k4);
#pragma unroll
        for (int i = 0; i < 4; ++i) { bur += br[i] * u[4 * k4 + i]; bui += bi[i] * u[4 * k4 + i]; } }
    const float ar = C.abr[idx], ai = C.abi[idx];
    const float h0r = C.st_re[(size_t)s * 4096 + idx], h0i = C.st_im[(size_t)s * 4096 + idx];
    const float hr = ar * h0r - ai * h0i + bur, hi = ar * h0i + ai * h0r + bui;
    C.out[O_RS + (size_t)s * 4096 + idx] = hr; C.out[O_IS + (size_t)s * 4096 + idx] = hi;
    float yk = 0.f;
#pragma unroll
    for (int k = 0; k < 16; ++k) { const float v = wave_sum(C.c_re[(size_t)(g * GSZ + k) * NST + p] * hr - C.c_im[(size_t)(g * GSZ + k) * NST + p] * hi); if (p == k) yk = v; }
    if (p < 16) { const int ch = g * GSZ + p; const float ul = bf2f(C.P[row * NPROJ + W_LRU + ch]);
        C.GY[row * W_SSM + ch] = (bf16)f2bf(gelu_tanh(yk + C.ssm_d[ch] * ul)); }
}

template <int MF, int NF, int UNR, class Epi>
__device__ __forceinline__ void skinny_gemm(const Ctx& C, const bf16* A, const bf16* Wt, int K, int ncb, const Epi& E) {
    constexpr int RB = MF * 16, NRB = 128 / RB;
    const int ntiles = NRB * ncb, l15 = C.lane & 15, kg = C.lane >> 4, kw = K / NWAVES;
    LAS f32x4* part = (LAS f32x4*)C.lds;
    for (int t = blockIdx.x; t < ntiles; t += C.G) {
        const int rb = t % NRB, cb = t / NRB;
        f32x4 acc[MF][NF];
#pragma unroll
        for (int i = 0; i < MF; ++i)
#pragma unroll
            for (int j = 0; j < NF; ++j) acc[i][j] = (f32x4){0.f, 0.f, 0.f, 0.f};
        const bf16* Ap = A + (size_t)(rb * RB + l15) * K + C.wave * kw + 8 * kg;
        const bf16* Bp[NF];
#pragma unroll
        for (int j = 0; j < NF; ++j) Bp[j] = Wt + (size_t)(E.brow(cb, j) + l15) * K + C.wave * kw + 8 * kg;
#pragma unroll UNR
        for (int ks = 0; ks < kw / 32; ++ks) {
            bf16x8 a[MF], b[NF];
#pragma unroll
            for (int i = 0; i < MF; ++i) a[i] = *(const bf16x8*)(Ap + (size_t)i * 16 * K + ks * 32);
#pragma unroll
            for (int j = 0; j < NF; ++j) b[j] = *(const bf16x8*)(Bp[j] + ks * 32);
#pragma unroll
            for (int i = 0; i < MF; ++i)
#pragma unroll
                for (int j = 0; j < NF; ++j) acc[i][j] = __builtin_amdgcn_mfma_f32_16x16x32_bf16(b[j], a[i], acc[i][j], 0, 0, 0);
        }
#pragma unroll
        for (int i = 0; i < MF; ++i)
#pragma unroll
            for (int j = 0; j < NF; ++j) part[((C.wave * MF + i) * NF + j) * 64 + C.lane] = acc[i][j];
        __syncthreads();
        for (int q = C.tid; q < MF * 64; q += NWAVES * 64) { const int mf = q >> 6, l64 = q & 63;
            f32x4 v[NF];
#pragma unroll
            for (int j = 0; j < NF; ++j) { f32x4 s = part[((0 * MF + mf) * NF + j) * 64 + l64];
#pragma unroll
                for (int wv = 1; wv < NWAVES; ++wv) s += part[((wv * MF + mf) * NF + j) * 64 + l64];
                v[j] = s; }
            E(rb * RB + mf * 16 + (l64 & 15), cb, l64 >> 4, v); }
        __syncthreads();
    }
}
struct SEpiProj { bf16* P;
    __device__ __forceinline__ int brow(int cb, int nf) const { return cb * 32 + nf * 16; }
    __device__ __forceinline__ void operator()(int r, int cb, int cq, const f32x4 (&v)[2]) const {
#pragma unroll
        for (int nf = 0; nf < 2; ++nf) { const int col = cb * 32 + nf * 16 + 4 * cq; f32x4 x = v[nf];
            if (col >= 2048) {
#pragma unroll
                for (int i = 0; i < 4; ++i) x[i] = sigm(x[i]); }
            v2u w; w.x = pk2(x[0], x[1]); w.y = pk2(x[2], x[3]); *(v2u*)(P + (size_t)(MP + r) * NPROJ + col) = w; } } };
struct SEpiGateA { bf16* T; const bf16* P;
    __device__ __forceinline__ int brow(int cb, int nf) const { return cb * 32 + nf * 16; }
    __device__ __forceinline__ void operator()(int r, int cb, int cq, const f32x4 (&v)[2]) const {
#pragma unroll
        for (int nf = 0; nf < 2; ++nf) { const int col = cb * 32 + nf * 16 + 4 * cq; const f32x4 x = v[nf];
            const v2u g = *(const v2u*)(P + (size_t)(MP + r) * NPROJ + 2048 + col);
            v2u w; w.x = pk2(x[0] * bflo(g.x), x[1] * bfhi(g.x)); w.y = pk2(x[2] * bflo(g.y), x[3] * bfhi(g.y)); *(v2u*)(T + (size_t)(MP + r) * D_MODEL + col) = w; } } };
struct SEpiGlu { bf16* MG; const bf16* T; const bf16* P;
    __device__ __forceinline__ int brow(int cb, int nf) const { const int v0 = cb * 16; return (v0 >> 7) * 256 + (v0 & 127) + nf * 128; }
    __device__ __forceinline__ void operator()(int r, int cb, int cq, const f32x4 (&v)[2]) const {
        const int col = cb * 16 + 4 * cq; const f32x4 a = v[0], g = v[1];
        const v2u t = *(const v2u*)(T + (size_t)(MP + r) * D_MODEL + col), z = *(const v2u*)(P + (size_t)(MP + r) * NPROJ + 4096 + col);
        v2u w; w.x = pk2(bflo(t.x) + bflo(z.x) * (a[0] * sigm(g[0])), bfhi(t.x) + bfhi(z.x) * (a[1] * sigm(g[1])));
        w.y = pk2(bflo(t.y) + bflo(z.y) * (a[2] * sigm(g[2])), bfhi(t.y) + bfhi(z.y) * (a[3] * sigm(g[3])));
        *(v2u*)(MG + (size_t)(MP + r) * D_MODEL + col) = w; } };
struct SEpiRes { const float* xin; float* out; const float* modt; int goff;
    __device__ __forceinline__ int brow(int cb, int nf) const { return cb * 32 + nf * 16; }
    __device__ __forceinline__ void operator()(int r, int cb, int cq, const f32x4 (&v)[2]) const {
#pragma unroll
        for (int nf = 0; nf < 2; ++nf) { const int col = cb * 32 + nf * 16 + 4 * cq;
            const f32x4 g = *(const f32x4*)(modt + (size_t)(4 + r) * MODN + goff + col), xv = *(const f32x4*)(xin + (size_t)r * D_MODEL + col);
            *(f32x4*)(out + (size_t)r * D_MODEL + col) = xv + g * v[nf]; } } };
struct SEpiRelu2 { bf16* O;
    __device__ __forceinline__ int brow(int cb, int nf) const { return cb * 32 + nf * 16; }
    __device__ __forceinline__ void operator()(int r, int cb, int cq, const f32x4 (&v)[2]) const {
#pragma unroll
        for (int nf = 0; nf < 2; ++nf) { const int col = cb * 32 + nf * 16 + 4 * cq; f32x4 x = v[nf];
#pragma unroll
            for (int i = 0; i < 4; ++i) { const float a = fmaxf(x[i], 0.f); x[i] = a * a; }
            v2u w; w.x = pk2(x[0], x[1]); w.y = pk2(x[2], x[3]); *(v2u*)(O + (size_t)(MP + r) * D_FF + col) = w; } } };

enum { PH_P0 = 0, PH_MOD, PH_H1, PH_G1, PH_SA, PH_SB, PH_G3, PH_G4, PH_G5, PH_H2, PH_G6, PH_G7, PH_FIN, N_PHASES };

__global__ void __launch_bounds__(NWAVES * 64, 2) hybrid_fwd(Args args) {
    extern __shared__ __attribute__((aligned(16))) unsigned char lds[];
    Ctx C;
    C.lds = (LAS unsigned char*)lds;
    C.tid = threadIdx.x; C.lane = C.tid & 63; C.wave = __builtin_amdgcn_readfirstlane(C.tid >> 6);
    C.G = gridDim.x; { const int bx = blockIdx.x; C.vcu = (C.G % 8 == 0) ? (bx % 8) * (C.G / 8) + bx / 8 : bx; }
    C.gw = C.vcu * NWAVES + C.wave; C.NGW = C.G * NWAVES;
    C.xp = (const float*)args.in[0]; C.xs = (const float*)args.in[1]; C.st_conv = (const float*)args.in[2]; C.st_lru = (const float*)args.in[3]; C.st_re = (const float*)args.in[4]; C.st_im = (const float*)args.in[5];
    C.c_p = (const float*)args.in[6]; C.c_s = (const float*)args.in[7]; C.w_ada = (const float*)args.in[8]; C.b_ada = (const float*)args.in[9]; C.g1 = (const float*)args.in[10]; C.g2 = (const float*)args.in[11];
    C.w_in = (const float*)args.in[12]; C.conv_w = (const float*)args.in[13]; C.conv_b = (const float*)args.in[14]; C.w_rga = (const float*)args.in[15]; C.b_rga = (const float*)args.in[16]; C.w_rgx = (const float*)args.in[17];
    C.b_rgx = (const float*)args.in[18]; C.lam = (const float*)args.in[19]; C.w_pa = (const float*)args.in[20]; C.a_re = (const float*)args.in[21]; C.a_im = (const float*)args.in[22]; C.log_dt = (const float*)args.in[23];
    C.b_re = (const float*)args.in[24]; C.b_im = (const float*)args.in[25]; C.c_re = (const float*)args.in[26]; C.c_im = (const float*)args.in[27]; C.ssm_d = (const float*)args.in[28]; C.w_glu = (const float*)args.in[29];
    C.w_out = (const float*)args.in[30]; C.w_up = (const float*)args.in[31]; C.w_dn = (const float*)args.in[32]; C.g_fin = (const float*)args.in[33];
    C.out = args.out; C.ws = args.ws;
    unsigned char* ws = args.ws;
    C.modt = (float*)(ws + WS_MOD); C.silu = (bf16*)(ws + WS_TAB + TB_SILU);
    C.abr = (float*)(ws + WS_TAB + TB_ABR); C.abi = (float*)(ws + WS_TAB + TB_ABI); C.bbr = (float*)(ws + WS_TAB + TB_BBR); C.bbi = (float*)(ws + WS_TAB + TB_BBI);
    C.ssr = (float*)(ws + WS_TAB + TB_SSR); C.ssi = (float*)(ws + WS_TAB + TB_SSI); C.lra = (float*)(ws + WS_TAB + TB_LRA); C.lre = (float*)(ws + WS_TAB + TB_LRE);
    C.Win = (bf16*)(ws + WS_WIN); C.Wpa = (bf16*)(ws + WS_WPA); C.Wglu = (bf16*)(ws + WS_WGLU); C.Wout = (bf16*)(ws + WS_WOUT); C.Wup = (bf16*)(ws + WS_WUP); C.Wdn = (bf16*)(ws + WS_WDN);
    C.A = (bf16*)(ws + WS_A); C.P = (bf16*)(ws + WS_PROJ); C.HS = (bf16*)(ws + WS_HSEQ); C.GY = (bf16*)(ws + WS_GY); C.T = (bf16*)(ws + WS_T); C.UC = (bf16*)(ws + WS_UCONV); C.ACT = (bf16*)(ws + WS_ACT);

#if MK_ONE_LAUNCH
    for (int u = C.tid; u < (LDS_BYTES - LDSCTL_OFF) / 4; u += NWAVES * 64) ((LAS unsigned*)(C.lds + LDSCTL_OFF))[u] = 0u;
    __syncthreads();
    XcdBarrier bar = xcd_barrier_post((unsigned*)(ws + WS_CTL) + CW_BAR, (volatile LAS unsigned*)(C.lds + MISC_OFF) + 8);
#define GRID_BAR() xcd_barrier(bar)
#else
#define GRID_BAR() do {} while (0)
#endif
    const int lo = args.ph_lo, hi = args.ph_hi;
#define IN(k) (lo <= (k) && (k) < hi)
#ifdef MK_PROBE
#define STAMP(k) do { if (blockIdx.x == 0 && C.tid == 0) { *(volatile LAS unsigned long long*)(C.lds + LDSCTL_OFF + 512 + 8 * ((k) + 1)) = __builtin_amdgcn_s_memrealtime(); } } while (0)
#else
#define STAMP(k) do {} while (0)
#endif
#define SEAM(k) do { if (IN(k) && IN((k) + 1)) GRID_BAR(); STAMP(k); } while (0)
    LAS unsigned char* wl = C.lds + C.wave * 16384;

    STAMP(-1);
    if (IN(PH_P0)) { p0_phase(C); } SEAM(PH_P0);
    if (IN(PH_MOD)) { mod_phase(C); } SEAM(PH_MOD);
    if (IN(PH_H1)) { norm_mod_phase(C, C.xp, C.xs, C.g1, 0, 2048, C.A); } SEAM(PH_H1);
    if (IN(PH_G1)) {
        pg8::Gemm g{C.A, C.Win, MP, NPROJ, D_MODEL}; pg8::StaticOrder S; S.init(MP, NPROJ, C.G, (int)blockIdx.x);
        pg8::EpiProj E{C.P};
        pg8::gemm_phase<pg8::EpiProj, pg8::StaticOrder, PG8_ALIGN, PG8_SP2>(C.lds, g, S, E);
        skinny_gemm<2, 2, 4>(C, C.A + (size_t)MP * D_MODEL, C.Win, D_MODEL, NPROJ / 32, SEpiProj{C.P});
    } SEAM(PH_G1);
    if (IN(PH_SA)) {
        for (int u = blockIdx.x; u < 256; u += C.G) s5_block<false>(C, u & 7, u >> 3);
        for (int u = blockIdx.x; u < 256; u += C.G) lru_block<false>(C, u);
        for (int u = C.gw; u < MS * NHEAD * 2; u += C.NGW) lru_sample_unit(C, u >> 4, (u >> 1) & 7, u & 1, wl);
        for (int u = C.gw; u < MS * NGRP; u += C.NGW) s5_sample_unit(C, u >> 6, u & 63);
        new_conv_prompt(C);
    } SEAM(PH_SA);
    if (IN(PH_SB)) {
        for (int u = blockIdx.x; u < 256; u += C.G) s5_block<true>(C, u & 7, u >> 3);
        for (int u = blockIdx.x; u < 256; u += C.G) lru_block<true>(C, u);
    } SEAM(PH_SB);
    if (IN(PH_G3)) {
        pg8::Gemm g{C.HS, C.Wpa, MP, D_MODEL, W_LRU}; pg8::StaticOrder S; S.init(MP, D_MODEL, C.G, (int)blockIdx.x);
        pg8::EpiGateA E{C.T, C.P};
        pg8::gemm_phase<pg8::EpiGateA, pg8::StaticOrder, PG8_ALIGN, PG8_SP2>(C.lds, g, S, E);
        skinny_gemm<2, 2, 4>(C, C.HS + (size_t)MP * W_LRU, C.Wpa, W_LRU, D_MODEL / 32, SEpiGateA{C.T, C.P});
    } SEAM(PH_G3);
    if (IN(PH_G4)) {
        pg8::Gemm g{C.GY, C.Wglu, MP, 2 * D_MODEL, W_SSM}; pg8::StaticOrder S; S.init(MP, 2 * D_MODEL, C.G, (int)blockIdx.x);
        pg8::EpiGlu E{C.A, C.T, C.P};
        pg8::gemm_phase<pg8::EpiGlu, pg8::StaticOrder, PG8_ALIGN, PG8_SP2>(C.lds, g, S, E);
        skinny_gemm<2, 2, 4>(C, C.GY + (size_t)MP * W_SSM, C.Wglu, W_SSM, D_MODEL / 16, SEpiGlu{C.A, C.T, C.P});
    } SEAM(PH_G4);
    if (IN(PH_G5)) {
        pg8::Gemm g{C.A, C.Wout, MP, D_MODEL, D_MODEL}; pg8::StaticOrder S; S.init(MP, D_MODEL, C.G, (int)blockIdx.x);
        pg8::EpiRes E{C.xp, C.xs, C.out, C.modt, 2 * D_MODEL};
        pg8::gemm_phase<pg8::EpiRes, pg8::StaticOrder, PG8_ALIGN, PG8_SP2>(C.lds, g, S, E);
        skinny_gemm<2, 2, 4>(C, C.A + (size_t)MP * D_MODEL, C.Wout, D_MODEL, D_MODEL / 32, SEpiRes{C.xs, C.out + (size_t)MP * D_MODEL, C.modt, 2 * D_MODEL});
    } SEAM(PH_G5);
    if (IN(PH_H2)) { norm_mod_phase(C, C.out, C.out + (size_t)MP * D_MODEL, C.g2, 3 * D_MODEL, 4 * D_MODEL, C.A); } SEAM(PH_H2);
    if (IN(PH_G6)) {
        pg8::Gemm g{C.A, C.Wup, MP, D_FF, D_MODEL}; pg8::StaticOrder S; S.init(MP, D_FF, C.G, (int)blockIdx.x);
        pg8::EpiRelu2 E{C.ACT};
        pg8::gemm_phase<pg8::EpiRelu2, pg8::StaticOrder, PG8_ALIGN, PG8_SP2>(C.lds, g, S, E);
        skinny_gemm<8, 2, 2>(C, C.A + (size_t)MP * D_MODEL, C.Wup, D_MODEL, D_FF / 32, SEpiRelu2{C.ACT});
    } SEAM(PH_G6);
    if (IN(PH_G7)) {
        pg8::Gemm g{C.ACT, C.Wdn, MP, D_MODEL, D_FF}; pg8::StaticOrder S; S.init(MP, D_MODEL, C.G, (int)blockIdx.x);
        pg8::EpiRes E{C.out, C.out + (size_t)MP * D_MODEL, C.out, C.modt, 5 * D_MODEL};
        pg8::gemm_phase<pg8::EpiRes, pg8::StaticOrder, PG8_ALIGN, PG8_SP2>(C.lds, g, S, E);
        skinny_gemm<2, 2, 4>(C, C.ACT + (size_t)MP * D_FF, C.Wdn, D_FF, D_MODEL / 32, SEpiRes{C.out + (size_t)MP * D_MODEL, C.out + (size_t)MP * D_MODEL, C.modt, 5 * D_MODEL});
    } SEAM(PH_G7);
    if (IN(PH_FIN)) { final_norm_phase(C); }
#ifdef MK_PROBE
    STAMP(PH_FIN);
    if (blockIdx.x == 0 && C.tid == 0) {
        volatile LAS unsigned long long* ts = (volatile LAS unsigned long long*)(C.lds + LDSCTL_OFF + 512);
        const unsigned long long delay = (ts[MK_PROBE_A_HI + 1] - ts[MK_PROBE_A_LO]) * (unsigned long long)MK_PROBE_MUL;
        const unsigned long long t0 = __builtin_amdgcn_s_memrealtime();
        while (__builtin_amdgcn_s_memrealtime() - t0 < delay) __builtin_amdgcn_s_sleep(8);
    }
#endif
#undef IN
#undef SEAM
}

extern "C" void kernel_launch(void* const* d_in, const int* in_sizes, int n_in, void* d_out, int out_size, void* d_ws, size_t ws_size, hipStream_t stream) {
    static int grid = 0;
    if (grid == 0) {
        if (n_in != 34 || in_sizes[0] != MP * D_MODEL || (size_t)out_size != O_END || ws_size < WS_END) {
            fprintf(stderr, "kernel_launch: built for 34 inputs, out %zu floats, >= %zu bytes of workspace; got n_in %d, in0 %d, out %d, ws %zu; nothing launched\n", (size_t)O_END, (size_t)WS_END, n_in, n_in > 0 ? in_sizes[0] : -1, out_size, ws_size); grid = -1; return; }
        int dev = 0, cus = 0, per_cu = 0;
        if (hipGetDevice(&dev) != hipSuccess || hipDeviceGetAttribute(&cus, hipDeviceAttributeMultiprocessorCount, dev) != hipSuccess) { fprintf(stderr, "kernel_launch: device query failed\n"); grid = -1; return; }
        if (hipFuncSetAttribute((const void*)hybrid_fwd, hipFuncAttributeMaxDynamicSharedMemorySize, LDS_BYTES) != hipSuccess) { fprintf(stderr, "kernel_launch: hipFuncSetAttribute failed\n"); grid = -1; return; }
        if (hipOccupancyMaxActiveBlocksPerMultiprocessor(&per_cu, (const void*)hybrid_fwd, NWAVES * 64, LDS_BYTES) != hipSuccess || per_cu < 1) { fprintf(stderr, "kernel_launch: occupancy query says %d workgroups per CU\n", per_cu); per_cu = 1; }
        (void)hipGetLastError();
        grid = cus;
    }
    if (grid < 0) return;
    if (hipMemsetAsync((char*)d_ws + WS_CTL, 0, CTL_ZERO_BYTES, stream) != hipSuccess) { fprintf(stderr, "kernel_launch: memset failed\n"); return; }
    Args a{};
    for (int i = 0; i < 34; ++i) a.in[i] = d_in[i];
    a.out = (float*)d_out; a.ws = (unsigned char*)d_ws;
#if MK_ONE_LAUNCH
    a.ph_lo = 0; a.ph_hi = N_PHASES;
    hipLaunchKernelGGL(hybrid_fwd, dim3(grid), dim3(NWAVES * 64), LDS_BYTES, stream, a);
#else
    for (int p = 0; p < N_PHASES; ++p) { a.ph_lo = p; a.ph_hi = p + 1; hipLaunchKernelGGL(hybrid_fwd, dim3(grid), dim3(NWAVES * 64), LDS_BYTES, stream, a); }
#endif
    const hipError_t le = hipPeekAtLastError();
    if (le != hipSuccess) fprintf(stderr, "kernel_launch: launch failed: %s\n", hipGetErrorName(le));
}
```

```cpp
#include <hip/hip_runtime.h>
#include <cstdio>
#include <cstdint>
namespace pg8 {
#define PG8_LAS __attribute__((address_space(3)))
typedef unsigned short bf16_t;
typedef short bf16x8 __attribute__((ext_vector_type(8)));
typedef float f32x4 __attribute__((ext_vector_type(4)));
typedef unsigned u32x4 __attribute__((ext_vector_type(4)));
constexpr int BM = 256, BK = 64, HALF = 128, HTB = HALF * BK * 2  , STAGE_BYTES = 8 * HTB, NXCD = 8, WGM = 8;

__host__ __device__ __forceinline__ int lds_byte(int r, int c) { const int st = (r >> 4) * 2 + (c >> 5), rr = r & 15, cc = c & 31, ob = rr * 64 + cc * 2; return st * 1024 + (ob ^ (((ob >> 9) & 1) << 5)); }
__host__ __device__ __forceinline__ void stage_rc(int b, int& R, int& C) { const int st = b / 1024, sb = b % 1024, swz = sb ^ (((sb >> 9) & 1) << 5); R = (st >> 1) * 16 + swz / 64; C = (st & 1) * 32 + (swz % 64) / 2; }
__host__ __device__ __forceinline__ int perm32(int rho) { const int n = rho >> 4, i = rho & 15; return 8 * (i >> 2) + 4 * n + (i & 3); }

struct Unit { int pm, pn; };
struct Gemm { const bf16_t* A; const bf16_t* Bt; int M, N, K; };

struct StaticOrder {
    int nM, nN, nwg, G, c;
    __host__ __device__ void init(int M, int N, int G_, int c_) { nM = M / BM; nN = N / BM; nwg = nM * nN; G = G_; c = c_; }
    __host__ __device__ bool next(int i, Unit& u) const {
        const long L = (long)i * G + c; if (L >= nwg) return false;
        int wgid = (int)L; { const int q = nwg / NXCD, r = nwg % NXCD, xcd = wgid % NXCD, off = wgid / NXCD; wgid = (xcd < r ? xcd * (q + 1) : r * (q + 1) + (xcd - r) * q) + off; }
        const int nig = WGM * nN, gid = wgid / nig, fm = gid * WGM, gsz = (nM - fm) < WGM ? (nM - fm) : WGM;
        u.pm = fm + ((wgid % nig) % gsz); u.pn = (wgid % nig) / gsz; return true;
    }
    __device__ __forceinline__ void a_ready(const Unit&) const {}
    __device__ __forceinline__ void done(const Unit&) const {}
};

__device__ __forceinline__ unsigned cvt_pk_bf16(float lo, float hi) { unsigned r; asm volatile("v_cvt_pk_bf16_f32 %0, %1, %2" : "=v"(r) : "v"(lo), "v"(hi)); return r; }
constexpr int D_MODEL = 2048, MP = 8192  , MS = 128  , MR = MP + MS  , MODN = 6 * D_MODEL, NPROJ = 6144, D_FF = 8192;
__device__ __forceinline__ float bflo(unsigned w) { return __uint_as_float(w << 16); }
__device__ __forceinline__ float bfhi(unsigned w) { return __uint_as_float(w & 0xffff0000u); }
__device__ __forceinline__ float sigm(float x) { return __builtin_amdgcn_rcpf(1.0f + __builtin_amdgcn_exp2f(-1.44269504f * x)); }
__device__ __forceinline__ int mod_row(int row) { int r = row < MP ? (row >> 11) : (4 + row - MP); return r > 143 ? 143 : r; }

struct EpiProj {
    static constexpr bool PERM = true, AFTER_DRAIN = false;
    bf16_t* O;
    __device__ __forceinline__ void operator()(const f32x4 (&acc)[2][2][4][2], const Unit& u, int wr, int wc, int fr, int fq) const {
        const int row0 = u.pm * BM + wr * 64 + fr, col0 = u.pn * BM + wc * 32 + 8 * fq; const bool sg = u.pn >= 8;
#pragma unroll
        for (int ai = 0; ai < 2; ++ai)
#pragma unroll
            for (int m = 0; m < 4; ++m) { bf16_t* rowp = O + (size_t)(row0 + ai * HALF + m * 16) * NPROJ + col0;
#pragma unroll
                for (int bj = 0; bj < 2; ++bj) { f32x4 v0 = acc[ai][bj][m][0], v1 = acc[ai][bj][m][1];
                    if (sg) {
#pragma unroll
                        for (int i = 0; i < 4; ++i) { v0[i] = sigm(v0[i]); v1[i] = sigm(v1[i]); } }
                    u32x4 w; w.x = cvt_pk_bf16(v0[0], v0[1]); w.y = cvt_pk_bf16(v0[2], v0[3]); w.z = cvt_pk_bf16(v1[0], v1[1]); w.w = cvt_pk_bf16(v1[2], v1[3]);
                    *(u32x4*)(rowp + bj * HALF) = w; } }
    }
};
struct EpiGateA {
    static constexpr bool PERM = true, AFTER_DRAIN = false;
    bf16_t* T; const bf16_t* P;
    __device__ __forceinline__ void operator()(const f32x4 (&acc)[2][2][4][2], const Unit& u, int wr, int wc, int fr, int fq) const {
        const int row0 = u.pm * BM + wr * 64 + fr, col0 = u.pn * BM + wc * 32 + 8 * fq;
#pragma unroll
        for (int ai = 0; ai < 2; ++ai)
#pragma unroll
            for (int m = 0; m < 4; ++m) { const size_t row = (size_t)(row0 + ai * HALF + m * 16);
#pragma unroll
                for (int bj = 0; bj < 2; ++bj) { const int col = col0 + bj * HALF;
                    const u32x4 g = *(const u32x4*)(P + row * NPROJ + 2048 + col);
                    f32x4 v0 = acc[ai][bj][m][0], v1 = acc[ai][bj][m][1];
                    v0[0] *= bflo(g.x); v0[1] *= bfhi(g.x); v0[2] *= bflo(g.y); v0[3] *= bfhi(g.y); v1[0] *= bflo(g.z); v1[1] *= bfhi(g.z); v1[2] *= bflo(g.w); v1[3] *= bfhi(g.w);
                    u32x4 w; w.x = cvt_pk_bf16(v0[0], v0[1]); w.y = cvt_pk_bf16(v0[2], v0[3]); w.z = cvt_pk_bf16(v1[0], v1[1]); w.w = cvt_pk_bf16(v1[2], v1[3]);
                    *(u32x4*)(T + row * D_MODEL + col) = w; } }
    }
};
struct EpiGlu {
    static constexpr bool PERM = true, AFTER_DRAIN = false;
    bf16_t* MG; const bf16_t* T; const bf16_t* P;
    __device__ __forceinline__ void operator()(const f32x4 (&acc)[2][2][4][2], const Unit& u, int wr, int wc, int fr, int fq) const {
        const int row0 = u.pm * BM + wr * 64 + fr, vcol = u.pn * HALF + wc * 32 + 8 * fq;
#pragma unroll
        for (int ai = 0; ai < 2; ++ai)
#pragma unroll
            for (int m = 0; m < 4; ++m) { const size_t row = (size_t)(row0 + ai * HALF + m * 16);
                const u32x4 t = *(const u32x4*)(T + row * D_MODEL + vcol);
                const u32x4 z = *(const u32x4*)(P + row * NPROJ + 4096 + vcol);
                const f32x4 a0 = acc[ai][0][m][0], a1 = acc[ai][0][m][1], g0 = acc[ai][1][m][0], g1 = acc[ai][1][m][1];
                float o[8];
                o[0] = bflo(t.x) + bflo(z.x) * (a0[0] * sigm(g0[0])); o[1] = bfhi(t.x) + bfhi(z.x) * (a0[1] * sigm(g0[1]));
                o[2] = bflo(t.y) + bflo(z.y) * (a0[2] * sigm(g0[2])); o[3] = bfhi(t.y) + bfhi(z.y) * (a0[3] * sigm(g0[3]));
                o[4] = bflo(t.z) + bflo(z.z) * (a1[0] * sigm(g1[0])); o[5] = bfhi(t.z) + bfhi(z.z) * (a1[1] * sigm(g1[1]));
                o[6] = bflo(t.w) + bflo(z.w) * (a1[2] * sigm(g1[2])); o[7] = bfhi(t.w) + bfhi(z.w) * (a1[3] * sigm(g1[3]));
                u32x4 w; w.x = cvt_pk_bf16(o[0], o[1]); w.y = cvt_pk_bf16(o[2], o[3]); w.z = cvt_pk_bf16(o[4], o[5]); w.w = cvt_pk_bf16(o[6], o[7]);
                *(u32x4*)(MG + row * D_MODEL + vcol) = w; }
    }
};
struct EpiRes {
    static constexpr bool PERM = false, AFTER_DRAIN = false;
    const float* xp; const float* xs; float* out; const float* modt; int goff;
    __device__ __forceinline__ void operator()(const f32x4 (&acc)[2][2][4][2], const Unit& u, int wr, int wc, int fr, int fq) const {
        const int row0 = u.pm * BM + wr * 64 + fr, col0 = u.pn * BM + wc * 32 + 4 * fq;
#pragma unroll
        for (int ai = 0; ai < 2; ++ai)
#pragma unroll
            for (int m = 0; m < 4; ++m) { const int row = row0 + ai * HALF + m * 16;
                if (row < MR) {
                    const float* xr = row < MP ? xp + (size_t)row * D_MODEL : xs + (size_t)(row - MP) * D_MODEL;
                    const float* gr = modt + (size_t)mod_row(row) * MODN + goff;
                    float* orow = out + (size_t)row * D_MODEL;
#pragma unroll
                    for (int bj = 0; bj < 2; ++bj)
#pragma unroll
                        for (int n = 0; n < 2; ++n) { const int col = col0 + bj * HALF + n * 16;
                            const f32x4 g = *(const f32x4*)(gr + col); const f32x4 xv = *(const f32x4*)(xr + col);
                            *(f32x4*)(orow + col) = xv + g * acc[ai][bj][m][n]; } } }
    }
};
struct EpiRelu2 {
    static constexpr bool PERM = true, AFTER_DRAIN = false;
    bf16_t* O;
    __device__ __forceinline__ void operator()(const f32x4 (&acc)[2][2][4][2], const Unit& u, int wr, int wc, int fr, int fq) const {
        const int row0 = u.pm * BM + wr * 64 + fr, col0 = u.pn * BM + wc * 32 + 8 * fq;
#pragma unroll
        for (int ai = 0; ai < 2; ++ai)
#pragma unroll
            for (int m = 0; m < 4; ++m) { bf16_t* rowp = O + (size_t)(row0 + ai * HALF + m * 16) * D_FF + col0;
#pragma unroll
                for (int bj = 0; bj < 2; ++bj) { f32x4 v0 = acc[ai][bj][m][0], v1 = acc[ai][bj][m][1];
#pragma unroll
                    for (int i = 0; i < 4; ++i) { const float a = fmaxf(v0[i], 0.f), b = fmaxf(v1[i], 0.f); v0[i] = a * a; v1[i] = b * b; }
                    u32x4 w; w.x = cvt_pk_bf16(v0[0], v0[1]); w.y = cvt_pk_bf16(v0[2], v0[3]); w.z = cvt_pk_bf16(v1[0], v1[1]); w.w = cvt_pk_bf16(v1[2], v1[3]);
                    *(u32x4*)(rowp + bj * HALF) = w; } }
    }
};

template <class Epi, class Sched, bool ALIGN_EPI = false, bool SP2 = false>
__device__ __forceinline__ void gemm_phase(PG8_LAS unsigned char* lds, const Gemm g, const Sched& S, const Epi& E) {
    const int tid = threadIdx.x, wid = __builtin_amdgcn_readfirstlane(tid >> 6), lane = tid & 63, wr = wid >> 2, wc = wid & 3, fr = lane & 15, fq = lane >> 4;
    const int K = g.K, nt = K / BK;
    unsigned voffA[2], voffB[2];
#pragma unroll
    for (int i = 0; i < 2; ++i) { int R, C; stage_rc(tid * 16 + i * 8192, R, C); const int Rb = Epi::PERM ? ((R & ~31) + perm32(R & 31)) : R;
        voffA[i] = (unsigned)(R * K + C) * 2u; voffB[i] = (unsigned)(Rb * K + C) * 2u; }
    const size_t kstep = (size_t)(BK * 2);
    const size_t hstep = (size_t)HALF * K * 2;
    const size_t tstep = 2 * hstep;
    const unsigned ldsw = (unsigned)wid * 1024u;
    const int aoff = lds_byte(wr * 64 + fr, fq * 8), boff = lds_byte(wc * 32 + fr, fq * 8);
#define PG8_SA(b, h) (((b) * 2 + (h)) * HTB)
#define PG8_SB(b, h) ((4 + (b) * 2 + (h)) * HTB)
#define PG8_STAGE(bufoff, gbase, voff) do { _Pragma("unroll") for (int _i = 0; _i < 2; ++_i) \
        __builtin_amdgcn_global_load_lds((const unsigned*)((const char*)(gbase) + (voff)[_i]), (PG8_LAS unsigned*)(lds + (bufoff) + ldsw + _i * 8192), 16, 0, 0); } while (0)
#define PG8_LDA(dst, b, h) do { _Pragma("unroll") for (int m = 0; m < 4; ++m) _Pragma("unroll") for (int k = 0; k < 2; ++k) dst[m][k] = *(const PG8_LAS bf16x8*)(lds + PG8_SA(b, h) + aoff + m * 2048 + k * 1024); } while (0)
#define PG8_LDB(dst, b, h) do { _Pragma("unroll") for (int n = 0; n < 2; ++n) _Pragma("unroll") for (int k = 0; k < 2; ++k) dst[n][k] = *(const PG8_LAS bf16x8*)(lds + PG8_SB(b, h) + boff + n * 2048 + k * 1024); } while (0)
#define PG8_MMA(ai, bj, At, Bt) do { __builtin_amdgcn_s_setprio(1); _Pragma("unroll") for (int m = 0; m < 4; ++m) _Pragma("unroll") for (int n = 0; n < 2; ++n) _Pragma("unroll") for (int k = 0; k < 2; ++k) \
        acc[ai][bj][m][n] = __builtin_amdgcn_mfma_f32_16x16x32_bf16(Bt[n][k], At[m][k], acc[ai][bj][m][n], 0, 0, 0); __builtin_amdgcn_s_setprio(0); } while (0)
#define PG8_WAIT_V(n) asm volatile("s_waitcnt vmcnt(" #n ")" ::: "memory")
#define PG8_WAIT_L(n) asm volatile("s_waitcnt lgkmcnt(" #n ")" ::: "memory")
#define PG8_BAR __builtin_amdgcn_s_barrier()
#define PG8_SCHED __builtin_amdgcn_sched_barrier(0)
    Unit cur, nxt; int ui = 0;
    if (!S.next(0, cur)) return;
    f32x4 acc[2][2][4][2];
#pragma unroll
    for (int a = 0; a < 2; ++a)
#pragma unroll
        for (int b = 0; b < 2; ++b)
#pragma unroll
            for (int m = 0; m < 4; ++m)
#pragma unroll
                for (int n = 0; n < 2; ++n) acc[a][b][m][n] = (f32x4){0.f, 0.f, 0.f, 0.f};
    bf16x8 At[4][2], B0[2][2], B1[2][2];
    const char* cA = (const char*)g.A + (size_t)cur.pm * tstep; const char* cB = (const char*)g.Bt + (size_t)cur.pn * tstep;
    S.a_ready(cur);
    if constexpr (SP2) {
        PG8_STAGE(PG8_SB(0, 0), cB, voffB); PG8_STAGE(PG8_SB(0, 1), cB + hstep, voffB); PG8_STAGE(PG8_SA(0, 0), cA, voffA); PG8_STAGE(PG8_SA(0, 1), cA + hstep, voffA);
        if (wr == 1) PG8_BAR;
        PG8_WAIT_V(2); PG8_BAR;
        PG8_STAGE(PG8_SB(1, 0), cB + kstep, voffB); PG8_STAGE(PG8_SA(1, 0), cA + kstep, voffA); PG8_STAGE(PG8_SB(1, 1), cB + hstep + kstep, voffB);
        PG8_WAIT_V(6); PG8_BAR;
    } else {
        PG8_STAGE(PG8_SB(0, 0), cB, voffB); PG8_STAGE(PG8_SA(0, 0), cA, voffA); PG8_STAGE(PG8_SB(0, 1), cB + hstep, voffB); PG8_STAGE(PG8_SA(0, 1), cA + hstep, voffA);
        if (wr == 1) PG8_BAR;
        PG8_WAIT_V(4); PG8_BAR;
        PG8_STAGE(PG8_SB(1, 0), cB + kstep, voffB); PG8_STAGE(PG8_SA(1, 0), cA + kstep, voffA); PG8_STAGE(PG8_SB(1, 1), cB + hstep + kstep, voffB);
        PG8_WAIT_V(6); PG8_BAR;
    }
    for (;;) {
        const bool has_next = S.next(ui + 1, nxt);
        const char* nA = has_next ? (const char*)g.A + (size_t)nxt.pm * tstep : cA; const char* nB = has_next ? (const char*)g.Bt + (size_t)nxt.pn * tstep : cB;
        for (int t = 0; t < nt; t += 2) {
            const bool last = (t == nt - 2);
            const char* a1 = cA + (size_t)(t + 1) * kstep;
            const char* a2 = last ? nA : cA + (size_t)(t + 2) * kstep; const char* b2 = last ? nB : cB + (size_t)(t + 2) * kstep;
            const char* a3 = a2 + kstep; const char* b3 = b2 + kstep;
            if (last && has_next) S.a_ready(nxt);
            if constexpr (SP2) {
            PG8_LDB(B0, 0, 0); PG8_LDB(B1, 0, 1); PG8_SCHED; PG8_LDA(At, 0, 0); PG8_STAGE(PG8_SA(1, 1), a1 + hstep, voffA);
            PG8_WAIT_V(8); PG8_WAIT_L(0); PG8_BAR; PG8_MMA(0, 0, At, B0); PG8_MMA(0, 1, At, B1); PG8_BAR; PG8_SCHED;
            PG8_LDA(At, 0, 1); PG8_STAGE(PG8_SB(0, 0), b2, voffB); PG8_STAGE(PG8_SB(0, 1), b2 + hstep, voffB); PG8_STAGE(PG8_SA(0, 0), a2, voffA);
            PG8_WAIT_V(8); PG8_WAIT_L(0); PG8_BAR; PG8_MMA(1, 0, At, B0); PG8_MMA(1, 1, At, B1); PG8_BAR; PG8_SCHED;
            PG8_LDB(B0, 1, 0); PG8_LDB(B1, 1, 1); PG8_SCHED; PG8_LDA(At, 1, 0); PG8_STAGE(PG8_SA(0, 1), a2 + hstep, voffA);
            PG8_WAIT_V(8); PG8_WAIT_L(0); PG8_BAR; PG8_MMA(0, 0, At, B0); PG8_MMA(0, 1, At, B1); PG8_BAR; PG8_SCHED;
            PG8_LDA(At, 1, 1); PG8_STAGE(PG8_SB(1, 0), b3, voffB); PG8_STAGE(PG8_SB(1, 1), b3 + hstep, voffB); PG8_STAGE(PG8_SA(1, 0), a3, voffA);
            PG8_WAIT_V(8); PG8_WAIT_L(0); PG8_BAR; PG8_MMA(1, 0, At, B0); PG8_MMA(1, 1, At, B1); PG8_BAR; PG8_SCHED;
            } else {
            PG8_LDB(B0, 0, 0); PG8_SCHED; PG8_LDA(At, 0, 0); PG8_STAGE(PG8_SA(1, 1), a1 + hstep, voffA);
            PG8_WAIT_L(8); PG8_BAR; PG8_WAIT_L(0); PG8_MMA(0, 0, At, B0); PG8_BAR; PG8_SCHED;
            PG8_LDB(B1, 0, 1); PG8_STAGE(PG8_SB(0, 0), b2, voffB);
            PG8_BAR; PG8_WAIT_L(0); PG8_MMA(0, 1, At, B1); PG8_BAR;
            PG8_LDA(At, 0, 1); PG8_STAGE(PG8_SA(0, 0), a2, voffA);
            PG8_BAR; PG8_WAIT_L(0); PG8_MMA(1, 0, At, B0); PG8_BAR; PG8_SCHED;
            PG8_STAGE(PG8_SB(0, 1), b2 + hstep, voffB);
            PG8_WAIT_V(6); PG8_BAR; PG8_MMA(1, 1, At, B1); PG8_BAR;
            PG8_LDB(B0, 1, 0); PG8_SCHED; PG8_LDA(At, 1, 0); PG8_STAGE(PG8_SA(0, 1), a2 + hstep, voffA);
            PG8_WAIT_L(8); PG8_BAR; PG8_WAIT_L(0); PG8_MMA(0, 0, At, B0); PG8_BAR; PG8_SCHED;
            PG8_LDB(B1, 1, 1); PG8_STAGE(PG8_SB(1, 0), b3, voffB);
            PG8_BAR; PG8_WAIT_L(0); PG8_MMA(0, 1, At, B1); PG8_BAR;
            PG8_LDA(At, 1, 1); PG8_STAGE(PG8_SA(1, 0), a3, voffA);
            PG8_BAR; PG8_WAIT_L(0); PG8_MMA(1, 0, At, B0); PG8_BAR; PG8_SCHED;
            PG8_STAGE(PG8_SB(1, 1), b3 + hstep, voffB);
            PG8_WAIT_V(6); PG8_BAR; PG8_MMA(1, 1, At, B1); PG8_BAR;
            }
        }
        if constexpr (ALIGN_EPI) { if (wr == 0) PG8_BAR; }
        if constexpr (!Epi::AFTER_DRAIN) { E(acc, cur, wr, wc, fr, fq); S.done(cur); }
        if (!has_next) break;
#pragma unroll
        for (int a = 0; a < 2; ++a)
#pragma unroll
            for (int b = 0; b < 2; ++b)
#pragma unroll
                for (int m = 0; m < 4; ++m)
#pragma unroll
                    for (int n = 0; n < 2; ++n) acc[a][b][m][n] = (f32x4){0.f, 0.f, 0.f, 0.f};
        cur = nxt; cA = nA; cB = nB; ++ui;
        if constexpr (ALIGN_EPI) { if (wr == 1) PG8_BAR; }
    }
    PG8_WAIT_V(0);
    if constexpr (!ALIGN_EPI) { if (wr == 0) PG8_BAR; }
    PG8_BAR;
    if constexpr (Epi::AFTER_DRAIN) { E.fused(acc, cur, wr, wc, fr, fq, lds, wid, lane); S.done(cur); }
#undef PG8_SA
#undef PG8_SB
#undef PG8_STAGE
#undef PG8_LDA
#undef PG8_LDB
#undef PG8_MMA
#undef PG8_WAIT_V
#undef PG8_WAIT_L
#undef PG8_BAR
#undef PG8_SCHED
}
}
#ifndef PG8_SP2
#define PG8_SP2 true
#endif
#ifndef PG8_ALIGN
#define PG8_ALIGN true
#endif
#ifndef MK_ONE_LAUNCH
#define MK_ONE_LAUNCH 1
#endif

using pg8::D_MODEL; using pg8::MP; using pg8::MS; using pg8::MR; using pg8::MODN; using pg8::NPROJ; using pg8::D_FF;
constexpr int MPAD = 8448;
constexpr int SEQ = 2048, NB = 4, W_LRU = 1024, W_SSM = 1024, NHEAD = 8, HDIM = 128, NGRP = 64, NST = 64, GSZ = 16;
constexpr int S5_TC = 128, S5_NCH = SEQ / S5_TC;
constexpr int LR_TC = 64,  LR_NCH = SEQ / LR_TC;
constexpr float EPS = 1e-6f;
constexpr size_t O_YP = 0, O_YS = 16777216, O_CP = 17039360, O_LP = 17051648, O_RP = 17055744, O_IP = 17072128, O_CS = 17088512, O_LS = 17481728, O_RS = 17612800, O_IS = 18137088, O_END = 18661376;

constexpr size_t MiB = 1u << 20;
constexpr size_t WS_CTL = 0, CTL_ZERO_BYTES = 1 * MiB;
constexpr size_t WS_MOD = 1 * MiB;
constexpr size_t WS_TAB = 8 * MiB;
constexpr size_t TB_SILU = 0;
constexpr size_t TB_ABR = 1 * MiB, TB_ABI = TB_ABR + 16384;
constexpr size_t TB_BBR = TB_ABI + 16384, TB_BBI = TB_BBR + 262144;
constexpr size_t TB_SSR = 2 * MiB, TB_SSI = 3 * MiB;
constexpr size_t TB_LRA = 4 * MiB, TB_LRE = 4 * MiB + 524288;
constexpr size_t WS_WIN = 16 * MiB, WS_WPA = 40 * MiB, WS_WGLU = 44 * MiB, WS_WOUT = 52 * MiB, WS_WUP = 60 * MiB, WS_WDN = 92 * MiB;
constexpr size_t WS_A = 124 * MiB;
constexpr size_t WS_PROJ = 157 * MiB;
constexpr size_t WS_HSEQ = 256 * MiB, WS_GY = 273 * MiB;
constexpr size_t WS_T = 290 * MiB, WS_UCONV = WS_T;
constexpr size_t WS_ACT = 157 * MiB;
constexpr size_t WS_END = 323 * MiB;
static_assert(WS_ACT + (size_t)MPAD * D_FF * 2 <= WS_T && WS_T + (size_t)MPAD * D_MODEL * 2 <= WS_END && WS_PROJ + (size_t)MPAD * NPROJ * 2 <= WS_HSEQ, "d_ws map");
constexpr int CW_BAR = 4096;

constexpr int RING_BYTES = 131072, LDS_BYTES = 147456, LDSCTL_OFF = LDS_BYTES - 1024, MISC_OFF = LDSCTL_OFF + 320;
constexpr int NWAVES = 8;

#define GAS __attribute__((address_space(1)))
#define LAS __attribute__((address_space(3)))
typedef unsigned short bf16;
typedef unsigned v4u __attribute__((ext_vector_type(4)));
typedef unsigned v2u __attribute__((ext_vector_type(2)));
typedef float f32x4 __attribute__((ext_vector_type(4)));
typedef float f32x16 __attribute__((ext_vector_type(16)));
typedef short bf16x8 __attribute__((ext_vector_type(8)));
typedef GAS unsigned gu32;
#define RLX_AGENT __ATOMIC_RELAXED, __HIP_MEMORY_SCOPE_AGENT
#define LDS_WAIT() asm volatile("s_waitcnt lgkmcnt(0)" ::: "memory")
#define VM_WAIT() asm volatile("s_waitcnt vmcnt(0)" ::: "memory")
__device__ __forceinline__ unsigned f2bf(float f) { unsigned u = __builtin_bit_cast(unsigned, f); return (u + 0x7fffu + ((u >> 16) & 1u)) >> 16; }
__device__ __forceinline__ unsigned pk2(float lo, float hi) { return pg8::cvt_pk_bf16(lo, hi); }
__device__ __forceinline__ float bf2f(bf16 v) { return __uint_as_float((unsigned)v << 16); }
using pg8::bflo; using pg8::bfhi; using pg8::sigm;
__device__ __forceinline__ bf16x8 pack8(f32x4 a, f32x4 b) { v4u w; w.x = pk2(a[0], a[1]); w.y = pk2(a[2], a[3]); w.z = pk2(b[0], b[1]); w.w = pk2(b[2], b[3]); return __builtin_bit_cast(bf16x8, w); }
__device__ __forceinline__ float gelu_tanh(float v) {
    const float z = 0.7978845608f * (v + 0.044715f * v * v * v);
    const float t = __builtin_amdgcn_exp2f(2.885390082f * z);
    return v - v * __builtin_amdgcn_rcpf(1.0f + t);
}
__device__ __forceinline__ float wave_sum(float v) {
#pragma unroll
    for (int o = 1; o < 64; o <<= 1) v += __shfl_xor(v, o);
    return v;
}

#if MK_ONE_LAUNCH
#define XB_TMO      128
#define XB_XCNT(j)  (256  + 64 * (j))
#define XB_XSUB(j)  (1280 + 64 * (j))
#define XB_XGEN(j)  (2304 + 64 * (j))
#define XB_TOP      3328
#define XB_TOPGEN   3392
#define XCD_BAR_WORDS 3456
#define XB_SPIN_CAP (1u << 18)

__device__ __forceinline__ unsigned xb_ld(unsigned* p)              { return __hip_atomic_load(p, __ATOMIC_RELAXED, __HIP_MEMORY_SCOPE_AGENT); }
__device__ __forceinline__ unsigned xb_add(unsigned* p, unsigned v) { return __hip_atomic_fetch_add(p, v, __ATOMIC_RELAXED, __HIP_MEMORY_SCOPE_AGENT); }
__device__ __forceinline__ unsigned xb_xcc_id() { return (unsigned)__builtin_amdgcn_s_getreg((3 << 11) | 20) & 0xFu; }
#define XB_SPIN(cond, bar) do { unsigned _sp = 0; while (cond) { __builtin_amdgcn_s_sleep(1); \
    if ((++_sp & 255u) == 0u) { if (xb_ld(&(bar)[XB_TMO])) break; if (_sp > XB_SPIN_CAP) { atomicAdd(&(bar)[XB_TMO], 1u); break; } } } } while (0)

struct XcdBarrier {
    unsigned* bar; unsigned x;
    volatile LAS unsigned* st;
};

__device__ __forceinline__ XcdBarrier xcd_barrier_post(unsigned* bar, volatile LAS unsigned* st) {
    XcdBarrier b; b.bar = bar; b.x = xb_xcc_id(); b.st = st;
    if (threadIdx.x == 0) (void)xb_add(&bar[XB_XCNT(b.x)], 1u);
    return b;
}
__device__ __forceinline__ void xcd_barrier_complete(unsigned* bar, unsigned x, unsigned& nloc, unsigned& nx) {
    const unsigned G = gridDim.x * gridDim.y * gridDim.z;
    unsigned sum, cnt, mine, sp = 0u;
    for (;;) {
        sum = 0u; cnt = 0u; mine = 0u;
#pragma unroll
        for (unsigned j = 0; j < 16; ++j) { const unsigned c = xb_ld(&bar[XB_XCNT(j)]); sum += c; cnt += (c > 0u) ? 1u : 0u; mine = (j == x) ? c : mine; }
        if (sum == G) break;
        __builtin_amdgcn_s_sleep(1);
        if ((++sp & 255u) == 0u) { if (xb_ld(&bar[XB_TMO])) break; if (sp > XB_SPIN_CAP) { atomicAdd(&bar[XB_TMO], 1u); break; } }
    }
    nloc = mine > 0u ? mine : 1u; nx = cnt > 0u ? cnt : 1u;
}

__device__ __forceinline__ void xcd_barrier(const XcdBarrier& b) {
    asm volatile("s_waitcnt vmcnt(0)" ::: "memory");
    __syncthreads();
    if (threadIdx.x == 0) {
        unsigned* bar = b.bar;
        __builtin_amdgcn_s_waitcnt(0);
        unsigned nloc = b.st[0], nx = b.st[1];
        if (nloc == 0u) { xcd_barrier_complete(bar, b.x, nloc, nx); b.st[0] = nloc; b.st[1] = nx; }
        const unsigned old = xb_add(&bar[XB_XSUB(b.x)], 1u);
        const unsigned gen = old / nloc;
        if (old + 1u == (gen + 1u) * nloc) {
            __builtin_amdgcn_fence(__ATOMIC_RELEASE, "agent");
            asm volatile("s_waitcnt vmcnt(0)" ::: "memory");
            const unsigned og = xb_add(&bar[XB_TOP], 1u);
            const unsigned tg = og / nx;
            if (og + 1u == (tg + 1u) * nx) xb_add(&bar[XB_TOPGEN], 1u);
            else XB_SPIN(xb_ld(&bar[XB_TOPGEN]) == tg, bar);
            __builtin_amdgcn_fence(__ATOMIC_ACQUIRE, "agent");
            xb_add(&bar[XB_XGEN(b.x)], 1u);
            asm volatile("s_waitcnt vmcnt(0)" ::: "memory");
        } else {
            XB_SPIN(xb_ld(&bar[XB_XGEN(b.x)]) == gen, bar);
            __builtin_amdgcn_fence(__ATOMIC_ACQUIRE, "agent");
            asm volatile("s_waitcnt vmcnt(0)" ::: "memory");
        }
    }
    __syncthreads();
}

#endif

struct Args { const void* in[34]; float* out; unsigned char* ws; int ph_lo, ph_hi; };

struct Ctx {
    LAS unsigned char* lds; int tid, lane, wave, vcu, G, gw, NGW;
    const float *xp, *xs, *st_conv, *st_lru, *st_re, *st_im, *c_p, *c_s, *w_ada, *b_ada, *g1, *g2, *w_in, *conv_w, *conv_b, *w_rga, *b_rga, *w_rgx, *b_rgx, *lam, *w_pa;
    const float *a_re, *a_im, *log_dt, *b_re, *b_im, *c_re, *c_im, *ssm_d, *w_glu, *w_out, *w_up, *w_dn, *g_fin;
    float* out; unsigned char* ws;
    float* modt; bf16* silu; float *abr, *abi, *bbr, *bbi, *ssr, *ssi, *lra, *lre;
    bf16 *Win, *Wpa, *Wglu, *Wout, *Wup, *Wdn, *A, *P, *HS, *GY, *T, *UC, *ACT;
};

__device__ __forceinline__ void p0_transpose_item(const float* W, int K, int N, bf16* WT, int glu, LAS float* scr, int item, int lane) {
    const int nblk = N / 32, kb = item / nblk, nb = item % nblk, k0 = 64 * kb, n0 = 32 * nb;
#pragma unroll 8
    for (int i = 0; i < 32; ++i) { const int kk = 2 * i + (lane >> 5); scr[kk * 33 + (lane & 31)] = W[(size_t)(k0 + kk) * N + n0 + (lane & 31)]; }
    LDS_WAIT(); asm volatile("" ::: "memory");
    const int c = lane & 7;
    int d0 = n0; if (glu) d0 = n0 < 2048 ? ((n0 >> 7) * 256 + (n0 & 127)) : (((n0 - 2048) >> 7) * 256 + 128 + ((n0 - 2048) & 127));
#pragma unroll
    for (int j = 0; j < 4; ++j) { const int n = (lane >> 3) + 8 * j; const LAS float* s = scr + (8 * c) * 33 + n;
        v4u o; o.x = pk2(s[0 * 33], s[1 * 33]); o.y = pk2(s[2 * 33], s[3 * 33]); o.z = pk2(s[4 * 33], s[5 * 33]); o.w = pk2(s[6 * 33], s[7 * 33]);
        *(v4u*)(WT + (size_t)(d0 + n) * K + k0 + 8 * c) = o; }
    LDS_WAIT(); asm volatile("" ::: "memory");
}
__device__ __forceinline__ void p0_phase(const Ctx& C) {
    LAS float* scr = (LAS float*)(C.lds + C.wave * 16384);
    constexpr int I_IN = (2048 / 64) * (6144 / 32), I_PA = (1024 / 64) * (2048 / 32), I_GLU = (1024 / 64) * (4096 / 32), I_OUT = (2048 / 64) * (2048 / 32), I_UP = (2048 / 64) * (8192 / 32), I_DN = (8192 / 64) * (2048 / 32);
    constexpr int NIT = I_IN + I_PA + I_GLU + I_OUT + I_UP + I_DN;
    for (int it = C.gw; it < NIT; it += C.NGW) {
        int r = it;
        if (r < I_IN) { p0_transpose_item(C.w_in, 2048, 6144, C.Win, 0, scr, r, C.lane); continue; } r -= I_IN;
        if (r < I_PA) { p0_transpose_item(C.w_pa, 1024, 2048, C.Wpa, 0, scr, r, C.lane); continue; } r -= I_PA;
        if (r < I_GLU) { p0_transpose_item(C.w_glu, 1024, 4096, C.Wglu, 1, scr, r, C.lane); continue; } r -= I_GLU;
        if (r < I_OUT) { p0_transpose_item(C.w_out, 2048, 2048, C.Wout, 0, scr, r, C.lane); continue; } r -= I_OUT;
        if (r < I_UP) { p0_transpose_item(C.w_up, 2048, 8192, C.Wup, 0, scr, r, C.lane); continue; } r -= I_UP;
        p0_transpose_item(C.w_dn, 8192, 2048, C.Wdn, 0, scr, r, C.lane);
    }
    for (int r = C.gw; r < 144; r += C.NGW) {
        const float* src = r < 4 ? C.c_p + (size_t)r * D_MODEL : C.c_s + (size_t)(r < 132 ? r - 4 : 0) * D_MODEL;
#pragma unroll
        for (int j = 0; j < 4; ++j) { const int idx = j * 512 + C.lane * 8;
            f32x4 a = *(const f32x4*)(src + idx), b = *(const f32x4*)(src + idx + 4);
#pragma unroll
            for (int i = 0; i < 4; ++i) { a[i] = a[i] * sigm(a[i]); b[i] = b[i] * sigm(b[i]); }
            if (r >= 132) { a = (f32x4){0.f, 0.f, 0.f, 0.f}; b = a; }
            v4u o; o.x = pk2(a[0], a[1]); o.y = pk2(a[2], a[3]); o.z = pk2(b[0], b[1]); o.w = pk2(b[2], b[3]);
            *(v4u*)(C.silu + (size_t)r * D_MODEL + idx) = o; }
    }
    for (int g = C.gw; g < NGRP; g += C.NGW) {
        const int idx = g * NST + C.lane;
        const float ar = C.a_re[idx], ai = C.a_im[idx], dt = expf(C.log_dt[g]);
        const float mag = expf(dt * ar), ang = dt * ai;
        float sn, cs; sincosf(ang, &sn, &cs);
        const float abr = mag * cs, abi = mag * sn;
        const float den = ar * ar + ai * ai, nr = abr - 1.0f, ni = abi;
        const float qre = (nr * ar + ni * ai) / den, qim = (ni * ar - nr * ai) / den;
        C.abr[idx] = abr; C.abi[idx] = abi;
#pragma unroll
        for (int k4 = 0; k4 < 4; ++k4) { const f32x4 br = *(const f32x4*)(C.b_re + (size_t)idx * 16 + 4 * k4), bi = *(const f32x4*)(C.b_im + (size_t)idx * 16 + 4 * k4);
            *(f32x4*)(C.bbr + (size_t)idx * 16 + 4 * k4) = qre * br - qim * bi; *(f32x4*)(C.bbi + (size_t)idx * 16 + 4 * k4) = qre * bi + qim * br; }
    }
}

__device__ __forceinline__ void mod_phase(const Ctx& C) {
    const int n = C.lane & 15, kg = C.lane >> 4;
    LAS f32x4* part = (LAS f32x4*)C.lds;
    for (int u = blockIdx.x; u < MODN / 48; u += C.G) {
        const int n0 = u * 48;
        const float* Wp = C.w_ada + (size_t)(256 * C.wave + 8 * kg) * MODN + n0 + n;
        const bf16* Ap = C.silu + (size_t)n * D_MODEL + 256 * C.wave + 8 * kg;
        f32x4 acc[9][3];
#pragma unroll
        for (int i = 0; i < 9; ++i)
#pragma unroll
            for (int j = 0; j < 3; ++j) acc[i][j] = (f32x4){0.f, 0.f, 0.f, 0.f};
        float wc[3][8], wn[3][8];
#pragma unroll
        for (int f = 0; f < 3; ++f)
#pragma unroll
            for (int j = 0; j < 8; ++j) wc[f][j] = Wp[(size_t)j * MODN + 16 * f];
#pragma unroll 1
        for (int ks = 0; ks < 8; ++ks) {
            const int kn = ks + 1 < 8 ? ks + 1 : ks;
#pragma unroll
            for (int f = 0; f < 3; ++f)
#pragma unroll
                for (int j = 0; j < 8; ++j) wn[f][j] = Wp[(size_t)(kn * 32 + j) * MODN + 16 * f];
            bf16x8 bfr[3];
#pragma unroll
            for (int f = 0; f < 3; ++f) bfr[f] = pack8((f32x4){wc[f][0], wc[f][1], wc[f][2], wc[f][3]}, (f32x4){wc[f][4], wc[f][5], wc[f][6], wc[f][7]});
#pragma unroll
            for (int mf = 0; mf < 9; ++mf) { const bf16x8 a = *(const bf16x8*)(Ap + (size_t)mf * 16 * D_MODEL + ks * 32);
#pragma unroll
                for (int f = 0; f < 3; ++f) acc[mf][f] = __builtin_amdgcn_mfma_f32_16x16x32_bf16(bfr[f], a, acc[mf][f], 0, 0, 0); }
#pragma unroll
            for (int f = 0; f < 3; ++f)
#pragma unroll
                for (int j = 0; j < 8; ++j) wc[f][j] = wn[f][j];
        }
#pragma unroll
        for (int f = 0; f < 3; ++f) {
#pragma unroll
            for (int mf = 0; mf < 9; ++mf) part[(C.wave * 9 + mf) * 64 + C.lane] = acc[mf][f];
            __syncthreads();
            for (int e = C.tid; e < 9 * 64; e += NWAVES * 64) {
                f32x4 sm = part[e];
#pragma unroll
                for (int wv = 1; wv < 8; ++wv) sm += part[wv * 576 + e];
                const int mf = e >> 6, l64 = e & 63, row = mf * 16 + (l64 & 15), col = n0 + 16 * f + 4 * (l64 >> 4);
                *(f32x4*)(C.modt + (size_t)row * MODN + col) = sm + *(const f32x4*)(C.b_ada + col);
            }
            __syncthreads();
        }
    }
}

__device__ __forceinline__ void norm_mod_phase(const Ctx& C, const float* xp, const float* xs, const float* g, int sh_off, int sc_off, bf16* O) {
    const int r0 = (int)(((long)C.gw * MR) / C.NGW), r1 = (int)(((long)(C.gw + 1) * MR) / C.NGW);
    if (r0 >= r1) return;
    f32x4 gs[8], sh[8], v[8], vn[8];
    int cur_m = -1;
#pragma unroll
    for (int j = 0; j < 8; ++j) { const float* xr = r0 < MP ? xp + (size_t)r0 * D_MODEL : xs + (size_t)(r0 - MP) * D_MODEL; v[j] = *(const f32x4*)(xr + 256 * j + 4 * C.lane); }
    for (int row = r0; row < r1; ++row) {
        if (row + 1 < r1) { const float* xr = row + 1 < MP ? xp + (size_t)(row + 1) * D_MODEL : xs + (size_t)(row + 1 - MP) * D_MODEL;
#pragma unroll
            for (int j = 0; j < 8; ++j) vn[j] = *(const f32x4*)(xr + 256 * j + 4 * C.lane); }
        const int m = pg8::mod_row(row);
        if (m != cur_m) { cur_m = m; const float* mr = C.modt + (size_t)m * MODN;
#pragma unroll
            for (int j = 0; j < 8; ++j) { const int col = 256 * j + 4 * C.lane; gs[j] = *(const f32x4*)(g + col) * (1.0f + *(const f32x4*)(mr + sc_off + col)); sh[j] = *(const f32x4*)(mr + sh_off + col); } }
        float ss = 0.f;
#pragma unroll
        for (int j = 0; j < 8; ++j) ss += (v[j][0] * v[j][0] + v[j][1] * v[j][1]) + (v[j][2] * v[j][2] + v[j][3] * v[j][3]);
        const float rstd = 1.0f / sqrtf(wave_sum(ss) * (1.0f / D_MODEL) + EPS);
#pragma unroll
        for (int j = 0; j < 8; ++j) { const int col = 256 * j + 4 * C.lane;
            const f32x4 o = v[j] * rstd * gs[j] + sh[j];
            v2u w; w.x = pk2(o[0], o[1]); w.y = pk2(o[2], o[3]);
            *(v2u*)(O + (size_t)row * D_MODEL + col) = w; }
#pragma unroll
        for (int j = 0; j < 8; ++j) v[j] = vn[j];
    }
}
__device__ __forceinline__ void final_norm_phase(const Ctx& C) {
    const int r0 = (int)(((long)C.gw * MR) / C.NGW), r1 = (int)(((long)(C.gw + 1) * MR) / C.NGW);
    if (r0 >= r1) return;
    f32x4 gf[8], v[8], vn[8];
#pragma unroll
    for (int j = 0; j < 8; ++j) { gf[j] = *(const f32x4*)(C.g_fin + 256 * j + 4 * C.lane); v[j] = *(const f32x4*)(C.out + (size_t)r0 * D_MODEL + 256 * j + 4 * C.lane); }
    for (int row = r0; row < r1; ++row) {
        float* xr = C.out + (size_t)row * D_MODEL;
        if (row + 1 < r1) {
#pragma unroll
            for (int j = 0; j < 8; ++j) vn[j] = *(const f32x4*)(xr + D_MODEL + 256 * j + 4 * C.lane); }
        float ss = 0.f;
#pragma unroll
        for (int j = 0; j < 8; ++j) ss += (v[j][0] * v[j][0] + v[j][1] * v[j][1]) + (v[j][2] * v[j][2] + v[j][3] * v[j][3]);
        const float rstd = 1.0f / sqrtf(wave_sum(ss) * (1.0f / D_MODEL) + EPS);
#pragma unroll
        for (int j = 0; j < 8; ++j) *(f32x4*)(xr + 256 * j + 4 * C.lane) = v[j] * rstd * gf[j];
#pragma unroll
        for (int j = 0; j < 8; ++j) v[j] = vn[j];
    }
}

__device__ __forceinline__ f32x16 zero16() { return f32x16{}; }

constexpr int TROW = 272;
constexpr int TILE256 = 256 * TROW, TILE128 = 128 * TROW;
static_assert(TILE256 + NWAVES * 8704 <= LDSCTL_OFF && 4 * TILE128 <= LDSCTL_OFF, "scan LDS map");

__device__ __forceinline__ void new_conv_prompt(const Ctx& C) {
    const int nthr = C.G * NWAVES * 64;
    for (int idx = C.vcu * (NWAVES * 64) + C.tid; idx < NB * 3 * W_LRU; idx += nthr) {
        const int ch = idx & (W_LRU - 1), k = (idx >> 10) % 3, b = idx / (3 * W_LRU);
        C.out[O_CP + idx] = bf2f(C.P[(size_t)(b * SEQ + SEQ - 3 + k) * NPROJ + ch]);
    }
}

template <bool APPLY>
__device__ __forceinline__ void s5_block(const Ctx& C, int go, int q) {
    const int lane = C.lane, c31 = lane & 31, kh = lane >> 5, w = C.wave, g = go * 8 + w;
    const int asel = (c31 >> 2) & 1, atok = (c31 & 3) + 4 * (c31 >> 3);
    const int b = q >> 3, cX = 2 * (q & 7), myc = cX + kh;
    const int rowX = b * SEQ + cX * S5_TC;
    LAS unsigned char* tile = C.lds;
    {
        const int rr = C.tid >> 4, cc = (C.tid & 15) * 8;
        v4u tmp[8];
#pragma unroll
        for (int i = 0; i < 8; ++i) tmp[i] = *(const v4u*)(C.P + (size_t)(rowX + i * 32 + rr) * NPROJ + W_LRU + go * 128 + cc);
#pragma unroll
        for (int i = 0; i < 8; ++i) *(LAS v4u*)(tile + (i * 32 + rr) * TROW + cc * 2) = tmp[i];
    }
    bf16x8 bb[2][2]; float ar[2], ai[2], hr[2], hi[2];
#pragma unroll
    for (int ph = 0; ph < 2; ++ph) { const int idx = g * NST + ph * 32 + c31;
        ar[ph] = C.abr[idx]; ai[ph] = C.abi[idx]; hr[ph] = 0.f; hi[ph] = 0.f;
        const f32x4* sr = (const f32x4*)(C.bbr + (size_t)idx * 16 + 8 * kh); const f32x4* si = (const f32x4*)(C.bbi + (size_t)idx * 16 + 8 * kh);
        bb[0][ph] = pack8(sr[0], sr[1]); bb[1][ph] = pack8(si[0], si[1]); }
    bf16x8 cb[8];
    float dsk = 0.f;
    if (APPLY) {
#pragma unroll
        for (int ph = 0; ph < 2; ++ph) { float pr = ar[ph], pi = ai[ph];
#pragma unroll
            for (int s = 0; s < 7; ++s) { const float nr = pr * pr - pi * pi, ni = 2.0f * pr * pi; pr = nr; pi = ni; }
            const size_t sidx = (size_t)g * NST + ph * 32 + c31; float Hr = 0.f, Hi = 0.f;
#pragma unroll
            for (int j = 0; j < S5_NCH - 1; ++j) { const float sr = C.ssr[(size_t)(b * S5_NCH + j) * 4096 + sidx], si = C.ssi[(size_t)(b * S5_NCH + j) * 4096 + sidx];
                const float nr = pr * Hr - pi * Hi + sr, ni = pr * Hi + pi * Hr + si; if (j < myc) { Hr = nr; Hi = ni; } }
            hr[ph] = Hr; hi[ph] = Hi; }
#pragma unroll
        for (int s = 0; s < 8; ++s) { f32x4 a = (f32x4){0.f, 0.f, 0.f, 0.f}, bq = a;
            if (c31 < 16) { const float* src = (s < 4 ? C.c_re : C.c_im) + (size_t)(g * GSZ + c31) * NST + 16 * (s & 3) + 8 * kh; a = *(const f32x4*)src; bq = *(const f32x4*)(src + 4); if (s >= 4) { a = -a; bq = -bq; } }
            cb[s] = pack8(a, bq); }
        dsk = C.ssm_d[g * GSZ + (c31 & 15)];
    }
    __syncthreads();
    LAS bf16* hl = (LAS bf16*)(C.lds + TILE256 + w * 8704);
    const LAS unsigned char* abase = tile + (asel * S5_TC + atok) * TROW + (16 * w + 8 * kh) * 2;
    LAS bf16* ubase = (LAS bf16*)(tile + (kh * S5_TC) * TROW) + 16 * w + (c31 & 15);
    for (int st = 0; st < S5_TC / 16; ++st) {
        const bf16x8 af = *(const LAS bf16x8*)(abase + st * 16 * TROW);
        const f32x16 z = zero16();
        f32x16 re0 = __builtin_amdgcn_mfma_f32_32x32x16_bf16(af, bb[0][0], z, 0, 0, 0), re1 = __builtin_amdgcn_mfma_f32_32x32x16_bf16(af, bb[0][1], z, 0, 0, 0);
        f32x16 im0 = __builtin_amdgcn_mfma_f32_32x32x16_bf16(af, bb[1][0], z, 0, 0, 0), im1 = __builtin_amdgcn_mfma_f32_32x32x16_bf16(af, bb[1][1], z, 0, 0, 0);
#pragma unroll
        for (int r = 0; r < 16; ++r) {
            { const float nr = ar[0] * hr[0] - ai[0] * hi[0] + re0[r], ni = ar[0] * hi[0] + ai[0] * hr[0] + im0[r]; hr[0] = nr; hi[0] = ni; re0[r] = nr; im0[r] = ni; }
            { const float nr = ar[1] * hr[1] - ai[1] * hi[1] + re1[r], ni = ar[1] * hi[1] + ai[1] * hr[1] + im1[r]; hr[1] = nr; hi[1] = ni; re1[r] = nr; im1[r] = ni; }
        }
        if (APPLY) {
#pragma unroll
            for (int r = 0; r < 16; ++r) { const int rho = (r & 3) + 4 * kh + 8 * (r >> 2);
                hl[rho * 136 + c31] = (bf16)f2bf(re0[r]); hl[rho * 136 + 32 + c31] = (bf16)f2bf(re1[r]);
                hl[rho * 136 + 64 + c31] = (bf16)f2bf(im0[r]); hl[rho * 136 + 96 + c31] = (bf16)f2bf(im1[r]); }
            f32x16 y = zero16();
#pragma unroll
            for (int s = 0; s < 8; ++s) { const bf16x8 hA = *(const LAS bf16x8*)(hl + c31 * 136 + 16 * s + 8 * kh); y = __builtin_amdgcn_mfma_f32_32x32x16_bf16(hA, cb[s], y, 0, 0, 0); }
            if (c31 < 16) {
#pragma unroll
                for (int r = 0; r < 16; ++r) { LAS bf16* up = ubase + (st * 16 + r) * (TROW / 2);
                    const float u = bf2f(*up); *up = (bf16)f2bf(gelu_tanh(y[r] + dsk * u)); } }
        }
    }
#pragma unroll
    for (int ph = 0; ph < 2; ++ph) { const size_t sidx = (size_t)g * NST + ph * 32 + c31;
        if (!APPLY) { C.ssr[(size_t)(b * S5_NCH + myc) * 4096 + sidx] = hr[ph]; C.ssi[(size_t)(b * S5_NCH + myc) * 4096 + sidx] = hi[ph]; }
        else if (myc == S5_NCH - 1) { C.out[O_RP + (size_t)b * 4096 + sidx] = hr[ph]; C.out[O_IP + (size_t)b * 4096 + sidx] = hi[ph]; } }
    __syncthreads();
    if (APPLY) {
        const int rr = C.tid >> 4, cc = (C.tid & 15) * 8;
#pragma unroll
        for (int i = 0; i < 8; ++i) *(v4u*)(C.GY + (size_t)(rowX + i * 32 + rr) * W_SSM + go * 128 + cc) = *(const LAS v4u*)(tile + (i * 32 + rr) * TROW + cc * 2);
        __syncthreads();
    }
}

template <bool APPLY>
__device__ __forceinline__ void lru_block(const Ctx& C, int U) {
    const int lane = C.lane, c31 = lane & 31, kh = lane >> 5, sub = C.wave >> 2, jt = C.wave & 3;
    const int asel = (c31 >> 2) & 1, atok = (c31 & 3) + 4 * (c31 >> 3);
    const int cmb = 2 * U + sub, hd = cmb & 7, q = cmb >> 3;
    const int b = q >> 4, cX = 2 * (q & 15), myc = cX + kh;
    const int rowX = b * SEQ + cX * LR_TC;
    const int ch = hd * HDIM + jt * 32 + c31;
    LAS unsigned char* tin = C.lds + sub * TILE128;
    LAS unsigned char* tout = C.lds + 2 * TILE128 + sub * TILE128;
    {
        const int tt = C.tid & 255, rr = tt >> 4, c0 = hd * HDIM + (tt & 15) * 8;
        f32x4 cw0[4], cw1[4];
#pragma unroll
        for (int d = 0; d < 4; ++d) { cw0[d] = *(const f32x4*)(C.conv_w + (3 - d) * W_LRU + c0); cw1[d] = *(const f32x4*)(C.conv_w + (3 - d) * W_LRU + c0 + 4); }
        const f32x4 cb0 = *(const f32x4*)(C.conv_b + c0), cb1 = *(const f32x4*)(C.conv_b + c0 + 4);
#pragma unroll 2
        for (int i = 0; i < 8; ++i) { const int r = i * 16 + rr, row = rowX + r, t = row & (SEQ - 1);
            f32x4 a0 = cb0, a1 = cb1;
#pragma unroll
            for (int d = 0; d < 4; ++d) {
                if (t - d >= 0) { const v4u u = *(const v4u*)(C.P + (size_t)(row - d) * NPROJ + c0);
                    a0[0] += cw0[d][0] * bflo(u.x); a0[1] += cw0[d][1] * bfhi(u.x); a0[2] += cw0[d][2] * bflo(u.y); a0[3] += cw0[d][3] * bfhi(u.y);
                    a1[0] += cw1[d][0] * bflo(u.z); a1[1] += cw1[d][1] * bfhi(u.z); a1[2] += cw1[d][2] * bflo(u.w); a1[3] += cw1[d][3] * bfhi(u.w); } }
            v4u o; o.x = pk2(a0[0], a0[1]); o.y = pk2(a0[2], a0[3]); o.z = pk2(a1[0], a1[1]); o.w = pk2(a1[2], a1[3]);
            *(LAS v4u*)(tin + r * TROW + (tt & 15) * 16) = o; }
    }
    bf16x8 wa[8], wx[8];
#pragma unroll
    for (int s = 0; s < 8; ++s) { float ta[8], tx[8];
#pragma unroll
        for (int j = 0; j < 8; ++j) { const size_t wi = (size_t)(hd * HDIM + 16 * s + 8 * kh + j) * HDIM + jt * 32 + c31; ta[j] = C.w_rga[wi]; tx[j] = C.w_rgx[wi]; }
        wa[s] = pack8((f32x4){ta[0], ta[1], ta[2], ta[3]}, (f32x4){ta[4], ta[5], ta[6], ta[7]}); wx[s] = pack8((f32x4){tx[0], tx[1], tx[2], tx[3]}, (f32x4){tx[4], tx[5], tx[6], tx[7]}); }
    const float ba = C.b_rga[ch], bx = C.b_rgx[ch];
    const float lm = C.lam[ch];
    const float sp8 = 8.0f * (fmaxf(-lm, 0.f) + log1pf(expf(-fabsf(lm))));
    float h = 0.f, aprod = 1.f;
    if (APPLY) { float H = 0.f;
#pragma unroll
        for (int j = 0; j < LR_NCH - 1; ++j) { const float A = C.lra[(size_t)(b * LR_NCH + j) * W_LRU + ch], E = C.lre[(size_t)(b * LR_NCH + j) * W_LRU + ch]; const float nh = A * H + E; if (j < myc) H = nh; }
        h = H; }
    __syncthreads();
    const LAS unsigned char* abase = tin + (asel * LR_TC + atok) * TROW + 8 * kh * 2;
    const LAS bf16* ucb = (const LAS bf16*)(tin + (kh * LR_TC) * TROW) + jt * 32 + c31;
    LAS bf16* hob = (LAS bf16*)(tout + (kh * LR_TC) * TROW) + jt * 32 + c31;
    for (int st = 0; st < LR_TC / 16; ++st) {
        f32x16 pr = zero16(), pi = zero16();
#pragma unroll
        for (int s = 0; s < 8; ++s) { const bf16x8 af = *(const LAS bf16x8*)(abase + st * 16 * TROW + 32 * s);
            pr = __builtin_amdgcn_mfma_f32_32x32x16_bf16(af, wa[s], pr, 0, 0, 0); pi = __builtin_amdgcn_mfma_f32_32x32x16_bf16(af, wx[s], pi, 0, 0, 0); }
#pragma unroll
        for (int r = 0; r < 16; ++r) {
            const float uc = bf2f(ucb[(st * 16 + r) * (TROW / 2)]);
            const float rr = sigm(pr[r] + ba), ii = sigm(pi[r] + bx);
            const float la = -sp8 * rr, a = __builtin_amdgcn_exp2f(1.44269504f * la);
            const float t2 = 2.0f * la;
            const float om = t2 > -0.25f ? -t2 * (1.0f + t2 * (0.5f + t2 * (0.16666667f + t2 * (0.041666668f + t2 * (0.008333334f + t2 * 0.0013888889f))))) : 1.0f - a * a;
            const float mult = sqrtf(fmaxf(om, 0.f));
            h = a * h + mult * ii * uc; aprod *= a;
            if (APPLY) hob[(st * 16 + r) * (TROW / 2)] = (bf16)f2bf(h); }
    }
    if (!APPLY) { C.lra[(size_t)(b * LR_NCH + myc) * W_LRU + ch] = aprod; C.lre[(size_t)(b * LR_NCH + myc) * W_LRU + ch] = h; }
    else if (myc == LR_NCH - 1) C.out[O_LP + (size_t)b * W_LRU + ch] = h;
    __syncthreads();
    if (APPLY) {
        const int tt = C.tid & 255, rr = tt >> 4, cc = (tt & 15) * 8;
#pragma unroll
        for (int i = 0; i < 8; ++i) *(v4u*)(C.HS + (size_t)(rowX + i * 16 + rr) * W_LRU + hd * HDIM + cc) = *(const LAS v4u*)(tout + (i * 16 + rr) * TROW + cc * 2);
        __syncthreads();
    }
}

__device__ __forceinline__ void lru_sample_unit(const Ctx& C, int s, int hd, int jh, LAS unsigned char* wl) {
    LAS float* ucl = (LAS float*)wl;
    const size_t row = (size_t)(MP + s);
#pragma unroll
    for (int t = 0; t < 2; ++t) { const int i = C.lane + 64 * t, ci = hd * HDIM + i;
        const float u = bf2f(C.P[row * NPROJ + ci]);
        const float s0 = C.st_conv[(size_t)(s * 3 + 0) * W_LRU + ci], s1 = C.st_conv[(size_t)(s * 3 + 1) * W_LRU + ci], s2 = C.st_conv[(size_t)(s * 3 + 2) * W_LRU + ci];
        ucl[i] = C.conv_b[ci] + C.conv_w[ci] * s0 + C.conv_w[W_LRU + ci] * s1 + C.conv_w[2 * W_LRU + ci] * s2 + C.conv_w[3 * W_LRU + ci] * u;
        if (t == jh) { C.out[O_CS + (size_t)(s * 3 + 0) * W_LRU + ci] = s1; C.out[O_CS + (size_t)(s * 3 + 1) * W_LRU + ci] = s2; C.out[O_CS + (size_t)(s * 3 + 2) * W_LRU + ci] = u; } }
    LDS_WAIT(); asm volatile("" ::: "memory");
    const int j = jh * 64 + C.lane, cj = hd * HDIM + j;
    float accr = 0.f, acci = 0.f;
#pragma unroll 8
    for (int i = 0; i < HDIM; ++i) { const float uv = ucl[i]; const size_t wi = (size_t)(hd * HDIM + i) * HDIM + j; accr += uv * C.w_rga[wi]; acci += uv * C.w_rgx[wi]; }
    const float lm = C.lam[cj];
    const float sp8 = 8.0f * (fmaxf(-lm, 0.f) + log1pf(expf(-fabsf(lm))));
    const float rr = sigm(accr + C.b_rga[cj]), ii = sigm(acci + C.b_rgx[cj]);
    const float la = -sp8 * rr, a = __expf(la), mult = sqrtf(fmaxf(-expm1f(2.0f * la), 0.f));
    const float h = a * C.st_lru[(size_t)s * W_LRU + cj] + mult * ii * ucl[j];
    C.out[O_LS + (size_t)s * W_LRU + cj] = h;
    C.HS[row * W_LRU + cj] = (bf16)f2bf(h);
    LDS_WAIT(); asm volatile("" ::: "memory");
}
__device__ __forceinline__ void s5_sample_unit(const Ctx& C, int s, int g) {
    const size_t row = (size_t)(MP + s); const int p = C.lane, idx = g * NST + p;
    const v4u u0 = *(const v4u*)(C.P + row * NPROJ + W_LRU + g * GSZ), u1 = *(const v4u*)(C.P + row * NPROJ + W_LRU + g * GSZ + 8);
    float u[16] = {bflo(u0.x), bfhi(u0.x), bflo(u0.y), bfhi(u0.y), bflo(u0.z), bfhi(u0.z), bflo(u0.w), bfhi(u0.w), bflo(u1.x), bfhi(u1.x), bflo(u1.y), bfhi(u1.y), bflo(u1.z), bfhi(u1.z), bflo(u1.w), bfhi(u1.w)};
    float bur = 0.f, bui = 0.f;
#pragma unroll
    for (int k4 = 0; k4 < 4; ++k4) { const f32x4 br = *(const f32x4*)(C.bbr + (size_t)idx * 16 + 4 * k4), bi = *(const f32x4*)(C.bbi + (size_t)idx * 16 + 4 * k4);
#pragma unroll
        for (int i = 0; i < 4; ++i) { bur += br[i] * u[4 * k4 + i]; bui += bi[i] * u[4 * k4 + i]; } }
    const float ar = C.abr[idx], ai = C.abi[idx];
    const float h0r = C.st_re[(size_t)s * 4096 + idx], h0i = C.st_im[(size_t)s * 4096 + idx];
    const float hr = ar * h0r - ai * h0i + bur, hi = ar * h0i + ai * h0r + bui;
    C.out[O_RS + (size_t)s * 4096 + idx] = hr; C.out[O_IS + (size_t)s * 4096 + idx] = hi;
    float yk = 0.f;
#pragma unroll
    for (int k = 0; k < 16; ++k) { const float v = wave_sum(C.c_re[(size_t)(g * GSZ + k) * NST + p] * hr - C.c_im[(size_t)(g * GSZ + k) * NST + p] * hi); if (p == k) yk = v; }
    if (p < 16) { const int ch = g * GSZ + p; const float ul = bf2f(C.P[row * NPROJ + W_LRU + ch]);
        C.GY[row * W_SSM + ch] = (bf16)f2bf(gelu_tanh(yk + C.ssm_d[ch] * ul)); }
}

template <int MF, int NF, int UNR, class Epi>
__device__ __forceinline__ void skinny_gemm(const Ctx& C, const bf16* A, const bf16* Wt, int K, int ncb, const Epi& E) {
    constexpr int RB = MF * 16, NRB = 128 / RB;
    const int ntiles = NRB * ncb, l15 = C.lane & 15, kg = C.lane >> 4, kw = K / NWAVES;
    LAS f32x4* part = (LAS f32x4*)C.lds;
    for (int t = blockIdx.x; t < ntiles; t += C.G) {
        const int rb = t % NRB, cb = t / NRB;
        f32x4 acc[MF][NF];
#pragma unroll
        for (int i = 0; i < MF; ++i)
#pragma unroll
            for (int j = 0; j < NF; ++j) acc[i][j] = (f32x4){0.f, 0.f, 0.f, 0.f};
        const bf16* Ap = A + (size_t)(rb * RB + l15) * K + C.wave * kw + 8 * kg;
        const bf16* Bp[NF];
#pragma unroll
        for (int j = 0; j < NF; ++j) Bp[j] = Wt + (size_t)(E.brow(cb, j) + l15) * K + C.wave * kw + 8 * kg;
#pragma unroll UNR
        for (int ks = 0; ks < kw / 32; ++ks) {
            bf16x8 a[MF], b[NF];
#pragma unroll
            for (int i = 0; i < MF; ++i) a[i] = *(const bf16x8*)(Ap + (size_t)i * 16 * K + ks * 32);
#pragma unroll
            for (int j = 0; j < NF; ++j) b[j] = *(const bf16x8*)(Bp[j] + ks * 32);
#pragma unroll
            for (int i = 0; i < MF; ++i)
#pragma unroll
                for (int j = 0; j < NF; ++j) acc[i][j] = __builtin_amdgcn_mfma_f32_16x16x32_bf16(b[j], a[i], acc[i][j], 0, 0, 0);
        }
#pragma unroll
        for (int i = 0; i < MF; ++i)
#pragma unroll
            for (int j = 0; j < NF; ++j) part[((C.wave * MF + i) * NF + j) * 64 + C.lane] = acc[i][j];
        __syncthreads();
        for (int q = C.tid; q < MF * 64; q += NWAVES * 64) { const int mf = q >> 6, l64 = q & 63;
            f32x4 v[NF];
#pragma unroll
            for (int j = 0; j < NF; ++j) { f32x4 s = part[((0 * MF + mf) * NF + j) * 64 + l64];
#pragma unroll
                for (int wv = 1; wv < NWAVES; ++wv) s += part[((wv * MF + mf) * NF + j) * 64 + l64];
                v[j] = s; }
            E(rb * RB + mf * 16 + (l64 & 15), cb, l64 >> 4, v); }
        __syncthreads();
    }
}
struct SEpiProj { bf16* P;
    __device__ __forceinline__ int brow(int cb, int nf) const { return cb * 32 + nf * 16; }
    __device__ __forceinline__ void operator()(int r, int cb, int cq, const f32x4 (&v)[2]) const {
#pragma unroll
        for (int nf = 0; nf < 2; ++nf) { const int col = cb * 32 + nf * 16 + 4 * cq; f32x4 x = v[nf];
            if (col >= 2048) {
#pragma unroll
                for (int i = 0; i < 4; ++i) x[i] = sigm(x[i]); }
            v2u w; w.x = pk2(x[0], x[1]); w.y = pk2(x[2], x[3]); *(v2u*)(P + (size_t)(MP + r) * NPROJ + col) = w; } } };
struct SEpiGateA { bf16* T; const bf16* P;
    __device__ __forceinline__ int brow(int cb, int nf) const { return cb * 32 + nf * 16; }
    __device__ __forceinline__ void operator()(int r, int cb, int cq, const f32x4 (&v)[2]) const {
#pragma unroll
        for (int nf = 0; nf < 2; ++nf) { const int col = cb * 32 + nf * 16 + 4 * cq; const f32x4 x = v[nf];
            const v2u g = *(const v2u*)(P + (size_t)(MP + r) * NPROJ + 2048 + col);
            v2u w; w.x = pk2(x[0] * bflo(g.x), x[1] * bfhi(g.x)); w.y = pk2(x[2] * bflo(g.y), x[3] * bfhi(g.y)); *(v2u*)(T + (size_t)(MP + r) * D_MODEL + col) = w; } } };
struct SEpiGlu { bf16* MG; const bf16* T; const bf16* P;
    __device__ __forceinline__ int brow(int cb, int nf) const { const int v0 = cb * 16; return (v0 >> 7) * 256 + (v0 & 127) + nf * 128; }
    __device__ __forceinline__ void operator()(int r, int cb, int cq, const f32x4 (&v)[2]) const {
        const int col = cb * 16 + 4 * cq; const f32x4 a = v[0], g = v[1];
        const v2u t = *(const v2u*)(T + (size_t)(MP + r) * D_MODEL + col), z = *(const v2u*)(P + (size_t)(MP + r) * NPROJ + 4096 + col);
        v2u w; w.x = pk2(bflo(t.x) + bflo(z.x) * (a[0] * sigm(g[0])), bfhi(t.x) + bfhi(z.x) * (a[1] * sigm(g[1])));
        w.y = pk2(bflo(t.y) + bflo(z.y) * (a[2] * sigm(g[2])), bfhi(t.y) + bfhi(z.y) * (a[3] * sigm(g[3])));
        *(v2u*)(MG + (size_t)(MP + r) * D_MODEL + col) = w; } };
struct SEpiRes { const float* xin; float* out; const float* modt; int goff;
    __device__ __forceinline__ int brow(int cb, int nf) const { return cb * 32 + nf * 16; }
    __device__ __forceinline__ void operator()(int r, int cb, int cq, const f32x4 (&v)[2]) const {
#pragma unroll
        for (int nf = 0; nf < 2; ++nf) { const int col = cb * 32 + nf * 16 + 4 * cq;
            const f32x4 g = *(const f32x4*)(modt + (size_t)(4 + r) * MODN + goff + col), xv = *(const f32x4*)(xin + (size_t)r * D_MODEL + col);
            *(f32x4*)(out + (size_t)r * D_MODEL + col) = xv + g * v[nf]; } } };
struct SEpiRelu2 { bf16* O;
    __device__ __forceinline__ int brow(int cb, int nf) const { return cb * 32 + nf * 16; }
    __device__ __forceinline__ void operator()(int r, int cb, int cq, const f32x4 (&v)[2]) const {
#pragma unroll
        for (int nf = 0; nf < 2; ++nf) { const int col = cb * 32 + nf * 16 + 4 * cq; f32x4 x = v[nf];
#pragma unroll
            for (int i = 0; i < 4; ++i) { const float a = fmaxf(x[i], 0.f); x[i] = a * a; }
            v2u w; w.x = pk2(x[0], x[1]); w.y = pk2(x[2], x[3]); *(v2u*)(O + (size_t)(MP + r) * D_FF + col) = w; } } };

enum { PH_P0 = 0, PH_MOD, PH_H1, PH_G1, PH_SA, PH_SB, PH_G3, PH_G4, PH_G5, PH_H2, PH_G6, PH_G7, PH_FIN, N_PHASES };

__global__ void __launch_bounds__(NWAVES * 64, 2) hybrid_fwd(Args args) {
    extern __shared__ __attribute__((aligned(16))) unsigned char lds[];
    Ctx C;
    C.lds = (LAS unsigned char*)lds;
    C.tid = threadIdx.x; C.lane = C.tid & 63; C.wave = __builtin_amdgcn_readfirstlane(C.tid >> 6);
    C.G = gridDim.x; { const int bx = blockIdx.x; C.vcu = (C.G % 8 == 0) ? (bx % 8) * (C.G / 8) + bx / 8 : bx; }
    C.gw = C.vcu * NWAVES + C.wave; C.NGW = C.G * NWAVES;
    C.xp = (const float*)args.in[0]; C.xs = (const float*)args.in[1]; C.st_conv = (const float*)args.in[2]; C.st_lru = (const float*)args.in[3]; C.st_re = (const float*)args.in[4]; C.st_im = (const float*)args.in[5];
    C.c_p = (const float*)args.in[6]; C.c_s = (const float*)args.in[7]; C.w_ada = (const float*)args.in[8]; C.b_ada = (const float*)args.in[9]; C.g1 = (const float*)args.in[10]; C.g2 = (const float*)args.in[11];
    C.w_in = (const float*)args.in[12]; C.conv_w = (const float*)args.in[13]; C.conv_b = (const float*)args.in[14]; C.w_rga = (const float*)args.in[15]; C.b_rga = (const float*)args.in[16]; C.w_rgx = (const float*)args.in[17];
    C.b_rgx = (const float*)args.in[18]; C.lam = (const float*)args.in[19]; C.w_pa = (const float*)args.in[20]; C.a_re = (const float*)args.in[21]; C.a_im = (const float*)args.in[22]; C.log_dt = (const float*)args.in[23];
    C.b_re = (const float*)args.in[24]; C.b_im = (const float*)args.in[25]; C.c_re = (const float*)args.in[26]; C.c_im = (const float*)args.in[27]; C.ssm_d = (const float*)args.in[28]; C.w_glu = (const float*)args.in[29];
    C.w_out = (const float*)args.in[30]; C.w_up = (const float*)args.in[31]; C.w_dn = (const float*)args.in[32]; C.g_fin = (const float*)args.in[33];
    C.out = args.out; C.ws = args.ws;
    unsigned char* ws = args.ws;
    C.modt = (float*)(ws + WS_MOD); C.silu = (bf16*)(ws + WS_TAB + TB_SILU);
    C.abr = (float*)(ws + WS_TAB + TB_ABR); C.abi = (float*)(ws + WS_TAB + TB_ABI); C.bbr = (float*)(ws + WS_TAB + TB_BBR); C.bbi = (float*)(ws + WS_TAB + TB_BBI);
    C.ssr = (float*)(ws + WS_TAB + TB_SSR); C.ssi = (float*)(ws + WS_TAB + TB_SSI); C.lra = (float*)(ws + WS_TAB + TB_LRA); C.lre = (float*)(ws + WS_TAB + TB_LRE);
    C.Win = (bf16*)(ws + WS_WIN); C.Wpa = (bf16*)(ws + WS_WPA); C.Wglu = (bf16*)(ws + WS_WGLU); C.Wout = (bf16*)(ws + WS_WOUT); C.Wup = (bf16*)(ws + WS_WUP); C.Wdn = (bf16*)(ws + WS_WDN);
    C.A = (bf16*)(ws + WS_A); C.P = (bf16*)(ws + WS_PROJ); C.HS = (bf16*)(ws + WS_HSEQ); C.GY = (bf16*)(ws + WS_GY); C.T = (bf16*)(ws + WS_T); C.UC = (bf16*)(ws + WS_UCONV); C.ACT = (bf16*)(ws + WS_ACT);

#if MK_ONE_LAUNCH
    for (int u = C.tid; u < (LDS_BYTES - LDSCTL_OFF) / 4; u += NWAVES * 64) ((LAS unsigned*)(C.lds + LDSCTL_OFF))[u] = 0u;
    __syncthreads();
    XcdBarrier bar = xcd_barrier_post((unsigned*)(ws + WS_CTL) + CW_BAR, (volatile LAS unsigned*)(C.lds + MISC_OFF) + 8);
#define GRID_BAR() xcd_barrier(bar)
#else
#define GRID_BAR() do {} while (0)
#endif
    const int lo = args.ph_lo, hi = args.ph_hi;
#define IN(k) (lo <= (k) && (k) < hi)
#ifdef MK_PROBE
#define STAMP(k) do { if (blockIdx.x == 0 && C.tid == 0) { *(volatile LAS unsigned long long*)(C.lds + LDSCTL_OFF + 512 + 8 * ((k) + 1)) = __builtin_amdgcn_s_memrealtime(); } } while (0)
#else
#define STAMP(k) do {} while (0)
#endif
#define SEAM(k) do { if (IN(k) && IN((k) + 1)) GRID_BAR(); STAMP(k); } while (0)
    LAS unsigned char* wl = C.lds + C.wave * 16384;

    STAMP(-1);
    if (IN(PH_P0)) { p0_phase(C); } SEAM(PH_P0);
    if (IN(PH_MOD)) { mod_phase(C); } SEAM(PH_MOD);
    if (IN(PH_H1)) { norm_mod_phase(C, C.xp, C.xs, C.g1, 0, 2048, C.A); } SEAM(PH_H1);
    if (IN(PH_G1)) {
        pg8::Gemm g{C.A, C.Win, MP, NPROJ, D_MODEL}; pg8::StaticOrder S; S.init(MP, NPROJ, C.G, (int)blockIdx.x);
        pg8::EpiProj E{C.P};
        pg8::gemm_phase<pg8::EpiProj, pg8::StaticOrder, PG8_ALIGN, PG8_SP2>(C.lds, g, S, E);
        skinny_gemm<2, 2, 4>(C, C.A + (size_t)MP * D_MODEL, C.Win, D_MODEL, NPROJ / 32, SEpiProj{C.P});
    } SEAM(PH_G1);
    if (IN(PH_SA)) {
        for (int u = blockIdx.x; u < 256; u += C.G) s5_block<false>(C, u & 7, u >> 3);
        for (int u = blockIdx.x; u < 256; u += C.G) lru_block<false>(C, u);
        for (int u = C.gw; u < MS * NHEAD * 2; u += C.NGW) lru_sample_unit(C, u >> 4, (u >> 1) & 7, u & 1, wl);
        for (int u = C.gw; u < MS * NGRP; u += C.NGW) s5_sample_unit(C, u >> 6, u & 63);
        new_conv_prompt(C);
    } SEAM(PH_SA);
    if (IN(PH_SB)) {
        for (int u = blockIdx.x; u < 256; u += C.G) s5_block<true>(C, u & 7, u >> 3);
        for (int u = blockIdx.x; u < 256; u += C.G) lru_block<true>(C, u);
    } SEAM(PH_SB);
    if (IN(PH_G3)) {
        pg8::Gemm g{C.HS, C.Wpa, MP, D_MODEL, W_LRU}; pg8::StaticOrder S; S.init(MP, D_MODEL, C.G, (int)blockIdx.x);
        pg8::EpiGateA E{C.T, C.P};
        pg8::gemm_phase<pg8::EpiGateA, pg8::StaticOrder, PG8_ALIGN, PG8_SP2>(C.lds, g, S, E);
        skinny_gemm<2, 2, 4>(C, C.HS + (size_t)MP * W_LRU, C.Wpa, W_LRU, D_MODEL / 32, SEpiGateA{C.T, C.P});
    } SEAM(PH_G3);
    if (IN(PH_G4)) {
        pg8::Gemm g{C.GY, C.Wglu, MP, 2 * D_MODEL, W_SSM}; pg8::StaticOrder S; S.init(MP, 2 * D_MODEL, C.G, (int)blockIdx.x);
        pg8::EpiGlu E{C.A, C.T, C.P};
        pg8::gemm_phase<pg8::EpiGlu, pg8::StaticOrder, PG8_ALIGN, PG8_SP2>(C.lds, g, S, E);
        skinny_gemm<2, 2, 4>(C, C.GY + (size_t)MP * W_SSM, C.Wglu, W_SSM, D_MODEL / 16, SEpiGlu{C.A, C.T, C.P});
    } SEAM(PH_G4);
    if (IN(PH_G5)) {
        pg8::Gemm g{C.A, C.Wout, MP, D_MODEL, D_MODEL}; pg8::StaticOrder S; S.init(MP, D_MODEL, C.G, (int)blockIdx.x);
        pg8::EpiRes E{C.xp, C.xs, C.out, C.modt, 2 * D_MODEL};
        pg8::gemm_phase<pg8::EpiRes, pg8::StaticOrder, PG8_ALIGN, PG8_SP2>(C.lds, g, S, E);
        skinny_gemm<2, 2, 4>(C, C.A + (size_t)MP * D_MODEL, C.Wout, D_MODEL, D_MODEL / 32, SEpiRes{C.xs, C.out + (size_t)MP * D_MODEL, C.modt, 2 * D_MODEL});
    } SEAM(PH_G5);
    if (IN(PH_H2)) { norm_mod_phase(C, C.out, C.out + (size_t)MP * D_MODEL, C.g2, 3 * D_MODEL, 4 * D_MODEL, C.A); } SEAM(PH_H2);
    if (IN(PH_G6)) {
        pg8::Gemm g{C.A, C.Wup, MP, D_FF, D_MODEL}; pg8::StaticOrder S; S.init(MP, D_FF, C.G, (int)blockIdx.x);
        pg8::EpiRelu2 E{C.ACT};
        pg8::gemm_phase<pg8::EpiRelu2, pg8::StaticOrder, PG8_ALIGN, PG8_SP2>(C.lds, g, S, E);
        skinny_gemm<8, 2, 2>(C, C.A + (size_t)MP * D_MODEL, C.Wup, D_MODEL, D_FF / 32, SEpiRelu2{C.ACT});
    } SEAM(PH_G6);
    if (IN(PH_G7)) {
        pg8::Gemm g{C.ACT, C.Wdn, MP, D_MODEL, D_FF}; pg8::StaticOrder S; S.init(MP, D_MODEL, C.G, (int)blockIdx.x);
        pg8::EpiRes E{C.out, C.out + (size_t)MP * D_MODEL, C.out, C.modt, 5 * D_MODEL};
        pg8::gemm_phase<pg8::EpiRes, pg8::StaticOrder, PG8_ALIGN, PG8_SP2>(C.lds, g, S, E);
        skinny_gemm<2, 2, 4>(C, C.ACT + (size_t)MP * D_FF, C.Wdn, D_FF, D_MODEL / 32, SEpiRes{C.out + (size_t)MP * D_MODEL, C.out + (size_t)MP * D_MODEL, C.modt, 5 * D_MODEL});
    } SEAM(PH_G7);
    if (IN(PH_FIN)) { final_norm_phase(C); }
#ifdef MK_PROBE
    STAMP(PH_FIN);
    if (blockIdx.x == 0 && C.tid == 0) {
        volatile LAS unsigned long long* ts = (volatile LAS unsigned long long*)(C.lds + LDSCTL_OFF + 512);
        const unsigned long long delay = (ts[MK_PROBE_A_HI + 1] - ts[MK_PROBE_A_LO]) * (unsigned long long)MK_PROBE_MUL;
        const unsigned long long t0 = __builtin_amdgcn_s_memrealtime();
        while (__builtin_amdgcn_s_memrealtime() - t0 < delay) __builtin_amdgcn_s_sleep(8);
    }
#endif
#undef IN
#undef SEAM
}

extern "C" void kernel_launch(void* const* d_in, const int* in_sizes, int n_in, void* d_out, int out_size, void* d_ws, size_t ws_size, hipStream_t stream) {
    static int grid = 0;
    if (grid == 0) {
        if (n_in != 34 || in_sizes[0] != MP * D_MODEL || (size_t)out_size != O_END || ws_size < WS_END) {
            fprintf(stderr, "kernel_launch: built for 34 inputs, out %zu floats, >= %zu bytes of workspace; got n_in %d, in0 %d, out %d, ws %zu; nothing launched\n", (size_t)O_END, (size_t)WS_END, n_in, n_in > 0 ? in_sizes[0] : -1, out_size, ws_size); grid = -1; return; }
        int dev = 0, cus = 0, per_cu = 0;
        if (hipGetDevice(&dev) != hipSuccess || hipDeviceGetAttribute(&cus, hipDeviceAttributeMultiprocessorCount, dev) != hipSuccess) { fprintf(stderr, "kernel_launch: device query failed\n"); grid = -1; return; }
        if (hipFuncSetAttribute((const void*)hybrid_fwd, hipFuncAttributeMaxDynamicSharedMemorySize, LDS_BYTES) != hipSuccess) { fprintf(stderr, "kernel_launch: hipFuncSetAttribute failed\n"); grid = -1; return; }
        if (hipOccupancyMaxActiveBlocksPerMultiprocessor(&per_cu, (const void*)hybrid_fwd, NWAVES * 64, LDS_BYTES) != hipSuccess || per_cu < 1) { fprintf(stderr, "kernel_launch: occupancy query says %d workgroups per CU\n", per_cu); per_cu = 1; }
        (void)hipGetLastError();
        grid = cus;
    }
    if (grid < 0) return;
    if (hipMemsetAsync((char*)d_ws + WS_CTL, 0, CTL_ZERO_BYTES, stream) != hipSuccess) { fprintf(stderr, "kernel_launch: memset failed\n"); return; }
    Args a{};
    for (int i = 0; i < 34; ++i) a.in[i] = d_in[i];
    a.out = (float*)d_out; a.ws = (unsigned char*)d_ws;
#if MK_ONE_LAUNCH
    a.ph_lo = 0; a.ph_hi = N_PHASES;
    hipLaunchKernelGGL(hybrid_fwd, dim3(grid), dim3(NWAVES * 64), LDS_BYTES, stream, a);
#else
    for (int p = 0; p < N_PHASES; ++p) { a.ph_lo = p; a.ph_hi = p + 1; hipLaunchKernelGGL(hybrid_fwd, dim3(grid), dim3(NWAVES * 64), LDS_BYTES, stream, a); }
#endif
    const hipError_t le = hipPeekAtLastError();
    if (le != hipSuccess) fprintf(stderr, "kernel_launch: launch failed: %s\n", hipGetErrorName(le));
}
```

```cpp
#include <hip/hip_runtime.h>
#include <cstdio>
#include <cstdint>
namespace pg8 {
#define PG8_LAS __attribute__((address_space(3)))
typedef unsigned short bf16_t;
typedef short bf16x8 __attribute__((ext_vector_type(8)));
typedef float f32x4 __attribute__((ext_vector_type(4)));
typedef unsigned u32x4 __attribute__((ext_vector_type(4)));
constexpr int BM = 256, BK = 64, HALF = 128, HTB = HALF * BK * 2  , STAGE_BYTES = 8 * HTB, NXCD = 8, WGM = 8;

__host__ __device__ __forceinline__ int lds_byte(int r, int c) { const int st = (r >> 4) * 2 + (c >> 5), rr = r & 15, cc = c & 31, ob = rr * 64 + cc * 2; return st * 1024 + (ob ^ (((ob >> 9) & 1) << 5)); }
__host__ __device__ __forceinline__ void stage_rc(int b, int& R, int& C) { const int st = b / 1024, sb = b % 1024, swz = sb ^ (((sb >> 9) & 1) << 5); R = (st >> 1) * 16 + swz / 64; C = (st & 1) * 32 + (swz % 64) / 2; }
__host__ __device__ __forceinline__ int perm32(int rho) { const int n = rho >> 4, i = rho & 15; return 8 * (i >> 2) + 4 * n + (i & 3); }

struct Unit { int pm, pn; };
struct Gemm { const bf16_t* A; const bf16_t* Bt; int M, N, K; };

struct StaticOrder {
    int nM, nN, nwg, G, c;
    __host__ __device__ void init(int M, int N, int G_, int c_) { nM = M / BM; nN = N / BM; nwg = nM * nN; G = G_; c = c_; }
    __host__ __device__ bool next(int i, Unit& u) const {
        const long L = (long)i * G + c; if (L >= nwg) return false;
        int wgid = (int)L; { const int q = nwg / NXCD, r = nwg % NXCD, xcd = wgid % NXCD, off = wgid / NXCD; wgid = (xcd < r ? xcd * (q + 1) : r * (q + 1) + (xcd - r) * q) + off; }
        const int nig = WGM * nN, gid = wgid / nig, fm = gid * WGM, gsz = (nM - fm) < WGM ? (nM - fm) : WGM;
        u.pm = fm + ((wgid % nig) % gsz); u.pn = (wgid % nig) / gsz; return true;
    }
    __device__ __forceinline__ void a_ready(const Unit&) const {}
    __device__ __forceinline__ void done(const Unit&) const {}
};

__device__ __forceinline__ unsigned cvt_pk_bf16(float lo, float hi) { unsigned r; asm volatile("v_cvt_pk_bf16_f32 %0, %1, %2" : "=v"(r) : "v"(lo), "v"(hi)); return r; }
constexpr int D_MODEL = 2048, MP = 8192  , MS = 128  , MR = MP + MS  , MODN = 6 * D_MODEL, NPROJ = 6144, D_FF = 8192;
__device__ __forceinline__ float bflo(unsigned w) { return __uint_as_float(w << 16); }
__device__ __forceinline__ float bfhi(unsigned w) { return __uint_as_float(w & 0xffff0000u); }
__device__ __forceinline__ float sigm(float x) { return __builtin_amdgcn_rcpf(1.0f + __builtin_amdgcn_exp2f(-1.44269504f * x)); }
__device__ __forceinline__ int mod_row(int row) { int r = row < MP ? (row >> 11) : (4 + row - MP); return r > 143 ? 143 : r; }

struct EpiProj {
    static constexpr bool PERM = true, AFTER_DRAIN = false;
    bf16_t* O;
    __device__ __forceinline__ void operator()(const f32x4 (&acc)[2][2][4][2], const Unit& u, int wr, int wc, int fr, int fq) const {
        const int row0 = u.pm * BM + wr * 64 + fr, col0 = u.pn * BM + wc * 32 + 8 * fq; const bool sg = u.pn >= 8;
#pragma unroll
        for (int ai = 0; ai < 2; ++ai)
#pragma unroll
            for (int m = 0; m < 4; ++m) { bf16_t* rowp = O + (size_t)(row0 + ai * HALF + m * 16) * NPROJ + col0;
#pragma unroll
                for (int bj = 0; bj < 2; ++bj) { f32x4 v0 = acc[ai][bj][m][0], v1 = acc[ai][bj][m][1];
                    if (sg) {
#pragma unroll
                        for (int i = 0; i < 4; ++i) { v0[i] = sigm(v0[i]); v1[i] = sigm(v1[i]); } }
                    u32x4 w; w.x = cvt_pk_bf16(v0[0], v0[1]); w.y = cvt_pk_bf16(v0[2], v0[3]); w.z = cvt_pk_bf16(v1[0], v1[1]); w.w = cvt_pk_bf16(v1[2], v1[3]);
                    *(u32x4*)(rowp + bj * HALF) = w; } }
    }
};
struct EpiGateA {
    static constexpr bool PERM = true, AFTER_DRAIN = false;
    bf16_t* T; const bf16_t* P;
    __device__ __forceinline__ void operator()(const f32x4 (&acc)[2][2][4][2], const Unit& u, int wr, int wc, int fr, int fq) const {
        const int row0 = u.pm * BM + wr * 64 + fr, col0 = u.pn * BM + wc * 32 + 8 * fq;
#pragma unroll
        for (int ai = 0; ai < 2; ++ai)
#pragma unroll
            for (int m = 0; m < 4; ++m) { const size_t row = (size_t)(row0 + ai * HALF + m * 16);
#pragma unroll
                for (int bj = 0; bj < 2; ++bj) { const int col = col0 + bj * HALF;
                    const u32x4 g = *(const u32x4*)(P + row * NPROJ + 2048 + col);
                    f32x4 v0 = acc[ai][bj][m][0], v1 = acc[ai][bj][m][1];
                    v0[0] *= bflo(g.x); v0[1] *= bfhi(g.x); v0[2] *= bflo(g.y); v0[3] *= bfhi(g.y); v1[0] *= bflo(g.z); v1[1] *= bfhi(g.z); v1[2] *= bflo(g.w); v1[3] *= bfhi(g.w);
                    u32x4 w; w.x = cvt_pk_bf16(v0[0], v0[1]); w.y = cvt_pk_bf16(v0[2], v0[3]); w.z = cvt_pk_bf16(v1[0], v1[1]); w.w = cvt_pk_bf16(v1[2], v1[3]);
                    *(u32x4*)(T + row * D_MODEL + col) = w; } }
    }
};
struct EpiGlu {
    static constexpr bool PERM = true, AFTER_DRAIN = false;
    bf16_t* MG; const bf16_t* T; const bf16_t* P;
    __device__ __forceinline__ void operator()(const f32x4 (&acc)[2][2][4][2], const Unit& u, int wr, int wc, int fr, int fq) const {
        const int row0 = u.pm * BM + wr * 64 + fr, vcol = u.pn * HALF + wc * 32 + 8 * fq;
#pragma unroll
        for (int ai = 0; ai < 2; ++ai)
#pragma unroll
            for (int m = 0; m < 4; ++m) { const size_t row = (size_t)(row0 + ai * HALF + m * 16);
                const u32x4 t = *(const u32x4*)(T + row * D_MODEL + vcol);
                const u32x4 z = *(const u32x4*)(P + row * NPROJ + 4096 + vcol);
                const f32x4 a0 = acc[ai][0][m][0], a1 = acc[ai][0][m][1], g0 = acc[ai][1][m][0], g1 = acc[ai][1][m][1];
                float o[8];
                o[0] = bflo(t.x) + bflo(z.x) * (a0[0] * sigm(g0[0])); o[1] = bfhi(t.x) + bfhi(z.x) * (a0[1] * sigm(g0[1]));
                o[2] = bflo(t.y) + bflo(z.y) * (a0[2] * sigm(g0[2])); o[3] = bfhi(t.y) + bfhi(z.y) * (a0[3] * sigm(g0[3]));
                o[4] = bflo(t.z) + bflo(z.z) * (a1[0] * sigm(g1[0])); o[5] = bfhi(t.z) + bfhi(z.z) * (a1[1] * sigm(g1[1]));
                o[6] = bflo(t.w) + bflo(z.w) * (a1[2] * sigm(g1[2])); o[7] = bfhi(t.w) + bfhi(z.w) * (a1[3] * sigm(g1[3]));
                u32x4 w; w.x = cvt_pk_bf16(o[0], o[1]); w.y = cvt_pk_bf16(o[2], o[3]); w.z = cvt_pk_bf16(o[4], o[5]); w.w = cvt_pk_bf16(o[6], o[7]);
                *(u32x4*)(MG + row * D_MODEL + vcol) = w; }
    }
};
struct EpiRes {
    static constexpr bool PERM = false, AFTER_DRAIN = false;
    const float* xp; const float* xs; float* out; const float* modt; int goff;
    __device__ __forceinline__ void operator()(const f32x4 (&acc)[2][2][4][2], const Unit& u, int wr, int wc, int fr, int fq) const {
        const int row0 = u.pm * BM + wr * 64 + fr, col0 = u.pn * BM + wc * 32 + 4 * fq;
#pragma unroll
        for (int ai = 0; ai < 2; ++ai)
#pragma unroll
            for (int m = 0; m < 4; ++m) { const int row = row0 + ai * HALF + m * 16;
                if (row < MR) {
                    const float* xr = row < MP ? xp + (size_t)row * D_MODEL : xs + (size_t)(row - MP) * D_MODEL;
                    const float* gr = modt + (size_t)mod_row(row) * MODN + goff;
                    float* orow = out + (size_t)row * D_MODEL;
#pragma unroll
                    for (int bj = 0; bj < 2; ++bj)
#pragma unroll
                        for (int n = 0; n < 2; ++n) { const int col = col0 + bj * HALF + n * 16;
                            const f32x4 g = *(const f32x4*)(gr + col); const f32x4 xv = *(const f32x4*)(xr + col);
                            *(f32x4*)(orow + col) = xv + g * acc[ai][bj][m][n]; } } }
    }
};
struct EpiRelu2 {
    static constexpr bool PERM = true, AFTER_DRAIN = false;
    bf16_t* O;
    __device__ __forceinline__ void operator()(const f32x4 (&acc)[2][2][4][2], const Unit& u, int wr, int wc, int fr, int fq) const {
        const int row0 = u.pm * BM + wr * 64 + fr, col0 = u.pn * BM + wc * 32 + 8 * fq;
#pragma unroll
        for (int ai = 0; ai < 2; ++ai)
#pragma unroll
            for (int m = 0; m < 4; ++m) { bf16_t* rowp = O + (size_t)(row0 + ai * HALF + m * 16) * D_FF + col0;
#pragma unroll
                for (int bj = 0; bj < 2; ++bj) { f32x4 v0 = acc[ai][bj][m][0], v1 = acc[ai][bj][m][1];
#pragma unroll
                    for (int i = 0; i < 4; ++i) { const float a = fmaxf(v0[i], 0.f), b = fmaxf(v1[i], 0.f); v0[i] = a * a; v1[i] = b * b; }
                    u32x4 w; w.x = cvt_pk_bf16(v0[0], v0[1]); w.y = cvt_pk_bf16(v0[2], v0[3]); w.z = cvt_pk_bf16(v1[0], v1[1]); w.w = cvt_pk_bf16(v1[2], v1[3]);
                    *(u32x4*)(rowp + bj * HALF) = w; } }
    }
};

template <class Epi, class Sched, bool ALIGN_EPI = false, bool SP2 = false>
__device__ __forceinline__ void gemm_phase(PG8_LAS unsigned char* lds, const Gemm g, const Sched& S, const Epi& E) {
    const int tid = threadIdx.x, wid = __builtin_amdgcn_readfirstlane(tid >> 6), lane = tid & 63, wr = wid >> 2, wc = wid & 3, fr = lane & 15, fq = lane >> 4;
    const int K = g.K, nt = K / BK;
    unsigned voffA[2], voffB[2];
#pragma unroll
    for (int i = 0; i < 2; ++i) { int R, C; stage_rc(tid * 16 + i * 8192, R, C); const int Rb = Epi::PERM ? ((R & ~31) + perm32(R & 31)) : R;
        voffA[i] = (unsigned)(R * K + C) * 2u; voffB[i] = (unsigned)(Rb * K + C) * 2u; }
    const size_t kstep = (size_t)(BK * 2);
    const size_t hstep = (size_t)HALF * K * 2;
    const size_t tstep = 2 * hstep;
    const unsigned ldsw = (unsigned)wid * 1024u;
    const int aoff = lds_byte(wr * 64 + fr, fq * 8), boff = lds_byte(wc * 32 + fr, fq * 8);
#define PG8_SA(b, h) (((b) * 2 + (h)) * HTB)
#define PG8_SB(b, h) ((4 + (b) * 2 + (h)) * HTB)
#define PG8_STAGE(bufoff, gbase, voff) do { _Pragma("unroll") for (int _i = 0; _i < 2; ++_i) \
        __builtin_amdgcn_global_load_lds((const unsigned*)((const char*)(gbase) + (voff)[_i]), (PG8_LAS unsigned*)(lds + (bufoff) + ldsw + _i * 8192), 16, 0, 0); } while (0)
#define PG8_LDA(dst, b, h) do { _Pragma("unroll") for (int m = 0; m < 4; ++m) _Pragma("unroll") for (int k = 0; k < 2; ++k) dst[m][k] = *(const PG8_LAS bf16x8*)(lds + PG8_SA(b, h) + aoff + m * 2048 + k * 1024); } while (0)
#define PG8_LDB(dst, b, h) do { _Pragma("unroll") for (int n = 0; n < 2; ++n) _Pragma("unroll") for (int k = 0; k < 2; ++k) dst[n][k] = *(const PG8_LAS bf16x8*)(lds + PG8_SB(b, h) + boff + n * 2048 + k * 1024); } while (0)
#define PG8_MMA(ai, bj, At, Bt) do { __builtin_amdgcn_s_setprio(1); _Pragma("unroll") for (int m = 0; m < 4; ++m) _Pragma("unroll") for (int n = 0; n < 2; ++n) _Pragma("unroll") for (int k = 0; k < 2; ++k) \
        acc[ai][bj][m][n] = __builtin_amdgcn_mfma_f32_16x16x32_bf16(Bt[n][k], At[m][k], acc[ai][bj][m][n], 0, 0, 0); __builtin_amdgcn_s_setprio(0); } while (0)
#define PG8_WAIT_V(n) asm volatile("s_waitcnt vmcnt(" #n ")" ::: "memory")
#define PG8_WAIT_L(n) asm volatile("s_waitcnt lgkmcnt(" #n ")" ::: "memory")
#define PG8_BAR __builtin_amdgcn_s_barrier()
#define PG8_SCHED __builtin_amdgcn_sched_barrier(0)
    Unit cur, nxt; int ui = 0;
    if (!S.next(0, cur)) return;
    f32x4 acc[2][2][4][2];
#pragma unroll
    for (int a = 0; a < 2; ++a)
#pragma unroll
        for (int b = 0; b < 2; ++b)
#pragma unroll
            for (int m = 0; m < 4; ++m)
#pragma unroll
                for (int n = 0; n < 2; ++n) acc[a][b][m][n] = (f32x4){0.f, 0.f, 0.f, 0.f};
    bf16x8 At[4][2], B0[2][2], B1[2][2];
    const char* cA = (const char*)g.A + (size_t)cur.pm * tstep; const char* cB = (const char*)g.Bt + (size_t)cur.pn * tstep;
    S.a_ready(cur);
    if constexpr (SP2) {
        PG8_STAGE(PG8_SB(0, 0), cB, voffB); PG8_STAGE(PG8_SB(0, 1), cB + hstep, voffB); PG8_STAGE(PG8_SA(0, 0), cA, voffA); PG8_STAGE(PG8_SA(0, 1), cA + hstep, voffA);
        if (wr == 1) PG8_BAR;
        PG8_WAIT_V(2); PG8_BAR;
        PG8_STAGE(PG8_SB(1, 0), cB + kstep, voffB); PG8_STAGE(PG8_SA(1, 0), cA + kstep, voffA); PG8_STAGE(PG8_SB(1, 1), cB + hstep + kstep, voffB);
        PG8_WAIT_V(6); PG8_BAR;
    } else {
        PG8_STAGE(PG8_SB(0, 0), cB, voffB); PG8_STAGE(PG8_SA(0, 0), cA, voffA); PG8_STAGE(PG8_SB(0, 1), cB + hstep, voffB); PG8_STAGE(PG8_SA(0, 1), cA + hstep, voffA);
        if (wr == 1) PG8_BAR;
        PG8_WAIT_V(4); PG8_BAR;
        PG8_STAGE(PG8_SB(1, 0), cB + kstep, voffB); PG8_STAGE(PG8_SA(1, 0), cA + kstep, voffA); PG8_STAGE(PG8_SB(1, 1), cB + hstep + kstep, voffB);
        PG8_WAIT_V(6); PG8_BAR;
    }
    for (;;) {
        const bool has_next = S.next(ui + 1, nxt);
        const char* nA = has_next ? (const char*)g.A + (size_t)nxt.pm * tstep : cA; const char* nB = has_next ? (const char*)g.Bt + (size_t)nxt.pn * tstep : cB;
        for (int t = 0; t < nt; t += 2) {
            const bool last = (t == nt - 2);
            const char* a1 = cA + (size_t)(t + 1) * kstep;
            const char* a2 = last ? nA : cA + (size_t)(t + 2) * kstep; const char* b2 = last ? nB : cB + (size_t)(t + 2) * kstep;
            const char* a3 = a2 + kstep; const char* b3 = b2 + kstep;
            if (last && has_next) S.a_ready(nxt);
            if constexpr (SP2) {
            PG8_LDB(B0, 0, 0); PG8_LDB(B1, 0, 1); PG8_SCHED; PG8_LDA(At, 0, 0); PG8_STAGE(PG8_SA(1, 1), a1 + hstep, voffA);
            PG8_WAIT_V(8); PG8_WAIT_L(0); PG8_BAR; PG8_MMA(0, 0, At, B0); PG8_MMA(0, 1, At, B1); PG8_BAR; PG8_SCHED;
            PG8_LDA(At, 0, 1); PG8_STAGE(PG8_SB(0, 0), b2, voffB); PG8_STAGE(PG8_SB(0, 1), b2 + hstep, voffB); PG8_STAGE(PG8_SA(0, 0), a2, voffA);
            PG8_WAIT_V(8); PG8_WAIT_L(0); PG8_BAR; PG8_MMA(1, 0, At, B0); PG8_MMA(1, 1, At, B1); PG8_BAR; PG8_SCHED;
            PG8_LDB(B0, 1, 0); PG8_LDB(B1, 1, 1); PG8_SCHED; PG8_LDA(At, 1, 0); PG8_STAGE(PG8_SA(0, 1), a2 + hstep, voffA);
            PG8_WAIT_V(8); PG8_WAIT_L(0); PG8_BAR; PG8_MMA(0, 0, At, B0); PG8_MMA(0, 1, At, B1); PG8_BAR; PG8_SCHED;
            PG8_LDA(At, 1, 1); PG8_STAGE(PG8_SB(1, 0), b3, voffB); PG8_STAGE(PG8_SB(1, 1), b3 + hstep, voffB); PG8_STAGE(PG8_SA(1, 0), a3, voffA);
            PG8_WAIT_V(8); PG8_WAIT_L(0); PG8_BAR; PG8_MMA(1, 0, At, B0); PG8_MMA(1, 1, At, B1); PG8_BAR; PG8_SCHED;
            } else {
            PG8_LDB(B0, 0, 0); PG8_SCHED; PG8_LDA(At, 0, 0); PG8_STAGE(PG8_SA(1, 1), a1 + hstep, voffA);
            PG8_WAIT_L(8); PG8_BAR; PG8_WAIT_L(0); PG8_MMA(0, 0, At, B0); PG8_BAR; PG8_SCHED;
            PG8_LDB(B1, 0, 1); PG8_STAGE(PG8_SB(0, 0), b2, voffB);
            PG8_BAR; PG8_WAIT_L(0); PG8_MMA(0, 1, At, B1); PG8_BAR;
            PG8_LDA(At, 0, 1); PG8_STAGE(PG8_SA(0, 0), a2, voffA);
            PG8_BAR; PG8_WAIT_L(0); PG8_MMA(1, 0, At, B0); PG8_BAR; PG8_SCHED;
            PG8_STAGE(PG8_SB(0, 1), b2 + hstep, voffB);
            PG8_WAIT_V(6); PG8_BAR; PG8_MMA(1, 1, At, B1); PG8_BAR;
            PG8_LDB(B0, 1, 0); PG8_SCHED; PG8_LDA(At, 1, 0); PG8_STAGE(PG8_SA(0, 1), a2 + hstep, voffA);
            PG8_WAIT_L(8); PG8_BAR; PG8_WAIT_L(0); PG8_MMA(0, 0, At, B0); PG8_BAR; PG8_SCHED;
            PG8_LDB(B1, 1, 1); PG8_STAGE(PG8_SB(1, 0), b3, voffB);
            PG8_BAR; PG8_WAIT_L(0); PG8_MMA(0, 1, At, B1); PG8_BAR;
            PG8_LDA(At, 1, 1); PG8_STAGE(PG8_SA(1, 0), a3, voffA);
            PG8_BAR; PG8_WAIT_L(0); PG8_MMA(1, 0, At, B0); PG8_BAR; PG8_SCHED;
            PG8_STAGE(PG8_SB(1, 1), b3 + hstep, voffB);
            PG8_WAIT_V(6); PG8_BAR; PG8_MMA(1, 1, At, B1); PG8_BAR;
            }
        }
        if constexpr (ALIGN_EPI) { if (wr == 0) PG8_BAR; }
        if constexpr (!Epi::AFTER_DRAIN) { E(acc, cur, wr, wc, fr, fq); S.done(cur); }
        if (!has_next) break;
#pragma unroll
        for (int a = 0; a < 2; ++a)
#pragma unroll
            for (int b = 0; b < 2; ++b)
#pragma unroll
                for (int m = 0; m < 4; ++m)
#pragma unroll
                    for (int n = 0; n < 2; ++n) acc[a][b][m][n] = (f32x4){0.f, 0.f, 0.f, 0.f};
        cur = nxt; cA = nA; cB = nB; ++ui;
        if constexpr (ALIGN_EPI) { if (wr == 1) PG8_BAR; }
    }
    PG8_WAIT_V(0);
    if constexpr (!ALIGN_EPI) { if (wr == 0) PG8_BAR; }
    PG8_BAR;
    if constexpr (Epi::AFTER_DRAIN) { E.fused(acc, cur, wr, wc, fr, fq, lds, wid, lane); S.done(cur); }
#undef PG8_SA
#undef PG8_SB
#undef PG8_STAGE
#undef PG8_LDA
#undef PG8_LDB
#undef PG8_MMA
#undef PG8_WAIT_V
#undef PG8_WAIT_L
#undef PG8_BAR
#undef PG8_SCHED
}
}
#ifndef PG8_SP2
#define PG8_SP2 true
#endif
#ifndef PG8_ALIGN
#define PG8_ALIGN true
#endif
#ifndef MK_ONE_LAUNCH
#define MK_ONE_LAUNCH 1
#endif

using pg8::D_MODEL; using pg8::MP; using pg8::MS; using pg8::MR; using pg8::MODN; using pg8::NPROJ; using pg8::D_FF;
constexpr int MPAD = 8448;
constexpr int SEQ = 2048, NB = 4, W_LRU = 1024, W_SSM = 1024, NHEAD = 8, HDIM = 128, NGRP = 64, NST = 64, GSZ = 16;
constexpr int S5_TC = 128, S5_NCH = SEQ / S5_TC;
constexpr int LR_TC = 64,  LR_NCH = SEQ / LR_TC;
constexpr float EPS = 1e-6f;
constexpr size_t O_YP = 0, O_YS = 16777216, O_CP = 17039360, O_LP = 17051648, O_RP = 17055744, O_IP = 17072128, O_CS = 17088512, O_LS = 17481728, O_RS = 17612800, O_IS = 18137088, O_END = 18661376;

constexpr size_t MiB = 1u << 20;
constexpr size_t WS_CTL = 0, CTL_ZERO_BYTES = 1 * MiB;
constexpr size_t WS_MOD = 1 * MiB;
constexpr size_t WS_TAB = 8 * MiB;
constexpr size_t TB_SILU = 0;
constexpr size_t TB_ABR = 1 * MiB, TB_ABI = TB_ABR + 16384;
constexpr size_t TB_BBR = TB_ABI + 16384, TB_BBI = TB_BBR + 262144;
constexpr size_t TB_SSR = 2 * MiB, TB_SSI = 3 * MiB;
constexpr size_t TB_LRA = 4 * MiB, TB_LRE = 4 * MiB + 524288;
constexpr size_t WS_WIN = 16 * MiB, WS_WPA = 40 * MiB, WS_WGLU = 44 * MiB, WS_WOUT = 52 * MiB, WS_WUP = 60 * MiB, WS_WDN = 92 * MiB;
constexpr size_t WS_A = 124 * MiB;
constexpr size_t WS_PROJ = 157 * MiB;
constexpr size_t WS_HSEQ = 256 * MiB, WS_GY = 273 * MiB;
constexpr size_t WS_T = 290 * MiB, WS_UCONV = WS_T;
constexpr size_t WS_ACT = 157 * MiB;
constexpr size_t WS_END = 323 * MiB;
static_assert(WS_ACT + (size_t)MPAD * D_FF * 2 <= WS_T && WS_T + (size_t)MPAD * D_MODEL * 2 <= WS_END && WS_PROJ + (size_t)MPAD * NPROJ * 2 <= WS_HSEQ, "d_ws map");
constexpr int CW_BAR = 4096;

constexpr int RING_BYTES = 131072, LDS_BYTES = 147456, LDSCTL_OFF = LDS_BYTES - 1024, MISC_OFF = LDSCTL_OFF + 320;
constexpr int NWAVES = 8;

#define GAS __attribute__((address_space(1)))
#define LAS __attribute__((address_space(3)))
typedef unsigned short bf16;
typedef unsigned v4u __attribute__((ext_vector_type(4)));
typedef unsigned v2u __attribute__((ext_vector_type(2)));
typedef float f32x4 __attribute__((ext_vector_type(4)));
typedef float f32x16 __attribute__((ext_vector_type(16)));
typedef short bf16x8 __attribute__((ext_vector_type(8)));
typedef GAS unsigned gu32;
#define RLX_AGENT __ATOMIC_RELAXED, __HIP_MEMORY_SCOPE_AGENT
#define LDS_WAIT() asm volatile("s_waitcnt lgkmcnt(0)" ::: "memory")
#define VM_WAIT() asm volatile("s_waitcnt vmcnt(0)" ::: "memory")
__device__ __forceinline__ unsigned f2bf(float f) { unsigned u = __builtin_bit_cast(unsigned, f); return (u + 0x7fffu + ((u >> 16) & 1u)) >> 16; }
__device__ __forceinline__ unsigned pk2(float lo, float hi) { return pg8::cvt_pk_bf16(lo, hi); }
__device__ __forceinline__ float bf2f(bf16 v) { return __uint_as_float((unsigned)v << 16); }
using pg8::bflo; using pg8::bfhi; using pg8::sigm;
__device__ __forceinline__ bf16x8 pack8(f32x4 a, f32x4 b) { v4u w; w.x = pk2(a[0], a[1]); w.y = pk2(a[2], a[3]); w.z = pk2(b[0], b[1]); w.w = pk2(b[2], b[3]); return __builtin_bit_cast(bf16x8, w); }
__device__ __forceinline__ float gelu_tanh(float v) {
    const float z = 0.7978845608f * (v + 0.044715f * v * v * v);
    const float t = __builtin_amdgcn_exp2f(2.885390082f * z);
    return v - v * __builtin_amdgcn_rcpf(1.0f + t);
}
__device__ __forceinline__ float wave_sum(float v) {
#pragma unroll
    for (int o = 1; o < 64; o <<= 1) v += __shfl_xor(v, o);
    return v;
}

#if MK_ONE_LAUNCH
#define XB_TMO      128
#define XB_XCNT(j)  (256  + 64 * (j))
#define XB_XSUB(j)  (1280 + 64 * (j))
#define XB_XGEN(j)  (2304 + 64 * (j))
#define XB_TOP      3328
#define XB_TOPGEN   3392
#define XCD_BAR_WORDS 3456
#define XB_SPIN_CAP (1u << 18)

__device__ __forceinline__ unsigned xb_ld(unsigned* p)              { return __hip_atomic_load(p, __ATOMIC_RELAXED, __HIP_MEMORY_SCOPE_AGENT); }
__device__ __forceinline__ unsigned xb_add(unsigned* p, unsigned v) { return __hip_atomic_fetch_add(p, v, __ATOMIC_RELAXED, __HIP_MEMORY_SCOPE_AGENT); }
__device__ __forceinline__ unsigned xb_xcc_id() { return (unsigned)__builtin_amdgcn_s_getreg((3 << 11) | 20) & 0xFu; }
#define XB_SPIN(cond, bar) do { unsigned _sp = 0; while (cond) { __builtin_amdgcn_s_sleep(1); \
    if ((++_sp & 255u) == 0u) { if (xb_ld(&(bar)[XB_TMO])) break; if (_sp > XB_SPIN_CAP) { atomicAdd(&(bar)[XB_TMO], 1u); break; } } } } while (0)

struct XcdBarrier {
    unsigned* bar; unsigned x;
    volatile LAS unsigned* st;
};

__device__ __forceinline__ XcdBarrier xcd_barrier_post(unsigned* bar, volatile LAS unsigned* st) {
    XcdBarrier b; b.bar = bar; b.x = xb_xcc_id(); b.st = st;
    if (threadIdx.x == 0) (void)xb_add(&bar[XB_XCNT(b.x)], 1u);
    return b;
}
__device__ __forceinline__ void xcd_barrier_complete(unsigned* bar, unsigned x, unsigned& nloc, unsigned& nx) {
    const unsigned G = gridDim.x * gridDim.y * gridDim.z;
    unsigned sum, cnt, mine, sp = 0u;
    for (;;) {
        sum = 0u; cnt = 0u; mine = 0u;
#pragma unroll
        for (unsigned j = 0; j < 16; ++j) { const unsigned c = xb_ld(&bar[XB_XCNT(j)]); sum += c; cnt += (c > 0u) ? 1u : 0u; mine = (j == x) ? c : mine; }
        if (sum == G) break;
        __builtin_amdgcn_s_sleep(1);
        if ((++sp & 255u) == 0u) { if (xb_ld(&bar[XB_TMO])) break; if (sp > XB_SPIN_CAP) { atomicAdd(&bar[XB_TMO], 1u); break; } }
    }
    nloc = mine > 0u ? mine : 1u; nx = cnt > 0u ? cnt : 1u;
}

__device__ __forceinline__ void xcd_barrier(const XcdBarrier& b) {
    asm volatile("s_waitcnt vmcnt(0)" ::: "memory");
    __syncthreads();
    if (threadIdx.x == 0) {
        unsigned* bar = b.bar;
        __builtin_amdgcn_s_waitcnt(0);
        unsigned nloc = b.st[0], nx = b.st[1];
        if (nloc == 0u) { xcd_barrier_complete(bar, b.x, nloc, nx); b.st[0] = nloc; b.st[1] = nx; }
        const unsigned old = xb_add(&bar[XB_XSUB(b.x)], 1u);
        const unsigned gen = old / nloc;
        if (old + 1u == (gen + 1u) * nloc) {
            __builtin_amdgcn_fence(__ATOMIC_RELEASE, "agent");
            asm volatile("s_waitcnt vmcnt(0)" ::: "memory");
            const unsigned og = xb_add(&bar[XB_TOP], 1u);
            const unsigned tg = og / nx;
            if (og + 1u == (tg + 1u) * nx) xb_add(&bar[XB_TOPGEN], 1u);
            else XB_SPIN(xb_ld(&bar[XB_TOPGEN]) == tg, bar);
            __builtin_amdgcn_fence(__ATOMIC_ACQUIRE, "agent");
            xb_add(&bar[XB_XGEN(b.x)], 1u);
            asm volatile("s_waitcnt vmcnt(0)" ::: "memory");
        } else {
            XB_SPIN(xb_ld(&bar[XB_XGEN(b.x)]) == gen, bar);
            __builtin_amdgcn_fence(__ATOMIC_ACQUIRE, "agent");
            asm volatile("s_waitcnt vmcnt(0)" ::: "memory");
        }
    }
    __syncthreads();
}

#endif

struct Args { const void* in[34]; float* out; unsigned char* ws; int ph_lo, ph_hi; };

struct Ctx {
    LAS unsigned char* lds; int tid, lane, wave, vcu, G, gw, NGW;
    const float *xp, *xs, *st_conv, *st_lru, *st_re, *st_im, *c_p, *c_s, *w_ada, *b_ada, *g1, *g2, *w_in, *conv_w, *conv_b, *w_rga, *b_rga, *w_rgx, *b_rgx, *lam, *w_pa;
    const float *a_re, *a_im, *log_dt, *b_re, *b_im, *c_re, *c_im, *ssm_d, *w_glu, *w_out, *w_up, *w_dn, *g_fin;
    float* out; unsigned char* ws;
    float* modt; bf16* silu; float *abr, *abi, *bbr, *bbi, *ssr, *ssi, *lra, *lre;
    bf16 *Win, *Wpa, *Wglu, *Wout, *Wup, *Wdn, *A, *P, *HS, *GY, *T, *UC, *ACT;
};

__device__ __forceinline__ void p0_transpose_item(const float* W, int K, int N, bf16* WT, int glu, LAS float* scr, int item, int lane) {
    const int nblk = N / 32, kb = item / nblk, nb = item % nblk, k0 = 64 * kb, n0 = 32 * nb;
#pragma unroll 8
    for (int i = 0; i < 32; ++i) { const int kk = 2 * i + (lane >> 5); scr[kk * 33 + (lane & 31)] = W[(size_t)(k0 + kk) * N + n0 + (lane & 31)]; }
    LDS_WAIT(); asm volatile("" ::: "memory");
    const int c = lane & 7;
    int d0 = n0; if (glu) d0 = n0 < 2048 ? ((n0 >> 7) * 256 + (n0 & 127)) : (((n0 - 2048) >> 7) * 256 + 128 + ((n0 - 2048) & 127));
#pragma unroll
    for (int j = 0; j < 4; ++j) { const int n = (lane >> 3) + 8 * j; const LAS float* s = scr + (8 * c) * 33 + n;
        v4u o; o.x = pk2(s[0 * 33], s[1 * 33]); o.y = pk2(s[2 * 33], s[3 * 33]); o.z = pk2(s[4 * 33], s[5 * 33]); o.w = pk2(s[6 * 33], s[7 * 33]);
        *(v4u*)(WT + (size_t)(d0 + n) * K + k0 + 8 * c) = o; }
    LDS_WAIT(); asm volatile("" ::: "memory");
}
__device__ __forceinline__ void p0_phase(const Ctx& C) {
    LAS float* scr = (LAS float*)(C.lds + C.wave * 16384);
    constexpr int I_IN = (2048 / 64) * (6144 / 32), I_PA = (1024 / 64) * (2048 / 32), I_GLU = (1024 / 64) * (4096 / 32), I_OUT = (2048 / 64) * (2048 / 32), I_UP = (2048 / 64) * (8192 / 32), I_DN = (8192 / 64) * (2048 / 32);
    constexpr int NIT = I_IN + I_PA + I_GLU + I_OUT + I_UP + I_DN;
    for (int it = C.gw; it < NIT; it += C.NGW) {
        int r = it;
        if (r < I_IN) { p0_transpose_item(C.w_in, 2048, 6144, C.Win, 0, scr, r, C.lane); continue; } r -= I_IN;
        if (r < I_PA) { p0_transpose_item(C.w_pa, 1024, 2048, C.Wpa, 0, scr, r, C.lane); continue; } r -= I_PA;
        if (r < I_GLU) { p0_transpose_item(C.w_glu, 1024, 4096, C.Wglu, 1, scr, r, C.lane); continue; } r -= I_GLU;
        if (r < I_OUT) { p0_transpose_item(C.w_out, 2048, 2048, C.Wout, 0, scr, r, C.lane); continue; } r -= I_OUT;
        if (r < I_UP) { p0_transpose_item(C.w_up, 2048, 8192, C.Wup, 0, scr, r, C.lane); continue; } r -= I_UP;
        p0_transpose_item(C.w_dn, 8192, 2048, C.Wdn, 0, scr, r, C.lane);
    }
    for (int r = C.gw; r < 144; r += C.NGW) {
        const float* src = r < 4 ? C.c_p + (size_t)r * D_MODEL : C.c_s + (size_t)(r < 132 ? r - 4 : 0) * D_MODEL;
#pragma unroll
        for (int j = 0; j < 4; ++j) { const int idx = j * 512 + C.lane * 8;
            f32x4 a = *(const f32x4*)(src + idx), b = *(const f32x4*)(src + idx + 4);
#pragma unroll
            for (int i = 0; i < 4; ++i) { a[i] = a[i] * sigm(a[i]); b[i] = b[i] * sigm(b[i]); }
            if (r >= 132) { a = (f32x4){0.f, 0.f, 0.f, 0.f}; b = a; }
            v4u o; o.x = pk2(a[0], a[1]); o.y = pk2(a[2], a[3]); o.z = pk2(b[0], b[1]); o.w = pk2(b[2], b[3]);
            *(v4u*)(C.silu + (size_t)r * D_MODEL + idx) = o; }
    }
    for (int g = C.gw; g < NGRP; g += C.NGW) {
        const int idx = g * NST + C.lane;
        const float ar = C.a_re[idx], ai = C.a_im[idx], dt = expf(C.log_dt[g]);
        const float mag = expf(dt * ar), ang = dt * ai;
        float sn, cs; sincosf(ang, &sn, &cs);
        const float abr = mag * cs, abi = mag * sn;
        const float den = ar * ar + ai * ai, nr = abr - 1.0f, ni = abi;
        const float qre = (nr * ar + ni * ai) / den, qim = (ni * ar - nr * ai) / den;
        C.abr[idx] = abr; C.abi[idx] = abi;
#pragma unroll
        for (int k4 = 0; k4 < 4; ++k4) { const f32x4 br = *(const f32x4*)(C.b_re + (size_t)idx * 16 + 4 * k4), bi = *(const f32x4*)(C.b_im + (size_t)idx * 16 + 4 * k4);
            *(f32x4*)(C.bbr + (size_t)idx * 16 + 4 * k4) = qre * br - qim * bi; *(f32x4*)(C.bbi + (size_t)idx * 16 + 4 * k4) = qre * bi + qim * br; }
    }
}

__device__ __forceinline__ void mod_phase(const Ctx& C) {
    const int n = C.lane & 15, kg = C.lane >> 4;
    LAS f32x4* part = (LAS f32x4*)C.lds;
    for (int u = blockIdx.x; u < MODN / 48; u += C.G) {
        const int n0 = u * 48;
        const float* Wp = C.w_ada + (size_t)(256 * C.wave + 8 * kg) * MODN + n0 + n;
        const bf16* Ap = C.silu + (size_t)n * D_MODEL + 256 * C.wave + 8 * kg;
        f32x4 acc[9][3];
#pragma unroll
        for (int i = 0; i < 9; ++i)
#pragma unroll
            for (int j = 0; j < 3; ++j) acc[i][j] = (f32x4){0.f, 0.f, 0.f, 0.f};
        float wc[3][8], wn[3][8];
#pragma unroll
        for (int f = 0; f < 3; ++f)
#pragma unroll
            for (int j = 0; j < 8; ++j) wc[f][j] = Wp[(size_t)j * MODN + 16 * f];
#pragma unroll 1
        for (int ks = 0; ks < 8; ++ks) {
            const int kn = ks + 1 < 8 ? ks + 1 : ks;
#pragma unroll
            for (int f = 0; f < 3; ++f)
#pragma unroll
                for (int j = 0; j < 8; ++j) wn[f][j] = Wp[(size_t)(kn * 32 + j) * MODN + 16 * f];
            bf16x8 bfr[3];
#pragma unroll
            for (int f = 0; f < 3; ++f) bfr[f] = pack8((f32x4){wc[f][0], wc[f][1], wc[f][2], wc[f][3]}, (f32x4){wc[f][4], wc[f][5], wc[f][6], wc[f][7]});
#pragma unroll
            for (int mf = 0; mf < 9; ++mf) { const bf16x8 a = *(const bf16x8*)(Ap + (size_t)mf * 16 * D_MODEL + ks * 32);
#pragma unroll
                for (int f = 0; f < 3; ++f) acc[mf][f] = __builtin_amdgcn_mfma_f32_16x16x32_bf16(bfr[f], a, acc[mf][f], 0, 0, 0); }
#pragma unroll
            for (int f = 0; f < 3; ++f)
#pragma unroll
                for (int j = 0; j < 8; ++j) wc[f][j] = wn[f][j];
        }
#pragma unroll
        for (int f = 0; f < 3; ++f) {
#pragma unroll
            for (int mf = 0; mf < 9; ++mf) part[(C.wave * 9 + mf) * 64 + C.lane] = acc[mf][f];
            __syncthreads();
            for (int e = C.tid; e < 9 * 64; e += NWAVES * 64) {
                f32x4 sm = part[e];
#pragma unroll
                for (int wv = 1; wv < 8; ++wv) sm += part[wv * 576 + e];
                const int mf = e >> 6, l64 = e & 63, row = mf * 16 + (l64 & 15), col = n0 + 16 * f + 4 * (l64 >> 4);
                *(f32x4*)(C.modt + (size_t)row * MODN + col) = sm + *(const f32x4*)(C.b_ada + col);
            }
            __syncthreads();
        }
    }
}

__device__ __forceinline__ void norm_mod_phase(const Ctx& C, const float* xp, const float* xs, const float* g, int sh_off, int sc_off, bf16* O) {
    const int r0 = (int)(((long)C.gw * MR) / C.NGW), r1 = (int)(((long)(C.gw + 1) * MR) / C.NGW);
    if (r0 >= r1) return;
    f32x4 gs[8], sh[8], v[8], vn[8];
    int cur_m = -1;
#pragma unroll
    for (int j = 0; j < 8; ++j) { const float* xr = r0 < MP ? xp + (size_t)r0 * D_MODEL : xs + (size_t)(r0 - MP) * D_MODEL; v[j] = *(const f32x4*)(xr + 256 * j + 4 * C.lane); }
    for (int row = r0; row < r1; ++row) {
        if (row + 1 < r1) { const float* xr = row + 1 < MP ? xp + (size_t)(row + 1) * D_MODEL : xs + (size_t)(row + 1 - MP) * D_MODEL;
#pragma unroll
            for (int j = 0; j < 8; ++j) vn[j] = *(const f32x4*)(xr + 256 * j + 4 * C.lane); }
        const int m = pg8::mod_row(row);
        if (m != cur_m) { cur_m = m; const float* mr = C.modt + (size_t)m * MODN;
#pragma unroll
            for (int j = 0; j < 8; ++j) { const int col = 256 * j + 4 * C.lane; gs[j] = *(const f32x4*)(g + col) * (1.0f + *(const f32x4*)(mr + sc_off + col)); sh[j] = *(const f32x4*)(mr + sh_off + col); } }
        float ss = 0.f;
#pragma unroll
        for (int j = 0; j < 8; ++j) ss += (v[j][0] * v[j][0] + v[j][1] * v[j][1]) + (v[j][2] * v[j][2] + v[j][3] * v[j][3]);
        const float rstd = 1.0f / sqrtf(wave_sum(ss) * (1.0f / D_MODEL) + EPS);
#pragma unroll
        for (int j = 0; j < 8; ++j) { const int col = 256 * j + 4 * C.lane;
            const f32x4 o = v[j] * rstd * gs[j] + sh[j];
            v2u w; w.x = pk2(o[0], o[1]); w.y = pk2(o[2], o[3]);
            *(v2u*)(O + (size_t)row * D_MODEL + col) = w; }
#pragma unroll
        for (int j = 0; j < 8; ++j) v[j] = vn[j];
    }
}
__device__ __forceinline__ void final_norm_phase(const Ctx& C) {
    const int r0 = (int)(((long)C.gw * MR) / C.NGW), r1 = (int)(((long)(C.gw + 1) * MR) / C.NGW);
    if (r0 >= r1) return;
    f32x4 gf[8], v[8], vn[8];
#pragma unroll
    for (int j = 0; j < 8; ++j) { gf[j] = *(const f32x4*)(C.g_fin + 256 * j + 4 * C.lane); v[j] = *(const f32x4*)(C.out + (size_t)r0 * D_MODEL + 256 * j + 4 * C.lane); }
    for (int row = r0; row < r1; ++row) {
        float* xr = C.out + (size_t)row * D_MODEL;
        if (row + 1 < r1) {
#pragma unroll
            for (int j = 0; j < 8; ++j) vn[j] = *(const f32x4*)(xr + D_MODEL + 256 * j + 4 * C.lane); }
        float ss = 0.f;
#pragma unroll
        for (int j = 0; j < 8; ++j) ss += (v[j][0] * v[j][0] + v[j][1] * v[j][1]) + (v[j][2] * v[j][2] + v[j][3] * v[j][3]);
        const float rstd = 1.0f / sqrtf(wave_sum(ss) * (1.0f / D_MODEL) + EPS);
#pragma unroll
        for (int j = 0; j < 8; ++j) *(f32x4*)(xr + 256 * j + 4 * C.lane) = v[j] * rstd * gf[j];
#pragma unroll
        for (int j = 0; j < 8; ++j) v[j] = vn[j];
    }
}

__device__ __forceinline__ f32x16 zero16() { return f32x16{}; }

constexpr int TROW = 272;
constexpr int TILE256 = 256 * TROW, TILE128 = 128 * TROW;
static_assert(TILE256 + NWAVES * 8704 <= LDSCTL_OFF && 4 * TILE128 <= LDSCTL_OFF, "scan LDS map");

__device__ __forceinline__ void new_conv_prompt(const Ctx& C) {
    const int nthr = C.G * NWAVES * 64;
    for (int idx = C.vcu * (NWAVES * 64) + C.tid; idx < NB * 3 * W_LRU; idx += nthr) {
        const int ch = idx & (W_LRU - 1), k = (idx >> 10) % 3, b = idx / (3 * W_LRU);
        C.out[O_CP + idx] = bf2f(C.P[(size_t)(b * SEQ + SEQ - 3 + k) * NPROJ + ch]);
    }
}

template <bool APPLY>
__device__ __forceinline__ void s5_block(const Ctx& C, int go, int q) {
    const int lane = C.lane, c31 = lane & 31, kh = lane >> 5, w = C.wave, g = go * 8 + w;
    const int asel = (c31 >> 2) & 1, atok = (c31 & 3) + 4 * (c31 >> 3);
    const int b = q >> 3, cX = 2 * (q & 7), myc = cX + kh;
    const int rowX = b * SEQ + cX * S5_TC;
    LAS unsigned char* tile = C.lds;
    {
        const int rr = C.tid >> 4, cc = (C.tid & 15) * 8;
        v4u tmp[8];
#pragma unroll
        for (int i = 0; i < 8; ++i) tmp[i] = *(const v4u*)(C.P + (size_t)(rowX + i * 32 + rr) * NPROJ + W_LRU + go * 128 + cc);
#pragma unroll
        for (int i = 0; i < 8; ++i) *(LAS v4u*)(tile + (i * 32 + rr) * TROW + cc * 2) = tmp[i];
    }
    bf16x8 bb[2][2]; float ar[2], ai[2], hr[2], hi[2];
#pragma unroll
    for (int ph = 0; ph < 2; ++ph) { const int idx = g * NST + ph * 32 + c31;
        ar[ph] = C.abr[idx]; ai[ph] = C.abi[idx]; hr[ph] = 0.f; hi[ph] = 0.f;
        const f32x4* sr = (const f32x4*)(C.bbr + (size_t)idx * 16 + 8 * kh); const f32x4* si = (const f32x4*)(C.bbi + (size_t)idx * 16 + 8 * kh);
        bb[0][ph] = pack8(sr[0], sr[1]); bb[1][ph] = pack8(si[0], si[1]); }
    bf16x8 cb[8];
    float dsk = 0.f;
    if (APPLY) {
#pragma unroll
        for (int ph = 0; ph < 2; ++ph) { float pr = ar[ph], pi = ai[ph];
#pragma unroll
            for (int s = 0; s < 7; ++s) { const float nr = pr * pr - pi * pi, ni = 2.0f * pr * pi; pr = nr; pi = ni; }
            const size_t sidx = (size_t)g * NST + ph * 32 + c31; float Hr = 0.f, Hi = 0.f;
#pragma unroll
            for (int j = 0; j < S5_NCH - 1; ++j) { const float sr = C.ssr[(size_t)(b * S5_NCH + j) * 4096 + sidx], si = C.ssi[(size_t)(b * S5_NCH + j) * 4096 + sidx];
                const float nr = pr * Hr - pi * Hi + sr, ni = pr * Hi + pi * Hr + si; if (j < myc) { Hr = nr; Hi = ni; } }
            hr[ph] = Hr; hi[ph] = Hi; }
#pragma unroll
        for (int s = 0; s < 8; ++s) { f32x4 a = (f32x4){0.f, 0.f, 0.f, 0.f}, bq = a;
            if (c31 < 16) { const float* src = (s < 4 ? C.c_re : C.c_im) + (size_t)(g * GSZ + c31) * NST + 16 * (s & 3) + 8 * kh; a = *(const f32x4*)src; bq = *(const f32x4*)(src + 4); if (s >= 4) { a = -a; bq = -bq; } }
            cb[s] = pack8(a, bq); }
        dsk = C.ssm_d[g * GSZ + (c31 & 15)];
    }
    __syncthreads();
    LAS bf16* hl = (LAS bf16*)(C.lds + TILE256 + w * 8704);
    const LAS unsigned char* abase = tile + (asel * S5_TC + atok) * TROW + (16 * w + 8 * kh) * 2;
    LAS bf16* ubase = (LAS bf16*)(tile + (kh * S5_TC) * TROW) + 16 * w + (c31 & 15);
    for (int st = 0; st < S5_TC / 16; ++st) {
        const bf16x8 af = *(const LAS bf16x8*)(abase + st * 16 * TROW);
        const f32x16 z = zero16();
        f32x16 re0 = __builtin_amdgcn_mfma_f32_32x32x16_bf16(af, bb[0][0], z, 0, 0, 0), re1 = __builtin_amdgcn_mfma_f32_32x32x16_bf16(af, bb[0][1], z, 0, 0, 0);
        f32x16 im0 = __builtin_amdgcn_mfma_f32_32x32x16_bf16(af, bb[1][0], z, 0, 0, 0), im1 = __builtin_amdgcn_mfma_f32_32x32x16_bf16(af, bb[1][1], z, 0, 0, 0);
#pragma unroll
        for (int r = 0; r < 16; ++r) {
            { const float nr = ar[0] * hr[0] - ai[0] * hi[0] + re0[r], ni = ar[0] * hi[0] + ai[0] * hr[0] + im0[r]; hr[0] = nr; hi[0] = ni; re0[r] = nr; im0[r] = ni; }
            { const float nr = ar[1] * hr[1] - ai[1] * hi[1] + re1[r], ni = ar[1] * hi[1] + ai[1] * hr[1] + im1[r]; hr[1] = nr; hi[1] = ni; re1[r] = nr; im1[r] = ni; }
        }
        if (APPLY) {
#pragma unroll
            for (int r = 0; r < 16; ++r) { const int rho = (r & 3) + 4 * kh + 8 * (r >> 2);
                const unsigned wre = pk2(re0[r], re1[r]), wim = pk2(im0[r], im1[r]);
                hl[rho * 136 + c31] = (bf16)wre; hl[rho * 136 + 32 + c31] = (bf16)(wre >> 16);
                hl[rho * 136 + 64 + c31] = (bf16)wim; hl[rho * 136 + 96 + c31] = (bf16)(wim >> 16); }
            f32x16 y = zero16();
#pragma unroll
            for (int s = 0; s < 8; ++s) { const bf16x8 hA = *(const LAS bf16x8*)(hl + c31 * 136 + 16 * s + 8 * kh); y = __builtin_amdgcn_mfma_f32_32x32x16_bf16(hA, cb[s], y, 0, 0, 0); }
            if (c31 < 16) {
#pragma unroll
                for (int r = 0; r < 16; ++r) { LAS bf16* up = ubase + (st * 16 + r) * (TROW / 2);
                    const float u = bf2f(*up); { const float gv = gelu_tanh(y[r] + dsk * u); *up = (bf16)pk2(gv, gv); } } }
        }
    }
#pragma unroll
    for (int ph = 0; ph < 2; ++ph) { const size_t sidx = (size_t)g * NST + ph * 32 + c31;
        if (!APPLY) { C.ssr[(size_t)(b * S5_NCH + myc) * 4096 + sidx] = hr[ph]; C.ssi[(size_t)(b * S5_NCH + myc) * 4096 + sidx] = hi[ph]; }
        else if (myc == S5_NCH - 1) { C.out[O_RP + (size_t)b * 4096 + sidx] = hr[ph]; C.out[O_IP + (size_t)b * 4096 + sidx] = hi[ph]; } }
    __syncthreads();
    if (APPLY) {
        const int rr = C.tid >> 4, cc = (C.tid & 15) * 8;
#pragma unroll
        for (int i = 0; i < 8; ++i) *(v4u*)(C.GY + (size_t)(rowX + i * 32 + rr) * W_SSM + go * 128 + cc) = *(const LAS v4u*)(tile + (i * 32 + rr) * TROW + cc * 2);
        __syncthreads();
    }
}

template <bool APPLY>
__device__ __forceinline__ void lru_block(const Ctx& C, int U) {
    const int lane = C.lane, c31 = lane & 31, kh = lane >> 5, sub = C.wave >> 2, jt = C.wave & 3;
    const int asel = (c31 >> 2) & 1, atok = (c31 & 3) + 4 * (c31 >> 3);
    const int cmb = 2 * U + sub, hd = cmb & 7, q = cmb >> 3;
    const int b = q >> 4, cX = 2 * (q & 15), myc = cX + kh;
    const int rowX = b * SEQ + cX * LR_TC;
    const int ch = hd * HDIM + jt * 32 + c31;
    LAS unsigned char* tin = C.lds + sub * TILE128;
    LAS unsigned char* tout = C.lds + 2 * TILE128 + sub * TILE128;
    {
        const int tt = C.tid & 255, rr = tt >> 4, c0 = hd * HDIM + (tt & 15) * 8;
        f32x4 cw0[4], cw1[4];
#pragma unroll
        for (int d = 0; d < 4; ++d) { cw0[d] = *(const f32x4*)(C.conv_w + (3 - d) * W_LRU + c0); cw1[d] = *(const f32x4*)(C.conv_w + (3 - d) * W_LRU + c0 + 4); }
        const f32x4 cb0 = *(const f32x4*)(C.conv_b + c0), cb1 = *(const f32x4*)(C.conv_b + c0 + 4);
#pragma unroll 2
        for (int i = 0; i < 8; ++i) { const int r = i * 16 + rr, row = rowX + r, t = row & (SEQ - 1);
            f32x4 a0 = cb0, a1 = cb1;
#pragma unroll
            for (int d = 0; d < 4; ++d) {
                if (t - d >= 0) { const v4u u = *(const v4u*)(C.P + (size_t)(row - d) * NPROJ + c0);
                    a0[0] += cw0[d][0] * bflo(u.x); a0[1] += cw0[d][1] * bfhi(u.x); a0[2] += cw0[d][2] * bflo(u.y); a0[3] += cw0[d][3] * bfhi(u.y);
                    a1[0] += cw1[d][0] * bflo(u.z); a1[1] += cw1[d][1] * bfhi(u.z); a1[2] += cw1[d][2] * bflo(u.w); a1[3] += cw1[d][3] * bfhi(u.w); } }
            v4u o; o.x = pk2(a0[0], a0[1]); o.y = pk2(a0[2], a0[3]); o.z = pk2(a1[0], a1[1]); o.w = pk2(a1[2], a1[3]);
            *(LAS v4u*)(tin + r * TROW + (tt & 15) * 16) = o; }
    }
    bf16x8 wa[8], wx[8];
#pragma unroll
    for (int s = 0; s < 8; ++s) { float ta[8], tx[8];
#pragma unroll
        for (int j = 0; j < 8; ++j) { const size_t wi = (size_t)(hd * HDIM + 16 * s + 8 * kh + j) * HDIM + jt * 32 + c31; ta[j] = C.w_rga[wi]; tx[j] = C.w_rgx[wi]; }
        wa[s] = pack8((f32x4){ta[0], ta[1], ta[2], ta[3]}, (f32x4){ta[4], ta[5], ta[6], ta[7]}); wx[s] = pack8((f32x4){tx[0], tx[1], tx[2], tx[3]}, (f32x4){tx[4], tx[5], tx[6], tx[7]}); }
    const float ba = C.b_rga[ch], bx = C.b_rgx[ch];
    const float lm = C.lam[ch];
    const float sp8 = 8.0f * (fmaxf(-lm, 0.f) + log1pf(expf(-fabsf(lm))));
    float h = 0.f, aprod = 1.f;
    if (APPLY) { float H = 0.f;
#pragma unroll
        for (int j = 0; j < LR_NCH - 1; ++j) { const float A = C.lra[(size_t)(b * LR_NCH + j) * W_LRU + ch], E = C.lre[(size_t)(b * LR_NCH + j) * W_LRU + ch]; const float nh = A * H + E; if (j < myc) H = nh; }
        h = H; }
    __syncthreads();
    const LAS unsigned char* abase = tin + (asel * LR_TC + atok) * TROW + 8 * kh * 2;
    const LAS bf16* ucb = (const LAS bf16*)(tin + (kh * LR_TC) * TROW) + jt * 32 + c31;
    LAS bf16* hob = (LAS bf16*)(tout + (kh * LR_TC) * TROW) + jt * 32 + c31;
    for (int st = 0; st < LR_TC / 16; ++st) {
        f32x16 pr = zero16(), pi = zero16();
#pragma unroll
        for (int s = 0; s < 8; ++s) { const bf16x8 af = *(const LAS bf16x8*)(abase + st * 16 * TROW + 32 * s);
            pr = __builtin_amdgcn_mfma_f32_32x32x16_bf16(af, wa[s], pr, 0, 0, 0); pi = __builtin_amdgcn_mfma_f32_32x32x16_bf16(af, wx[s], pi, 0, 0, 0); }
#pragma unroll
        for (int r = 0; r < 16; ++r) {
            const float uc = bf2f(ucb[(st * 16 + r) * (TROW / 2)]);
            const float rr = sigm(pr[r] + ba), ii = sigm(pi[r] + bx);
            const float la = -sp8 * rr, a = __builtin_amdgcn_exp2f(1.44269504f * la);
            const float t2 = 2.0f * la;
            const float om = t2 > -0.25f ? -t2 * (1.0f + t2 * (0.5f + t2 * (0.16666667f + t2 * (0.041666668f + t2 * (0.008333334f + t2 * 0.0013888889f))))) : 1.0f - a * a;
            const float mult = sqrtf(fmaxf(om, 0.f));
            h = a * h + mult * ii * uc; aprod *= a;
            if (APPLY) hob[(st * 16 + r) * (TROW / 2)] = (bf16)pk2(h, h); }
    }
    if (!APPLY) { C.lra[(size_t)(b * LR_NCH + myc) * W_LRU + ch] = aprod; C.lre[(size_t)(b * LR_NCH + myc) * W_LRU + ch] = h; }
    else if (myc == LR_NCH - 1) C.out[O_LP + (size_t)b * W_LRU + ch] = h;
    __syncthreads();
    if (APPLY) {
        const int tt = C.tid & 255, rr = tt >> 4, cc = (tt & 15) * 8;
#pragma unroll
        for (int i = 0; i < 8; ++i) *(v4u*)(C.HS + (size_t)(rowX + i * 16 + rr) * W_LRU + hd * HDIM + cc) = *(const LAS v4u*)(tout + (i * 16 + rr) * TROW + cc * 2);
        __syncthreads();
    }
}

__device__ __forceinline__ void lru_sample_block(const Ctx& C, int U) {
    const int lane = C.lane, c31 = lane & 31, kh = lane >> 5, sub = C.wave >> 2, jt = C.wave & 3;
    const int cmb = 2 * U + sub, hd = cmb & 7, sb = cmb >> 3;
    const int ch = hd * HDIM + jt * 32 + c31;
    LAS unsigned char* tin = C.lds + sub * TILE128;
    {
        const int tt = C.tid & 255, rr = tt >> 4, c0 = hd * HDIM + (tt & 15) * 8;
#pragma unroll
        for (int i = 0; i < 2; ++i) { const int rho = i * 16 + rr, sidx = sb * 32 + rho;
            const v4u u = *(const v4u*)(C.P + (size_t)(MP + sidx) * NPROJ + c0);
            const f32x4 u0 = (f32x4){bflo(u.x), bfhi(u.x), bflo(u.y), bfhi(u.y)}, u1 = (f32x4){bflo(u.z), bfhi(u.z), bflo(u.w), bfhi(u.w)};
            f32x4 a0 = *(const f32x4*)(C.conv_b + c0) + *(const f32x4*)(C.conv_w + 3 * W_LRU + c0) * u0, a1 = *(const f32x4*)(C.conv_b + c0 + 4) + *(const f32x4*)(C.conv_w + 3 * W_LRU + c0 + 4) * u1;
            float* nc = C.out + O_CS + (size_t)sidx * 3 * W_LRU + c0;
#pragma unroll
            for (int k = 0; k < 3; ++k) { const f32x4 s0 = *(const f32x4*)(C.st_conv + (size_t)(sidx * 3 + k) * W_LRU + c0), s1 = *(const f32x4*)(C.st_conv + (size_t)(sidx * 3 + k) * W_LRU + c0 + 4);
                a0 += *(const f32x4*)(C.conv_w + k * W_LRU + c0) * s0; a1 += *(const f32x4*)(C.conv_w + k * W_LRU + c0 + 4) * s1;
                if (k > 0) { *(f32x4*)(nc + (k - 1) * W_LRU) = s0; *(f32x4*)(nc + (k - 1) * W_LRU + 4) = s1; } }
            *(f32x4*)(nc + 2 * W_LRU) = u0; *(f32x4*)(nc + 2 * W_LRU + 4) = u1;
            v4u o; o.x = pk2(a0[0], a0[1]); o.y = pk2(a0[2], a0[3]); o.z = pk2(a1[0], a1[1]); o.w = pk2(a1[2], a1[3]);
            *(LAS v4u*)(tin + rho * TROW + (tt & 15) * 16) = o; }
    }
    bf16x8 wa[8], wx[8];
#pragma unroll
    for (int s = 0; s < 8; ++s) { float ta[8], tx[8];
#pragma unroll
        for (int j = 0; j < 8; ++j) { const size_t wi = (size_t)(hd * HDIM + 16 * s + 8 * kh + j) * HDIM + jt * 32 + c31; ta[j] = C.w_rga[wi]; tx[j] = C.w_rgx[wi]; }
        wa[s] = pack8((f32x4){ta[0], ta[1], ta[2], ta[3]}, (f32x4){ta[4], ta[5], ta[6], ta[7]}); wx[s] = pack8((f32x4){tx[0], tx[1], tx[2], tx[3]}, (f32x4){tx[4], tx[5], tx[6], tx[7]}); }
    const float ba = C.b_rga[ch], bx = C.b_rgx[ch];
    const float lm = C.lam[ch];
    const float sp8 = 8.0f * (fmaxf(-lm, 0.f) + log1pf(expf(-fabsf(lm))));
    __syncthreads();
    f32x16 pr = zero16(), pi = zero16();
#pragma unroll
    for (int s = 0; s < 8; ++s) { const bf16x8 af = *(const LAS bf16x8*)(tin + c31 * TROW + 16 * kh + 32 * s);
        pr = __builtin_amdgcn_mfma_f32_32x32x16_bf16(af, wa[s], pr, 0, 0, 0); pi = __builtin_amdgcn_mfma_f32_32x32x16_bf16(af, wx[s], pi, 0, 0, 0); }
#pragma unroll
    for (int r = 0; r < 16; ++r) { const int rho = (r & 3) + 8 * (r >> 2) + 4 * kh, sidx = sb * 32 + rho;
        const float uc = bf2f(*((const LAS bf16*)(tin + rho * TROW) + jt * 32 + c31));
        const float rr = sigm(pr[r] + ba), ii = sigm(pi[r] + bx);
        const float la = -sp8 * rr, a = __builtin_amdgcn_exp2f(1.44269504f * la);
        const float t2 = 2.0f * la;
        const float om = t2 > -0.25f ? -t2 * (1.0f + t2 * (0.5f + t2 * (0.16666667f + t2 * (0.041666668f + t2 * (0.008333334f + t2 * 0.0013888889f))))) : 1.0f - a * a;
        const float h = a * C.st_lru[(size_t)sidx * W_LRU + ch] + sqrtf(fmaxf(om, 0.f)) * ii * uc;
        C.out[O_LS + (size_t)sidx * W_LRU + ch] = h;
        C.HS[(size_t)(MP + sidx) * W_LRU + ch] = (bf16)pk2(h, h); }
    __syncthreads();
}
__device__ __forceinline__ void s5_sample_wave(const Ctx& C, int g, int sb, LAS bf16* hl) {
    const int lane = C.lane, c31 = lane & 31, kh = lane >> 5;
    bf16x8 bb[2][2]; float ar[2], ai[2];
#pragma unroll
    for (int ph = 0; ph < 2; ++ph) { const int idx = g * NST + ph * 32 + c31;
        ar[ph] = C.abr[idx]; ai[ph] = C.abi[idx];
        const f32x4* sr = (const f32x4*)(C.bbr + (size_t)idx * 16 + 8 * kh); const f32x4* si = (const f32x4*)(C.bbi + (size_t)idx * 16 + 8 * kh);
        bb[0][ph] = pack8(sr[0], sr[1]); bb[1][ph] = pack8(si[0], si[1]); }
    bf16x8 cb[8];
#pragma unroll
    for (int s = 0; s < 8; ++s) { f32x4 a = (f32x4){0.f, 0.f, 0.f, 0.f}, bq = a;
        if (c31 < 16) { const float* src = (s < 4 ? C.c_re : C.c_im) + (size_t)(g * GSZ + c31) * NST + 16 * (s & 3) + 8 * kh; a = *(const f32x4*)src; bq = *(const f32x4*)(src + 4); if (s >= 4) { a = -a; bq = -bq; } }
        cb[s] = pack8(a, bq); }
    const float dsk = C.ssm_d[g * GSZ + (c31 & 15)];
    const bf16x8 af = *(const bf16x8*)(C.P + (size_t)(MP + sb * 32 + c31) * NPROJ + W_LRU + g * GSZ + 8 * kh);
    const f32x16 z = zero16();
    f32x16 re0 = __builtin_amdgcn_mfma_f32_32x32x16_bf16(af, bb[0][0], z, 0, 0, 0), re1 = __builtin_amdgcn_mfma_f32_32x32x16_bf16(af, bb[0][1], z, 0, 0, 0);
    f32x16 im0 = __builtin_amdgcn_mfma_f32_32x32x16_bf16(af, bb[1][0], z, 0, 0, 0), im1 = __builtin_amdgcn_mfma_f32_32x32x16_bf16(af, bb[1][1], z, 0, 0, 0);
#pragma unroll
    for (int r = 0; r < 16; ++r) { const int rho = (r & 3) + 8 * (r >> 2) + 4 * kh; const size_t so = (size_t)(sb * 32 + rho) * 4096 + g * NST + c31;
        const float a0r = C.st_re[so], a0i = C.st_im[so], a1r = C.st_re[so + 32], a1i = C.st_im[so + 32];
        const float h0r = ar[0] * a0r - ai[0] * a0i + re0[r], h0i = ar[0] * a0i + ai[0] * a0r + im0[r];
        const float h1r = ar[1] * a1r - ai[1] * a1i + re1[r], h1i = ar[1] * a1i + ai[1] * a1r + im1[r];
        C.out[O_RS + so] = h0r; C.out[O_IS + so] = h0i; C.out[O_RS + so + 32] = h1r; C.out[O_IS + so + 32] = h1i;
        const unsigned wre = pk2(h0r, h1r), wim = pk2(h0i, h1i);
        hl[rho * 136 + c31] = (bf16)wre; hl[rho * 136 + 32 + c31] = (bf16)(wre >> 16);
        hl[rho * 136 + 64 + c31] = (bf16)wim; hl[rho * 136 + 96 + c31] = (bf16)(wim >> 16); }
    f32x16 y = zero16();
#pragma unroll
    for (int s = 0; s < 8; ++s) { const bf16x8 hA = *(const LAS bf16x8*)(hl + c31 * 136 + 16 * s + 8 * kh); y = __builtin_amdgcn_mfma_f32_32x32x16_bf16(hA, cb[s], y, 0, 0, 0); }
    if (c31 < 16) { const int ch = g * GSZ + c31;
#pragma unroll
        for (int r = 0; r < 16; ++r) { const size_t row = (size_t)(MP + sb * 32 + (r & 3) + 8 * (r >> 2) + 4 * kh);
            const float u = bf2f(C.P[row * NPROJ + W_LRU + ch]); const float gv = gelu_tanh(y[r] + dsk * u);
            C.GY[row * W_SSM + ch] = (bf16)pk2(gv, gv); } }
    LDS_WAIT(); asm volatile("" ::: "memory");
}

template <int MF, int NF, int UNR, class Epi>
__device__ __forceinline__ void skinny_gemm(const Ctx& C, const bf16* A, const bf16* Wt, int K, int ncb, const Epi& E) {
    constexpr int RB = MF * 16, NRB = 128 / RB;
    const int ntiles = NRB * ncb, l15 = C.lane & 15, kg = C.lane >> 4, kw = K / NWAVES;
    LAS f32x4* part = (LAS f32x4*)C.lds;
    for (int t = blockIdx.x; t < ntiles; t += C.G) {
        const int rb = t % NRB, cb = t / NRB;
        f32x4 acc[MF][NF];
#pragma unroll
        for (int i = 0; i < MF; ++i)
#pragma unroll
            for (int j = 0; j < NF; ++j) acc[i][j] = (f32x4){0.f, 0.f, 0.f, 0.f};
        const bf16* Ap = A + (size_t)(rb * RB + l15) * K + C.wave * kw + 8 * kg;
        const bf16* Bp[NF];
#pragma unroll
        for (int j = 0; j < NF; ++j) Bp[j] = Wt + (size_t)(E.brow(cb, j) + l15) * K + C.wave * kw + 8 * kg;
#pragma unroll UNR
        for (int ks = 0; ks < kw / 32; ++ks) {
            bf16x8 a[MF], b[NF];
#pragma unroll
            for (int i = 0; i < MF; ++i) a[i] = *(const bf16x8*)(Ap + (size_t)i * 16 * K + ks * 32);
#pragma unroll
            for (int j = 0; j < NF; ++j) b[j] = *(const bf16x8*)(Bp[j] + ks * 32);
#pragma unroll
            for (int i = 0; i < MF; ++i)
#pragma unroll
                for (int j = 0; j < NF; ++j) acc[i][j] = __builtin_amdgcn_mfma_f32_16x16x32_bf16(b[j], a[i], acc[i][j], 0, 0, 0);
        }
#pragma unroll
        for (int i = 0; i < MF; ++i)
#pragma unroll
            for (int j = 0; j < NF; ++j) part[((C.wave * MF + i) * NF + j) * 64 + C.lane] = acc[i][j];
        __syncthreads();
        for (int q = C.tid; q < MF * 64; q += NWAVES * 64) { const int mf = q >> 6, l64 = q & 63;
            f32x4 v[NF];
#pragma unroll
            for (int j = 0; j < NF; ++j) { f32x4 s = part[((0 * MF + mf) * NF + j) * 64 + l64];
#pragma unroll
                for (int wv = 1; wv < NWAVES; ++wv) s += part[((wv * MF + mf) * NF + j) * 64 + l64];
                v[j] = s; }
            E(rb * RB + mf * 16 + (l64 & 15), cb, l64 >> 4, v); }
        __syncthreads();
    }
}
struct SEpiProj { bf16* P;
    __device__ __forceinline__ int brow(int cb, int nf) const { return cb * 32 + nf * 16; }
    __device__ __forceinline__ void operator()(int r, int cb, int cq, const f32x4 (&v)[2]) const {
#pragma unroll
        for (int nf = 0; nf < 2; ++nf) { const int col = cb * 32 + nf * 16 + 4 * cq; f32x4 x = v[nf];
            if (col >= 2048) {
#pragma unroll
                for (int i = 0; i < 4; ++i) x[i] = sigm(x[i]); }
            v2u w; w.x = pk2(x[0], x[1]); w.y = pk2(x[2], x[3]); *(v2u*)(P + (size_t)(MP + r) * NPROJ + col) = w; } } };
struct SEpiGateA { bf16* T; const bf16* P;
    __device__ __forceinline__ int brow(int cb, int nf) const { return cb * 32 + nf * 16; }
    __device__ __forceinline__ void operator()(int r, int cb, int cq, const f32x4 (&v)[2]) const {
#pragma unroll
        for (int nf = 0; nf < 2; ++nf) { const int col = cb * 32 + nf * 16 + 4 * cq; const f32x4 x = v[nf];
            const v2u g = *(const v2u*)(P + (size_t)(MP + r) * NPROJ + 2048 + col);
            v2u w; w.x = pk2(x[0] * bflo(g.x), x[1] * bfhi(g.x)); w.y = pk2(x[2] * bflo(g.y), x[3] * bfhi(g.y)); *(v2u*)(T + (size_t)(MP + r) * D_MODEL + col) = w; } } };
struct SEpiGlu { bf16* MG; const bf16* T; const bf16* P;
    __device__ __forceinline__ int brow(int cb, int nf) const { const int v0 = cb * 16; return (v0 >> 7) * 256 + (v0 & 127) + nf * 128; }
    __device__ __forceinline__ void operator()(int r, int cb, int cq, const f32x4 (&v)[2]) const {
        const int col = cb * 16 + 4 * cq; const f32x4 a = v[0], g = v[1];
        const v2u t = *(const v2u*)(T + (size_t)(MP + r) * D_MODEL + col), z = *(const v2u*)(P + (size_t)(MP + r) * NPROJ + 4096 + col);
        v2u w; w.x = pk2(bflo(t.x) + bflo(z.x) * (a[0] * sigm(g[0])), bfhi(t.x) + bfhi(z.x) * (a[1] * sigm(g[1])));
        w.y = pk2(bflo(t.y) + bflo(z.y) * (a[2] * sigm(g[2])), bfhi(t.y) + bfhi(z.y) * (a[3] * sigm(g[3])));
        *(v2u*)(MG + (size_t)(MP + r) * D_MODEL + col) = w; } };
struct SEpiRes { const float* xin; float* out; const float* modt; int goff;
    __device__ __forceinline__ int brow(int cb, int nf) const { return cb * 32 + nf * 16; }
    __device__ __forceinline__ void operator()(int r, int cb, int cq, const f32x4 (&v)[2]) const {
#pragma unroll
        for (int nf = 0; nf < 2; ++nf) { const int col = cb * 32 + nf * 16 + 4 * cq;
            const f32x4 g = *(const f32x4*)(modt + (size_t)(4 + r) * MODN + goff + col), xv = *(const f32x4*)(xin + (size_t)r * D_MODEL + col);
            *(f32x4*)(out + (size_t)r * D_MODEL + col) = xv + g * v[nf]; } } };
struct SEpiRelu2 { bf16* O;
    __device__ __forceinline__ int brow(int cb, int nf) const { return cb * 32 + nf * 16; }
    __device__ __forceinline__ void operator()(int r, int cb, int cq, const f32x4 (&v)[2]) const {
#pragma unroll
        for (int nf = 0; nf < 2; ++nf) { const int col = cb * 32 + nf * 16 + 4 * cq; f32x4 x = v[nf];
#pragma unroll
            for (int i = 0; i < 4; ++i) { const float a = fmaxf(x[i], 0.f); x[i] = a * a; }
            v2u w; w.x = pk2(x[0], x[1]); w.y = pk2(x[2], x[3]); *(v2u*)(O + (size_t)(MP + r) * D_FF + col) = w; } } };

enum { PH_P0 = 0, PH_MOD, PH_H1, PH_G1, PH_SA, PH_SB, PH_G3, PH_G4, PH_G5, PH_H2, PH_G6, PH_G7, PH_FIN, N_PHASES };

__global__ void __launch_bounds__(NWAVES * 64, 2) hybrid_fwd(Args args) {
    extern __shared__ __attribute__((aligned(16))) unsigned char lds[];
    Ctx C;
    C.lds = (LAS unsigned char*)lds;
    C.tid = threadIdx.x; C.lane = C.tid & 63; C.wave = __builtin_amdgcn_readfirstlane(C.tid >> 6);
    C.G = gridDim.x; { const int bx = blockIdx.x; C.vcu = (C.G % 8 == 0) ? (bx % 8) * (C.G / 8) + bx / 8 : bx; }
    C.gw = C.vcu * NWAVES + C.wave; C.NGW = C.G * NWAVES;
    C.xp = (const float*)args.in[0]; C.xs = (const float*)args.in[1]; C.st_conv = (const float*)args.in[2]; C.st_lru = (const float*)args.in[3]; C.st_re = (const float*)args.in[4]; C.st_im = (const float*)args.in[5];
    C.c_p = (const float*)args.in[6]; C.c_s = (const float*)args.in[7]; C.w_ada = (const float*)args.in[8]; C.b_ada = (const float*)args.in[9]; C.g1 = (const float*)args.in[10]; C.g2 = (const float*)args.in[11];
    C.w_in = (const float*)args.in[12]; C.conv_w = (const float*)args.in[13]; C.conv_b = (const float*)args.in[14]; C.w_rga = (const float*)args.in[15]; C.b_rga = (const float*)args.in[16]; C.w_rgx = (const float*)args.in[17];
    C.b_rgx = (const float*)args.in[18]; C.lam = (const float*)args.in[19]; C.w_pa = (const float*)args.in[20]; C.a_re = (const float*)args.in[21]; C.a_im = (const float*)args.in[22]; C.log_dt = (const float*)args.in[23];
    C.b_re = (const float*)args.in[24]; C.b_im = (const float*)args.in[25]; C.c_re = (const float*)args.in[26]; C.c_im = (const float*)args.in[27]; C.ssm_d = (const float*)args.in[28]; C.w_glu = (const float*)args.in[29];
    C.w_out = (const float*)args.in[30]; C.w_up = (const float*)args.in[31]; C.w_dn = (const float*)args.in[32]; C.g_fin = (const float*)args.in[33];
    C.out = args.out; C.ws = args.ws;
    unsigned char* ws = args.ws;
    C.modt = (float*)(ws + WS_MOD); C.silu = (bf16*)(ws + WS_TAB + TB_SILU);
    C.abr = (float*)(ws + WS_TAB + TB_ABR); C.abi = (float*)(ws + WS_TAB + TB_ABI); C.bbr = (float*)(ws + WS_TAB + TB_BBR); C.bbi = (float*)(ws + WS_TAB + TB_BBI);
    C.ssr = (float*)(ws + WS_TAB + TB_SSR); C.ssi = (float*)(ws + WS_TAB + TB_SSI); C.lra = (float*)(ws + WS_TAB + TB_LRA); C.lre = (float*)(ws + WS_TAB + TB_LRE);
    C.Win = (bf16*)(ws + WS_WIN); C.Wpa = (bf16*)(ws + WS_WPA); C.Wglu = (bf16*)(ws + WS_WGLU); C.Wout = (bf16*)(ws + WS_WOUT); C.Wup = (bf16*)(ws + WS_WUP); C.Wdn = (bf16*)(ws + WS_WDN);
    C.A = (bf16*)(ws + WS_A); C.P = (bf16*)(ws + WS_PROJ); C.HS = (bf16*)(ws + WS_HSEQ); C.GY = (bf16*)(ws + WS_GY); C.T = (bf16*)(ws + WS_T); C.UC = (bf16*)(ws + WS_UCONV); C.ACT = (bf16*)(ws + WS_ACT);

#if MK_ONE_LAUNCH
    for (int u = C.tid; u < (LDS_BYTES - LDSCTL_OFF) / 4; u += NWAVES * 64) ((LAS unsigned*)(C.lds + LDSCTL_OFF))[u] = 0u;
    __syncthreads();
    XcdBarrier bar = xcd_barrier_post((unsigned*)(ws + WS_CTL) + CW_BAR, (volatile LAS unsigned*)(C.lds + MISC_OFF) + 8);
#define GRID_BAR() xcd_barrier(bar)
#else
#define GRID_BAR() do {} while (0)
#endif
    const int lo = args.ph_lo, hi = args.ph_hi;
#define IN(k) (lo <= (k) && (k) < hi)
#ifdef MK_PROBE
#define STAMP(k) do { if (blockIdx.x == 0 && C.tid == 0) { *(volatile LAS unsigned long long*)(C.lds + LDSCTL_OFF + 512 + 8 * ((k) + 1)) = __builtin_amdgcn_s_memrealtime(); } } while (0)
#else
#define STAMP(k) do {} while (0)
#endif
#define SEAM(k) do { if (IN(k) && IN((k) + 1)) GRID_BAR(); STAMP(k); } while (0)
    LAS unsigned char* wl = C.lds + C.wave * 16384;

    STAMP(-1);
    if (IN(PH_P0)) { p0_phase(C); } SEAM(PH_P0);
    if (IN(PH_MOD)) { mod_phase(C); } SEAM(PH_MOD);
    if (IN(PH_H1)) { norm_mod_phase(C, C.xp, C.xs, C.g1, 0, 2048, C.A); } SEAM(PH_H1);
    if (IN(PH_G1)) {
        pg8::Gemm g{C.A, C.Win, MP, NPROJ, D_MODEL}; pg8::StaticOrder S; S.init(MP, NPROJ, C.G, (int)blockIdx.x);
        pg8::EpiProj E{C.P};
        pg8::gemm_phase<pg8::EpiProj, pg8::StaticOrder, PG8_ALIGN, PG8_SP2>(C.lds, g, S, E);
        skinny_gemm<2, 2, 4>(C, C.A + (size_t)MP * D_MODEL, C.Win, D_MODEL, NPROJ / 32, SEpiProj{C.P});
    } SEAM(PH_G1);
    if (IN(PH_SA)) {
        for (int u = blockIdx.x; u < 256; u += C.G) s5_block<false>(C, u & 7, u >> 3);
        for (int u = blockIdx.x; u < 256; u += C.G) lru_block<false>(C, u);
        for (int u = (int)blockIdx.x - (C.G - 16); u >= 0 && u < 16; u += C.G) lru_sample_block(C, u);
        for (int u = C.gw; u < NGRP * 4; u += C.NGW) s5_sample_wave(C, u & 63, u >> 6, (LAS bf16*)(C.lds + TILE256 + C.wave * 8704));
        new_conv_prompt(C);
    } SEAM(PH_SA);
    if (IN(PH_SB)) {
        for (int u = blockIdx.x; u < 256; u += C.G) s5_block<true>(C, u & 7, u >> 3);
        for (int u = blockIdx.x; u < 256; u += C.G) lru_block<true>(C, u);
    } SEAM(PH_SB);
    if (IN(PH_G3)) {
        pg8::Gemm g{C.HS, C.Wpa, MP, D_MODEL, W_LRU}; pg8::StaticOrder S; S.init(MP, D_MODEL, C.G, (int)blockIdx.x);
        pg8::EpiGateA E{C.T, C.P};
        pg8::gemm_phase<pg8::EpiGateA, pg8::StaticOrder, PG8_ALIGN, PG8_SP2>(C.lds, g, S, E);
        skinny_gemm<2, 2, 4>(C, C.HS + (size_t)MP * W_LRU, C.Wpa, W_LRU, D_MODEL / 32, SEpiGateA{C.T, C.P});
    } SEAM(PH_G3);
    if (IN(PH_G4)) {
        pg8::Gemm g{C.GY, C.Wglu, MP, 2 * D_MODEL, W_SSM}; pg8::StaticOrder S; S.init(MP, 2 * D_MODEL, C.G, (int)blockIdx.x);
        pg8::EpiGlu E{C.A, C.T, C.P};
        pg8::gemm_phase<pg8::EpiGlu, pg8::StaticOrder, PG8_ALIGN, PG8_SP2>(C.lds, g, S, E);
        skinny_gemm<2, 2, 4>(C, C.GY + (size_t)MP * W_SSM, C.Wglu, W_SSM, D_MODEL / 16, SEpiGlu{C.A, C.T, C.P});
    } SEAM(PH_G4);
    if (IN(PH_G5)) {
        pg8::Gemm g{C.A, C.Wout, MP, D_MODEL, D_MODEL}; pg8::StaticOrder S; S.init(MP, D_MODEL, C.G, (int)blockIdx.x);
        pg8::EpiRes E{C.xp, C.xs, C.out, C.modt, 2 * D_MODEL};
        pg8::gemm_phase<pg8::EpiRes, pg8::StaticOrder, PG8_ALIGN, PG8_SP2>(C.lds, g, S, E);
        skinny_gemm<2, 2, 4>(C, C.A + (size_t)MP * D_MODEL, C.Wout, D_MODEL, D_MODEL / 32, SEpiRes{C.xs, C.out + (size_t)MP * D_MODEL, C.modt, 2 * D_MODEL});
    } SEAM(PH_G5);
    if (IN(PH_H2)) { norm_mod_phase(C, C.out, C.out + (size_t)MP * D_MODEL, C.g2, 3 * D_MODEL, 4 * D_MODEL, C.A); } SEAM(PH_H2);
    if (IN(PH_G6)) {
        pg8::Gemm g{C.A, C.Wup, MP, D_FF, D_MODEL}; pg8::StaticOrder S; S.init(MP, D_FF, C.G, (int)blockIdx.x);
        pg8::EpiRelu2 E{C.ACT};
        pg8::gemm_phase<pg8::EpiRelu2, pg8::StaticOrder, PG8_ALIGN, PG8_SP2>(C.lds, g, S, E);
        skinny_gemm<8, 2, 2>(C, C.A + (size_t)MP * D_MODEL, C.Wup, D_MODEL, D_FF / 32, SEpiRelu2{C.ACT});
    } SEAM(PH_G6);
    if (IN(PH_G7)) {
        pg8::Gemm g{C.ACT, C.Wdn, MP, D_MODEL, D_FF}; pg8::StaticOrder S; S.init(MP, D_MODEL, C.G, (int)blockIdx.x);
        pg8::EpiRes E{C.out, C.out + (size_t)MP * D_MODEL, C.out, C.modt, 5 * D_MODEL};
        pg8::gemm_phase<pg8::EpiRes, pg8::StaticOrder, PG8_ALIGN, PG8_SP2>(C.lds, g, S, E);
        skinny_gemm<2, 2, 4>(C, C.ACT + (size_t)MP * D_FF, C.Wdn, D_FF, D_MODEL / 32, SEpiRes{C.out + (size_t)MP * D_MODEL, C.out + (size_t)MP * D_MODEL, C.modt, 5 * D_MODEL});
    } SEAM(PH_G7);
    if (IN(PH_FIN)) { final_norm_phase(C); }
#ifdef MK_PROBE
    STAMP(PH_FIN);
    if (blockIdx.x == 0 && C.tid == 0) {
        volatile LAS unsigned long long* ts = (volatile LAS unsigned long long*)(C.lds + LDSCTL_OFF + 512);
        const unsigned long long delay = (ts[MK_PROBE_A_HI + 1] - ts[MK_PROBE_A_LO]) * (unsigned long long)MK_PROBE_MUL;
        const unsigned long long t0 = __builtin_amdgcn_s_memrealtime();
        while (__builtin_amdgcn_s_memrealtime() - t0 < delay) __builtin_amdgcn_s_sleep(8);
    }
#endif
#undef IN
#undef SEAM
}

extern "C" void kernel_launch(void* const* d_in, const int* in_sizes, int n_in, void* d_out, int out_size, void* d_ws, size_t ws_size, hipStream_t stream) {
    static int grid = 0;
    if (grid == 0) {
        if (n_in != 34 || in_sizes[0] != MP * D_MODEL || (size_t)out_size != O_END || ws_size < WS_END) {
            fprintf(stderr, "kernel_launch: built for 34 inputs, out %zu floats, >= %zu bytes of workspace; got n_in %d, in0 %d, out %d, ws %zu; nothing launched\n", (size_t)O_END, (size_t)WS_END, n_in, n_in > 0 ? in_sizes[0] : -1, out_size, ws_size); grid = -1; return; }
        int dev = 0, cus = 0, per_cu = 0;
        if (hipGetDevice(&dev) != hipSuccess || hipDeviceGetAttribute(&cus, hipDeviceAttributeMultiprocessorCount, dev) != hipSuccess) { fprintf(stderr, "kernel_launch: device query failed\n"); grid = -1; return; }
        if (hipFuncSetAttribute((const void*)hybrid_fwd, hipFuncAttributeMaxDynamicSharedMemorySize, LDS_BYTES) != hipSuccess) { fprintf(stderr, "kernel_launch: hipFuncSetAttribute failed\n"); grid = -1; return; }
        if (hipOccupancyMaxActiveBlocksPerMultiprocessor(&per_cu, (const void*)hybrid_fwd, NWAVES * 64, LDS_BYTES) != hipSuccess || per_cu < 1) { fprintf(stderr, "kernel_launch: occupancy query says %d workgroups per CU\n", per_cu); per_cu = 1; }
        (void)hipGetLastError();
        grid = cus;
    }
    if (grid < 0) return;
    if (hipMemsetAsync((char*)d_ws + WS_CTL, 0, CTL_ZERO_BYTES, stream) != hipSuccess) { fprintf(stderr, "kernel_launch: memset failed\n"); return; }
    Args a{};
    for (int i = 0; i < 34; ++i) a.in[i] = d_in[i];
    a.out = (float*)d_out; a.ws = (unsigned char*)d_ws;
#if MK_ONE_LAUNCH
    a.ph_lo = 0; a.ph_hi = N_PHASES;
    hipLaunchKernelGGL(hybrid_fwd, dim3(grid), dim3(NWAVES * 64), LDS_BYTES, stream, a);
#else
    for (int p = 0; p < N_PHASES; ++p) { a.ph_lo = p; a.ph_hi = p + 1; hipLaunchKernelGGL(hybrid_fwd, dim3(grid), dim3(NWAVES * 64), LDS_BYTES, stream, a); }
#endif
    const hipError_t le = hipPeekAtLastError();
    if (le != hipSuccess) fprintf(stderr, "kernel_launch: launch failed: %s\n", hipGetErrorName(le));
}
```

```cpp
#include <hip/hip_runtime.h>
#include <cstdio>
#include <cstdint>
namespace pg8 {
#define PG8_LAS __attribute__((address_space(3)))
typedef unsigned short bf16_t;
typedef short bf16x8 __attribute__((ext_vector_type(8)));
typedef float f32x4 __attribute__((ext_vector_type(4)));
typedef unsigned u32x4 __attribute__((ext_vector_type(4)));
constexpr int BM = 256, BK = 64, HALF = 128, HTB = HALF * BK * 2  , STAGE_BYTES = 8 * HTB, NXCD = 8, WGM = 8;

__host__ __device__ __forceinline__ int lds_byte(int r, int c) { const int st = (r >> 4) * 2 + (c >> 5), rr = r & 15, cc = c & 31, ob = rr * 64 + cc * 2; return st * 1024 + (ob ^ (((ob >> 9) & 1) << 5)); }
__host__ __device__ __forceinline__ void stage_rc(int b, int& R, int& C) { const int st = b / 1024, sb = b % 1024, swz = sb ^ (((sb >> 9) & 1) << 5); R = (st >> 1) * 16 + swz / 64; C = (st & 1) * 32 + (swz % 64) / 2; }
__host__ __device__ __forceinline__ int perm32(int rho) { const int n = rho >> 4, i = rho & 15; return 8 * (i >> 2) + 4 * n + (i & 3); }

struct Unit { int pm, pn; };
struct Gemm { const bf16_t* A; const bf16_t* Bt; int M, N, K; };

struct StaticOrder {
    int nM, nN, nwg, G, c;
    __host__ __device__ void init(int M, int N, int G_, int c_) { nM = M / BM; nN = N / BM; nwg = nM * nN; G = G_; c = c_; }
    __host__ __device__ bool next(int i, Unit& u) const {
        const long L = (long)i * G + c; if (L >= nwg) return false;
        int wgid = (int)L; { const int q = nwg / NXCD, r = nwg % NXCD, xcd = wgid % NXCD, off = wgid / NXCD; wgid = (xcd < r ? xcd * (q + 1) : r * (q + 1) + (xcd - r) * q) + off; }
        const int nig = WGM * nN, gid = wgid / nig, fm = gid * WGM, gsz = (nM - fm) < WGM ? (nM - fm) : WGM;
        u.pm = fm + ((wgid % nig) % gsz); u.pn = (wgid % nig) / gsz; return true;
    }
    __device__ __forceinline__ void a_ready(const Unit&) const {}
    __device__ __forceinline__ void done(const Unit&) const {}
};

__device__ __forceinline__ unsigned cvt_pk_bf16(float lo, float hi) { unsigned r; asm volatile("v_cvt_pk_bf16_f32 %0, %1, %2" : "=v"(r) : "v"(lo), "v"(hi)); return r; }
constexpr int D_MODEL = 2048, MP = 8192  , MS = 128  , MR = MP + MS  , MODN = 6 * D_MODEL, NPROJ = 6144, D_FF = 8192;
__device__ __forceinline__ float bflo(unsigned w) { return __uint_as_float(w << 16); }
__device__ __forceinline__ float bfhi(unsigned w) { return __uint_as_float(w & 0xffff0000u); }
__device__ __forceinline__ float sigm(float x) { return __builtin_amdgcn_rcpf(1.0f + __builtin_amdgcn_exp2f(-1.44269504f * x)); }
__device__ __forceinline__ int mod_row(int row) { int r = row < MP ? (row >> 11) : (4 + row - MP); return r > 143 ? 143 : r; }

struct EpiProj {
    static constexpr bool PERM = true, AFTER_DRAIN = false;
    bf16_t* O;
    __device__ __forceinline__ void operator()(const f32x4 (&acc)[2][2][4][2], const Unit& u, int wr, int wc, int fr, int fq) const {
        const int row0 = u.pm * BM + wr * 64 + fr, col0 = u.pn * BM + wc * 32 + 8 * fq; const bool sg = u.pn >= 8;
#pragma unroll
        for (int ai = 0; ai < 2; ++ai)
#pragma unroll
            for (int m = 0; m < 4; ++m) { bf16_t* rowp = O + (size_t)(row0 + ai * HALF + m * 16) * NPROJ + col0;
#pragma unroll
                for (int bj = 0; bj < 2; ++bj) { f32x4 v0 = acc[ai][bj][m][0], v1 = acc[ai][bj][m][1];
                    if (sg) {
#pragma unroll
                        for (int i = 0; i < 4; ++i) { v0[i] = sigm(v0[i]); v1[i] = sigm(v1[i]); } }
                    u32x4 w; w.x = cvt_pk_bf16(v0[0], v0[1]); w.y = cvt_pk_bf16(v0[2], v0[3]); w.z = cvt_pk_bf16(v1[0], v1[1]); w.w = cvt_pk_bf16(v1[2], v1[3]);
                    *(u32x4*)(rowp + bj * HALF) = w; } }
    }
};
struct EpiGateA {
    static constexpr bool PERM = true, AFTER_DRAIN = false;
    bf16_t* T; const bf16_t* P;
    __device__ __forceinline__ void operator()(const f32x4 (&acc)[2][2][4][2], const Unit& u, int wr, int wc, int fr, int fq) const {
        const int row0 = u.pm * BM + wr * 64 + fr, col0 = u.pn * BM + wc * 32 + 8 * fq;
#pragma unroll
        for (int ai = 0; ai < 2; ++ai)
#pragma unroll
            for (int m = 0; m < 4; ++m) { const size_t row = (size_t)(row0 + ai * HALF + m * 16);
#pragma unroll
                for (int bj = 0; bj < 2; ++bj) { const int col = col0 + bj * HALF;
                    const u32x4 g = *(const u32x4*)(P + row * NPROJ + 2048 + col);
                    f32x4 v0 = acc[ai][bj][m][0], v1 = acc[ai][bj][m][1];
                    v0[0] *= bflo(g.x); v0[1] *= bfhi(g.x); v0[2] *= bflo(g.y); v0[3] *= bfhi(g.y); v1[0] *= bflo(g.z); v1[1] *= bfhi(g.z); v1[2] *= bflo(g.w); v1[3] *= bfhi(g.w);
                    u32x4 w; w.x = cvt_pk_bf16(v0[0], v0[1]); w.y = cvt_pk_bf16(v0[2], v0[3]); w.z = cvt_pk_bf16(v1[0], v1[1]); w.w = cvt_pk_bf16(v1[2], v1[3]);
                    *(u32x4*)(T + row * D_MODEL + col) = w; } }
    }
};
struct EpiGlu {
    static constexpr bool PERM = true, AFTER_DRAIN = false;
    bf16_t* MG; const bf16_t* T; const bf16_t* P;
    __device__ __forceinline__ void operator()(const f32x4 (&acc)[2][2][4][2], const Unit& u, int wr, int wc, int fr, int fq) const {
        const int row0 = u.pm * BM + wr * 64 + fr, vcol = u.pn * HALF + wc * 32 + 8 * fq;
#pragma unroll
        for (int ai = 0; ai < 2; ++ai)
#pragma unroll
            for (int m = 0; m < 4; ++m) { const size_t row = (size_t)(row0 + ai * HALF + m * 16);
                const u32x4 t = *(const u32x4*)(T + row * D_MODEL + vcol);
                const u32x4 z = *(const u32x4*)(P + row * NPROJ + 4096 + vcol);
                const f32x4 a0 = acc[ai][0][m][0], a1 = acc[ai][0][m][1], g0 = acc[ai][1][m][0], g1 = acc[ai][1][m][1];
                float o[8];
                o[0] = bflo(t.x) + bflo(z.x) * (a0[0] * sigm(g0[0])); o[1] = bfhi(t.x) + bfhi(z.x) * (a0[1] * sigm(g0[1]));
                o[2] = bflo(t.y) + bflo(z.y) * (a0[2] * sigm(g0[2])); o[3] = bfhi(t.y) + bfhi(z.y) * (a0[3] * sigm(g0[3]));
                o[4] = bflo(t.z) + bflo(z.z) * (a1[0] * sigm(g1[0])); o[5] = bfhi(t.z) + bfhi(z.z) * (a1[1] * sigm(g1[1]));
                o[6] = bflo(t.w) + bflo(z.w) * (a1[2] * sigm(g1[2])); o[7] = bfhi(t.w) + bfhi(z.w) * (a1[3] * sigm(g1[3]));
                u32x4 w; w.x = cvt_pk_bf16(o[0], o[1]); w.y = cvt_pk_bf16(o[2], o[3]); w.z = cvt_pk_bf16(o[4], o[5]); w.w = cvt_pk_bf16(o[6], o[7]);
                *(u32x4*)(MG + row * D_MODEL + vcol) = w; }
    }
};
struct EpiRes {
    static constexpr bool PERM = false, AFTER_DRAIN = false;
    const float* xp; const float* xs; float* out; const float* modt; int goff;
    __device__ __forceinline__ void operator()(const f32x4 (&acc)[2][2][4][2], const Unit& u, int wr, int wc, int fr, int fq) const {
        const int row0 = u.pm * BM + wr * 64 + fr, col0 = u.pn * BM + wc * 32 + 4 * fq;
#pragma unroll
        for (int ai = 0; ai < 2; ++ai)
#pragma unroll
            for (int m = 0; m < 4; ++m) { const int row = row0 + ai * HALF + m * 16;
                if (row < MR) {
                    const float* xr = row < MP ? xp + (size_t)row * D_MODEL : xs + (size_t)(row - MP) * D_MODEL;
                    const float* gr = modt + (size_t)mod_row(row) * MODN + goff;
                    float* orow = out + (size_t)row * D_MODEL;
#pragma unroll
                    for (int bj = 0; bj < 2; ++bj)
#pragma unroll
                        for (int n = 0; n < 2; ++n) { const int col = col0 + bj * HALF + n * 16;
                            const f32x4 g = *(const f32x4*)(gr + col); const f32x4 xv = *(const f32x4*)(xr + col);
                            *(f32x4*)(orow + col) = xv + g * acc[ai][bj][m][n]; } } }
    }
};
struct EpiRelu2 {
    static constexpr bool PERM = true, AFTER_DRAIN = false;
    bf16_t* O;
    __device__ __forceinline__ void operator()(const f32x4 (&acc)[2][2][4][2], const Unit& u, int wr, int wc, int fr, int fq) const {
        const int row0 = u.pm * BM + wr * 64 + fr, col0 = u.pn * BM + wc * 32 + 8 * fq;
#pragma unroll
        for (int ai = 0; ai < 2; ++ai)
#pragma unroll
            for (int m = 0; m < 4; ++m) { bf16_t* rowp = O + (size_t)(row0 + ai * HALF + m * 16) * D_FF + col0;
#pragma unroll
                for (int bj = 0; bj < 2; ++bj) { f32x4 v0 = acc[ai][bj][m][0], v1 = acc[ai][bj][m][1];
#pragma unroll
                    for (int i = 0; i < 4; ++i) { const float a = fmaxf(v0[i], 0.f), b = fmaxf(v1[i], 0.f); v0[i] = a * a; v1[i] = b * b; }
                    u32x4 w; w.x = cvt_pk_bf16(v0[0], v0[1]); w.y = cvt_pk_bf16(v0[2], v0[3]); w.z = cvt_pk_bf16(v1[0], v1[1]); w.w = cvt_pk_bf16(v1[2], v1[3]);
                    *(u32x4*)(rowp + bj * HALF) = w; } }
    }
};

#ifdef MK_PROBE
#define PG8_PSTAMP(slot) do { if (blockIdx.x == 0 && threadIdx.x == 0) *(volatile PG8_LAS unsigned long long*)(lds + 146432 + 512 + 8 * (slot)) = __builtin_amdgcn_s_memrealtime(); } while (0)
#else
#define PG8_PSTAMP(slot) do {} while (0)
#endif
template <class Epi, class Sched, bool ALIGN_EPI = false, bool SP2 = false>
__device__ __forceinline__ void gemm_phase(PG8_LAS unsigned char* lds, const Gemm g, const Sched& S, const Epi& E) {
    const int tid = threadIdx.x, wid = __builtin_amdgcn_readfirstlane(tid >> 6), lane = tid & 63, wr = wid >> 2, wc = wid & 3, fr = lane & 15, fq = lane >> 4;
    const int K = g.K, nt = K / BK;
    unsigned voffA[2], voffB[2];
#pragma unroll
    for (int i = 0; i < 2; ++i) { int R, C; stage_rc(tid * 16 + i * 8192, R, C); const int Rb = Epi::PERM ? ((R & ~31) + perm32(R & 31)) : R;
        voffA[i] = (unsigned)(R * K + C) * 2u; voffB[i] = (unsigned)(Rb * K + C) * 2u; }
    const size_t kstep = (size_t)(BK * 2);
    const size_t hstep = (size_t)HALF * K * 2;
    const size_t tstep = 2 * hstep;
    const unsigned ldsw = (unsigned)wid * 1024u;
    const int aoff = lds_byte(wr * 64 + fr, fq * 8), boff = lds_byte(wc * 32 + fr, fq * 8);
#define PG8_SA(b, h) (((b) * 2 + (h)) * HTB)
#define PG8_SB(b, h) ((4 + (b) * 2 + (h)) * HTB)
#define PG8_STAGE(bufoff, gbase, voff) do { _Pragma("unroll") for (int _i = 0; _i < 2; ++_i) \
        __builtin_amdgcn_global_load_lds((const unsigned*)((const char*)(gbase) + (voff)[_i]), (PG8_LAS unsigned*)(lds + (bufoff) + ldsw + _i * 8192), 16, 0, 0); } while (0)
#define PG8_LDA(dst, b, h) do { _Pragma("unroll") for (int m = 0; m < 4; ++m) _Pragma("unroll") for (int k = 0; k < 2; ++k) dst[m][k] = *(const PG8_LAS bf16x8*)(lds + PG8_SA(b, h) + aoff + m * 2048 + k * 1024); } while (0)
#define PG8_LDB(dst, b, h) do { _Pragma("unroll") for (int n = 0; n < 2; ++n) _Pragma("unroll") for (int k = 0; k < 2; ++k) dst[n][k] = *(const PG8_LAS bf16x8*)(lds + PG8_SB(b, h) + boff + n * 2048 + k * 1024); } while (0)
#define PG8_MMA(ai, bj, At, Bt) do { __builtin_amdgcn_s_setprio(1); _Pragma("unroll") for (int m = 0; m < 4; ++m) _Pragma("unroll") for (int n = 0; n < 2; ++n) _Pragma("unroll") for (int k = 0; k < 2; ++k) \
        acc[ai][bj][m][n] = __builtin_amdgcn_mfma_f32_16x16x32_bf16(Bt[n][k], At[m][k], acc[ai][bj][m][n], 0, 0, 0); __builtin_amdgcn_s_setprio(0); } while (0)
#define PG8_WAIT_V(n) asm volatile("s_waitcnt vmcnt(" #n ")" ::: "memory")
#define PG8_WAIT_L(n) asm volatile("s_waitcnt lgkmcnt(" #n ")" ::: "memory")
#define PG8_BAR __builtin_amdgcn_s_barrier()
#define PG8_SCHED __builtin_amdgcn_sched_barrier(0)
    Unit cur, nxt; int ui = 0;
    if (!S.next(0, cur)) return;
    f32x4 acc[2][2][4][2];
#pragma unroll
    for (int a = 0; a < 2; ++a)
#pragma unroll
        for (int b = 0; b < 2; ++b)
#pragma unroll
            for (int m = 0; m < 4; ++m)
#pragma unroll
                for (int n = 0; n < 2; ++n) acc[a][b][m][n] = (f32x4){0.f, 0.f, 0.f, 0.f};
    bf16x8 At[4][2], B0[2][2], B1[2][2];
    const char* cA = (const char*)g.A + (size_t)cur.pm * tstep; const char* cB = (const char*)g.Bt + (size_t)cur.pn * tstep;
    S.a_ready(cur);
    if constexpr (SP2) {
        PG8_STAGE(PG8_SB(0, 0), cB, voffB); PG8_STAGE(PG8_SB(0, 1), cB + hstep, voffB); PG8_STAGE(PG8_SA(0, 0), cA, voffA); PG8_STAGE(PG8_SA(0, 1), cA + hstep, voffA);
        if (wr == 1) PG8_BAR;
        PG8_WAIT_V(2); PG8_BAR;
        PG8_STAGE(PG8_SB(1, 0), cB + kstep, voffB); PG8_STAGE(PG8_SA(1, 0), cA + kstep, voffA); PG8_STAGE(PG8_SB(1, 1), cB + hstep + kstep, voffB);
        PG8_WAIT_V(6); PG8_BAR;
    } else {
        PG8_STAGE(PG8_SB(0, 0), cB, voffB); PG8_STAGE(PG8_SA(0, 0), cA, voffA); PG8_STAGE(PG8_SB(0, 1), cB + hstep, voffB); PG8_STAGE(PG8_SA(0, 1), cA + hstep, voffA);
        if (wr == 1) PG8_BAR;
        PG8_WAIT_V(4); PG8_BAR;
        PG8_STAGE(PG8_SB(1, 0), cB + kstep, voffB); PG8_STAGE(PG8_SA(1, 0), cA + kstep, voffA); PG8_STAGE(PG8_SB(1, 1), cB + hstep + kstep, voffB);
        PG8_WAIT_V(6); PG8_BAR;
    }
    for (;;) {
        const bool has_next = S.next(ui + 1, nxt);
        const char* nA = has_next ? (const char*)g.A + (size_t)nxt.pm * tstep : cA; const char* nB = has_next ? (const char*)g.Bt + (size_t)nxt.pn * tstep : cB;
        for (int t = 0; t < nt; t += 2) {
            const bool last = (t == nt - 2);
            const char* a1 = cA + (size_t)(t + 1) * kstep;
            const char* a2 = last ? nA : cA + (size_t)(t + 2) * kstep; const char* b2 = last ? nB : cB + (size_t)(t + 2) * kstep;
            const char* a3 = a2 + kstep; const char* b3 = b2 + kstep;
            if (last && has_next) S.a_ready(nxt);
            if constexpr (SP2) {
            PG8_LDB(B0, 0, 0); PG8_LDB(B1, 0, 1); PG8_SCHED; PG8_LDA(At, 0, 0); PG8_STAGE(PG8_SA(1, 1), a1 + hstep, voffA);
            PG8_WAIT_V(8); PG8_WAIT_L(0); PG8_BAR; PG8_MMA(0, 0, At, B0); PG8_MMA(0, 1, At, B1); PG8_BAR; PG8_SCHED;
            PG8_LDA(At, 0, 1); PG8_STAGE(PG8_SB(0, 0), b2, voffB); PG8_STAGE(PG8_SB(0, 1), b2 + hstep, voffB); PG8_STAGE(PG8_SA(0, 0), a2, voffA);
            PG8_WAIT_V(8); PG8_WAIT_L(0); PG8_BAR; PG8_MMA(1, 0, At, B0); PG8_MMA(1, 1, At, B1); PG8_BAR; PG8_SCHED;
            PG8_LDB(B0, 1, 0); PG8_LDB(B1, 1, 1); PG8_SCHED; PG8_LDA(At, 1, 0); PG8_STAGE(PG8_SA(0, 1), a2 + hstep, voffA);
            PG8_WAIT_V(8); PG8_WAIT_L(0); PG8_BAR; PG8_MMA(0, 0, At, B0); PG8_MMA(0, 1, At, B1); PG8_BAR; PG8_SCHED;
            PG8_LDA(At, 1, 1); PG8_STAGE(PG8_SB(1, 0), b3, voffB); PG8_STAGE(PG8_SB(1, 1), b3 + hstep, voffB); PG8_STAGE(PG8_SA(1, 0), a3, voffA);
            PG8_WAIT_V(8); PG8_WAIT_L(0); PG8_BAR; PG8_MMA(1, 0, At, B0); PG8_MMA(1, 1, At, B1); PG8_BAR; PG8_SCHED;
            } else {
            PG8_LDB(B0, 0, 0); PG8_SCHED; PG8_LDA(At, 0, 0); PG8_STAGE(PG8_SA(1, 1), a1 + hstep, voffA);
            PG8_WAIT_L(8); PG8_BAR; PG8_WAIT_L(0); PG8_MMA(0, 0, At, B0); PG8_BAR; PG8_SCHED;
            PG8_LDB(B1, 0, 1); PG8_STAGE(PG8_SB(0, 0), b2, voffB);
            PG8_BAR; PG8_WAIT_L(0); PG8_MMA(0, 1, At, B1); PG8_BAR;
            PG8_LDA(At, 0, 1); PG8_STAGE(PG8_SA(0, 0), a2, voffA);
            PG8_BAR; PG8_WAIT_L(0); PG8_MMA(1, 0, At, B0); PG8_BAR; PG8_SCHED;
            PG8_STAGE(PG8_SB(0, 1), b2 + hstep, voffB);
            PG8_WAIT_V(6); PG8_BAR; PG8_MMA(1, 1, At, B1); PG8_BAR;
            PG8_LDB(B0, 1, 0); PG8_SCHED; PG8_LDA(At, 1, 0); PG8_STAGE(PG8_SA(0, 1), a2 + hstep, voffA);
            PG8_WAIT_L(8); PG8_BAR; PG8_WAIT_L(0); PG8_MMA(0, 0, At, B0); PG8_BAR; PG8_SCHED;
            PG8_LDB(B1, 1, 1); PG8_STAGE(PG8_SB(1, 0), b3, voffB);
            PG8_BAR; PG8_WAIT_L(0); PG8_MMA(0, 1, At, B1); PG8_BAR;
            PG8_LDA(At, 1, 1); PG8_STAGE(PG8_SA(1, 0), a3, voffA);
            PG8_BAR; PG8_WAIT_L(0); PG8_MMA(1, 0, At, B0); PG8_BAR; PG8_SCHED;
            PG8_STAGE(PG8_SB(1, 1), b3 + hstep, voffB);
            PG8_WAIT_V(6); PG8_BAR; PG8_MMA(1, 1, At, B1); PG8_BAR;
            }
        }
        if constexpr (ALIGN_EPI) { if (wr == 0) PG8_BAR; }
        PG8_PSTAMP(41);
        if constexpr (!Epi::AFTER_DRAIN) { E(acc, cur, wr, wc, fr, fq); S.done(cur); }
        PG8_PSTAMP(42);
        if (!has_next) break;
#pragma unroll
        for (int a = 0; a < 2; ++a)
#pragma unroll
            for (int b = 0; b < 2; ++b)
#pragma unroll
                for (int m = 0; m < 4; ++m)
#pragma unroll
                    for (int n = 0; n < 2; ++n) acc[a][b][m][n] = (f32x4){0.f, 0.f, 0.f, 0.f};
        cur = nxt; cA = nA; cB = nB; ++ui;
        if constexpr (ALIGN_EPI) { if (wr == 1) PG8_BAR; }
    }
    PG8_WAIT_V(0);
    if constexpr (!ALIGN_EPI) { if (wr == 0) PG8_BAR; }
    PG8_BAR;
    if constexpr (Epi::AFTER_DRAIN) { E.fused(acc, cur, wr, wc, fr, fq, lds, wid, lane); S.done(cur); }
#undef PG8_SA
#undef PG8_SB
#undef PG8_STAGE
#undef PG8_LDA
#undef PG8_LDB
#undef PG8_MMA
#undef PG8_WAIT_V
#undef PG8_WAIT_L
#undef PG8_BAR
#undef PG8_SCHED
}
}
#ifndef PG8_SP2
#define PG8_SP2 true
#endif
#ifndef PG8_ALIGN
#define PG8_ALIGN true
#endif
#ifndef MK_ONE_LAUNCH
#define MK_ONE_LAUNCH 1
#endif

using pg8::D_MODEL; using pg8::MP; using pg8::MS; using pg8::MR; using pg8::MODN; using pg8::NPROJ; using pg8::D_FF;
constexpr int MPAD = 8448;
constexpr int SEQ = 2048, NB = 4, W_LRU = 1024, W_SSM = 1024, NHEAD = 8, HDIM = 128, NGRP = 64, NST = 64, GSZ = 16;
constexpr int S5_TC = 128, S5_NCH = SEQ / S5_TC;
constexpr int LR_TC = 64,  LR_NCH = SEQ / LR_TC;
constexpr float EPS = 1e-6f;
constexpr size_t O_YP = 0, O_YS = 16777216, O_CP = 17039360, O_LP = 17051648, O_RP = 17055744, O_IP = 17072128, O_CS = 17088512, O_LS = 17481728, O_RS = 17612800, O_IS = 18137088, O_END = 18661376;

constexpr size_t MiB = 1u << 20;
constexpr size_t WS_CTL = 0, CTL_ZERO_BYTES = 1 * MiB;
constexpr size_t WS_MOD = 1 * MiB;
constexpr size_t WS_TAB = 8 * MiB;
constexpr size_t TB_SILU = 0;
constexpr size_t TB_ABR = 1 * MiB, TB_ABI = TB_ABR + 16384;
constexpr size_t TB_BBR = TB_ABI + 16384, TB_BBI = TB_BBR + 262144;
constexpr size_t TB_SSR = 2 * MiB, TB_SSI = 3 * MiB;
constexpr size_t TB_LRA = 4 * MiB, TB_LRE = 4 * MiB + 524288;
constexpr size_t WS_WIN = 16 * MiB, WS_WPA = 40 * MiB, WS_WGLU = 44 * MiB, WS_WOUT = 52 * MiB, WS_WUP = 60 * MiB, WS_WDN = 92 * MiB;
constexpr size_t WS_A = 124 * MiB;
constexpr size_t WS_PROJ = 157 * MiB;
constexpr size_t WS_HSEQ = 256 * MiB, WS_GY = 273 * MiB;
constexpr size_t WS_T = 290 * MiB, WS_UCONV = WS_T;
constexpr size_t WS_ACT = 157 * MiB;
constexpr size_t WS_END = 323 * MiB;
static_assert(WS_ACT + (size_t)MPAD * D_FF * 2 <= WS_T && WS_T + (size_t)MPAD * D_MODEL * 2 <= WS_END && WS_PROJ + (size_t)MPAD * NPROJ * 2 <= WS_HSEQ, "d_ws map");
constexpr int CW_BAR = 4096;

constexpr int RING_BYTES = 131072, LDS_BYTES = 147456, LDSCTL_OFF = LDS_BYTES - 1024, MISC_OFF = LDSCTL_OFF + 320;
constexpr int NWAVES = 8;

#define GAS __attribute__((address_space(1)))
#define LAS __attribute__((address_space(3)))
typedef unsigned short bf16;
typedef unsigned v4u __attribute__((ext_vector_type(4)));
typedef unsigned v2u __attribute__((ext_vector_type(2)));
typedef float f32x4 __attribute__((ext_vector_type(4)));
typedef float f32x16 __attribute__((ext_vector_type(16)));
typedef short bf16x8 __attribute__((ext_vector_type(8)));
typedef GAS unsigned gu32;
#define RLX_AGENT __ATOMIC_RELAXED, __HIP_MEMORY_SCOPE_AGENT
#define LDS_WAIT() asm volatile("s_waitcnt lgkmcnt(0)" ::: "memory")
#define VM_WAIT() asm volatile("s_waitcnt vmcnt(0)" ::: "memory")
__device__ __forceinline__ unsigned f2bf(float f) { unsigned u = __builtin_bit_cast(unsigned, f); return (u + 0x7fffu + ((u >> 16) & 1u)) >> 16; }
__device__ __forceinline__ unsigned pk2(float lo, float hi) { return pg8::cvt_pk_bf16(lo, hi); }
__device__ __forceinline__ float bf2f(bf16 v) { return __uint_as_float((unsigned)v << 16); }
using pg8::bflo; using pg8::bfhi; using pg8::sigm;
__device__ __forceinline__ bf16x8 pack8(f32x4 a, f32x4 b) { v4u w; w.x = pk2(a[0], a[1]); w.y = pk2(a[2], a[3]); w.z = pk2(b[0], b[1]); w.w = pk2(b[2], b[3]); return __builtin_bit_cast(bf16x8, w); }
__device__ __forceinline__ float gelu_tanh(float v) {
    const float z = 0.7978845608f * (v + 0.044715f * v * v * v);
    const float t = __builtin_amdgcn_exp2f(2.885390082f * z);
    return v - v * __builtin_amdgcn_rcpf(1.0f + t);
}
__device__ __forceinline__ float wave_sum(float v) {
#pragma unroll
    for (int o = 1; o < 64; o <<= 1) v += __shfl_xor(v, o);
    return v;
}

#if MK_ONE_LAUNCH
#define XB_TMO      128
#define XB_XCNT(j)  (256  + 64 * (j))
#define XB_XSUB(j)  (1280 + 64 * (j))
#define XB_XGEN(j)  (2304 + 64 * (j))
#define XB_TOP      3328
#define XB_TOPGEN   3392
#define XCD_BAR_WORDS 3456
#define XB_SPIN_CAP (1u << 18)

__device__ __forceinline__ unsigned xb_ld(unsigned* p)              { return __hip_atomic_load(p, __ATOMIC_RELAXED, __HIP_MEMORY_SCOPE_AGENT); }
__device__ __forceinline__ unsigned xb_add(unsigned* p, unsigned v) { return __hip_atomic_fetch_add(p, v, __ATOMIC_RELAXED, __HIP_MEMORY_SCOPE_AGENT); }
__device__ __forceinline__ unsigned xb_xcc_id() { return (unsigned)__builtin_amdgcn_s_getreg((3 << 11) | 20) & 0xFu; }
#define XB_SPIN(cond, bar) do { unsigned _sp = 0; while (cond) { __builtin_amdgcn_s_sleep(1); \
    if ((++_sp & 255u) == 0u) { if (xb_ld(&(bar)[XB_TMO])) break; if (_sp > XB_SPIN_CAP) { atomicAdd(&(bar)[XB_TMO], 1u); break; } } } } while (0)

struct XcdBarrier {
    unsigned* bar; unsigned x;
    volatile LAS unsigned* st;
};

__device__ __forceinline__ XcdBarrier xcd_barrier_post(unsigned* bar, volatile LAS unsigned* st) {
    XcdBarrier b; b.bar = bar; b.x = xb_xcc_id(); b.st = st;
    if (threadIdx.x == 0) (void)xb_add(&bar[XB_XCNT(b.x)], 1u);
    return b;
}
__device__ __forceinline__ void xcd_barrier_complete(unsigned* bar, unsigned x, unsigned& nloc, unsigned& nx) {
    const unsigned G = gridDim.x * gridDim.y * gridDim.z;
    unsigned sum, cnt, mine, sp = 0u;
    for (;;) {
        sum = 0u; cnt = 0u; mine = 0u;
#pragma unroll
        for (unsigned j = 0; j < 16; ++j) { const unsigned c = xb_ld(&bar[XB_XCNT(j)]); sum += c; cnt += (c > 0u) ? 1u : 0u; mine = (j == x) ? c : mine; }
        if (sum == G) break;
        __builtin_amdgcn_s_sleep(1);
        if ((++sp & 255u) == 0u) { if (xb_ld(&bar[XB_TMO])) break; if (sp > XB_SPIN_CAP) { atomicAdd(&bar[XB_TMO], 1u); break; } }
    }
    nloc = mine > 0u ? mine : 1u; nx = cnt > 0u ? cnt : 1u;
}

__device__ __forceinline__ void xcd_barrier(const XcdBarrier& b) {
    asm volatile("s_waitcnt vmcnt(0)" ::: "memory");
    __syncthreads();
    if (threadIdx.x == 0) {
        unsigned* bar = b.bar;
        __builtin_amdgcn_s_waitcnt(0);
        unsigned nloc = b.st[0], nx = b.st[1];
        if (nloc == 0u) { xcd_barrier_complete(bar, b.x, nloc, nx); b.st[0] = nloc; b.st[1] = nx; }
        const unsigned old = xb_add(&bar[XB_XSUB(b.x)], 1u);
        const unsigned gen = old / nloc;
        if (old + 1u == (gen + 1u) * nloc) {
            __builtin_amdgcn_fence(__ATOMIC_RELEASE, "agent");
            asm volatile("s_waitcnt vmcnt(0)" ::: "memory");
            const unsigned og = xb_add(&bar[XB_TOP], 1u);
            const unsigned tg = og / nx;
            if (og + 1u == (tg + 1u) * nx) xb_add(&bar[XB_TOPGEN], 1u);
            else XB_SPIN(xb_ld(&bar[XB_TOPGEN]) == tg, bar);
            __builtin_amdgcn_fence(__ATOMIC_ACQUIRE, "agent");
            xb_add(&bar[XB_XGEN(b.x)], 1u);
            asm volatile("s_waitcnt vmcnt(0)" ::: "memory");
        } else {
            XB_SPIN(xb_ld(&bar[XB_XGEN(b.x)]) == gen, bar);
            __builtin_amdgcn_fence(__ATOMIC_ACQUIRE, "agent");
            asm volatile("s_waitcnt vmcnt(0)" ::: "memory");
        }
    }
    __syncthreads();
}

#endif

#ifdef MK_PROBE
#define SSTAMP(k) do { if (blockIdx.x == 0 && C.tid == 0) { *(volatile LAS unsigned long long*)(C.lds + LDSCTL_OFF + 512 + 8 * ((k) + 1)) = __builtin_amdgcn_s_memrealtime(); } } while (0)
#define ISTAMP(k) do { if (APPLY && blockIdx.x == 0 && C.tid == 0) { *(volatile LAS unsigned long long*)(C.lds + LDSCTL_OFF + 512 + 8 * ((k) + 1)) = __builtin_amdgcn_s_memrealtime(); } } while (0)
#else
#define SSTAMP(k) do {} while (0)
#define ISTAMP(k) do {} while (0)
#endif
struct Args { const void* in[34]; float* out; unsigned char* ws; int ph_lo, ph_hi; };

struct Ctx {
    LAS unsigned char* lds; int tid, lane, wave, vcu, G, gw, NGW;
    const float *xp, *xs, *st_conv, *st_lru, *st_re, *st_im, *c_p, *c_s, *w_ada, *b_ada, *g1, *g2, *w_in, *conv_w, *conv_b, *w_rga, *b_rga, *w_rgx, *b_rgx, *lam, *w_pa;
    const float *a_re, *a_im, *log_dt, *b_re, *b_im, *c_re, *c_im, *ssm_d, *w_glu, *w_out, *w_up, *w_dn, *g_fin;
    float* out; unsigned char* ws;
    float* modt; bf16* silu; float *abr, *abi, *bbr, *bbi, *ssr, *ssi, *lra, *lre;
    bf16 *Win, *Wpa, *Wglu, *Wout, *Wup, *Wdn, *A, *P, *HS, *GY, *T, *UC, *ACT;
};

__device__ __forceinline__ void p0_transpose_item(const float* W, int K, int N, bf16* WT, int glu, LAS float* scr, int item, int lane) {
    const int nblk = N / 32, kb = item / nblk, nb = item % nblk, k0 = 64 * kb, n0 = 32 * nb;
#pragma unroll 8
    for (int i = 0; i < 32; ++i) { const int kk = 2 * i + (lane >> 5); scr[kk * 33 + (lane & 31)] = W[(size_t)(k0 + kk) * N + n0 + (lane & 31)]; }
    LDS_WAIT(); asm volatile("" ::: "memory");
    const int c = lane & 7;
    int d0 = n0; if (glu) d0 = n0 < 2048 ? ((n0 >> 7) * 256 + (n0 & 127)) : (((n0 - 2048) >> 7) * 256 + 128 + ((n0 - 2048) & 127));
#pragma unroll
    for (int j = 0; j < 4; ++j) { const int n = (lane >> 3) + 8 * j; const LAS float* s = scr + (8 * c) * 33 + n;
        v4u o; o.x = pk2(s[0 * 33], s[1 * 33]); o.y = pk2(s[2 * 33], s[3 * 33]); o.z = pk2(s[4 * 33], s[5 * 33]); o.w = pk2(s[6 * 33], s[7 * 33]);
        *(v4u*)(WT + (size_t)(d0 + n) * K + k0 + 8 * c) = o; }
    LDS_WAIT(); asm volatile("" ::: "memory");
}
__device__ __forceinline__ void p0_phase(const Ctx& C) {
    LAS float* scr = (LAS float*)(C.lds + C.wave * 16384);
    constexpr int I_IN = (2048 / 64) * (6144 / 32), I_PA = (1024 / 64) * (2048 / 32), I_GLU = (1024 / 64) * (4096 / 32), I_OUT = (2048 / 64) * (2048 / 32), I_UP = (2048 / 64) * (8192 / 32), I_DN = (8192 / 64) * (2048 / 32);
    constexpr int NIT = I_IN + I_PA + I_GLU + I_OUT + I_UP + I_DN;
    for (int it = C.gw; it < NIT; it += C.NGW) {
        int r = it;
        if (r < I_IN) { p0_transpose_item(C.w_in, 2048, 6144, C.Win, 0, scr, r, C.lane); continue; } r -= I_IN;
        if (r < I_PA) { p0_transpose_item(C.w_pa, 1024, 2048, C.Wpa, 0, scr, r, C.lane); continue; } r -= I_PA;
        if (r < I_GLU) { p0_transpose_item(C.w_glu, 1024, 4096, C.Wglu, 1, scr, r, C.lane); continue; } r -= I_GLU;
        if (r < I_OUT) { p0_transpose_item(C.w_out, 2048, 2048, C.Wout, 0, scr, r, C.lane); continue; } r -= I_OUT;
        if (r < I_UP) { p0_transpose_item(C.w_up, 2048, 8192, C.Wup, 0, scr, r, C.lane); continue; } r -= I_UP;
        p0_transpose_item(C.w_dn, 8192, 2048, C.Wdn, 0, scr, r, C.lane);
    }
    for (int r = C.gw; r < 144; r += C.NGW) {
        const float* src = r < 4 ? C.c_p + (size_t)r * D_MODEL : C.c_s + (size_t)(r < 132 ? r - 4 : 0) * D_MODEL;
#pragma unroll
        for (int j = 0; j < 4; ++j) { const int idx = j * 512 + C.lane * 8;
            f32x4 a = *(const f32x4*)(src + idx), b = *(const f32x4*)(src + idx + 4);
#pragma unroll
            for (int i = 0; i < 4; ++i) { a[i] = a[i] * sigm(a[i]); b[i] = b[i] * sigm(b[i]); }
            if (r >= 132) { a = (f32x4){0.f, 0.f, 0.f, 0.f}; b = a; }
            v4u o; o.x = pk2(a[0], a[1]); o.y = pk2(a[2], a[3]); o.z = pk2(b[0], b[1]); o.w = pk2(b[2], b[3]);
            *(v4u*)(C.silu + (size_t)r * D_MODEL + idx) = o; }
    }
    for (int g = C.gw; g < NGRP; g += C.NGW) {
        const int idx = g * NST + C.lane;
        const float ar = C.a_re[idx], ai = C.a_im[idx], dt = expf(C.log_dt[g]);
        const float mag = expf(dt * ar), ang = dt * ai;
        float sn, cs; sincosf(ang, &sn, &cs);
        const float abr = mag * cs, abi = mag * sn;
        const float den = ar * ar + ai * ai, nr = abr - 1.0f, ni = abi;
        const float qre = (nr * ar + ni * ai) / den, qim = (ni * ar - nr * ai) / den;
        C.abr[idx] = abr; C.abi[idx] = abi;
#pragma unroll
        for (int k4 = 0; k4 < 4; ++k4) { const f32x4 br = *(const f32x4*)(C.b_re + (size_t)idx * 16 + 4 * k4), bi = *(const f32x4*)(C.b_im + (size_t)idx * 16 + 4 * k4);
            *(f32x4*)(C.bbr + (size_t)idx * 16 + 4 * k4) = qre * br - qim * bi; *(f32x4*)(C.bbi + (size_t)idx * 16 + 4 * k4) = qre * bi + qim * br; }
    }
}

__device__ __forceinline__ void mod_phase(const Ctx& C) {
    const int n = C.lane & 15, kg = C.lane >> 4;
    LAS f32x4* part = (LAS f32x4*)C.lds;
    for (int u = blockIdx.x; u < MODN / 48; u += C.G) {
        const int n0 = u * 48;
        const float* Wp = C.w_ada + (size_t)(256 * C.wave + 8 * kg) * MODN + n0 + n;
        const bf16* Ap = C.silu + (size_t)n * D_MODEL + 256 * C.wave + 8 * kg;
        f32x4 acc[9][3];
#pragma unroll
        for (int i = 0; i < 9; ++i)
#pragma unroll
            for (int j = 0; j < 3; ++j) acc[i][j] = (f32x4){0.f, 0.f, 0.f, 0.f};
        float wc[3][8], wn[3][8];
#pragma unroll
        for (int f = 0; f < 3; ++f)
#pragma unroll
            for (int j = 0; j < 8; ++j) wc[f][j] = Wp[(size_t)j * MODN + 16 * f];
#pragma unroll 1
        for (int ks = 0; ks < 8; ++ks) {
            const int kn = ks + 1 < 8 ? ks + 1 : ks;
#pragma unroll
            for (int f = 0; f < 3; ++f)
#pragma unroll
                for (int j = 0; j < 8; ++j) wn[f][j] = Wp[(size_t)(kn * 32 + j) * MODN + 16 * f];
            bf16x8 bfr[3];
#pragma unroll
            for (int f = 0; f < 3; ++f) bfr[f] = pack8((f32x4){wc[f][0], wc[f][1], wc[f][2], wc[f][3]}, (f32x4){wc[f][4], wc[f][5], wc[f][6], wc[f][7]});
#pragma unroll
            for (int mf = 0; mf < 9; ++mf) { const bf16x8 a = *(const bf16x8*)(Ap + (size_t)mf * 16 * D_MODEL + ks * 32);
#pragma unroll
                for (int f = 0; f < 3; ++f) acc[mf][f] = __builtin_amdgcn_mfma_f32_16x16x32_bf16(bfr[f], a, acc[mf][f], 0, 0, 0); }
#pragma unroll
            for (int f = 0; f < 3; ++f)
#pragma unroll
                for (int j = 0; j < 8; ++j) wc[f][j] = wn[f][j];
        }
#pragma unroll
        for (int f = 0; f < 3; ++f) {
#pragma unroll
            for (int mf = 0; mf < 9; ++mf) part[(C.wave * 9 + mf) * 64 + C.lane] = acc[mf][f];
            __syncthreads();
            for (int e = C.tid; e < 9 * 64; e += NWAVES * 64) {
                f32x4 sm = part[e];
#pragma unroll
                for (int wv = 1; wv < 8; ++wv) sm += part[wv * 576 + e];
                const int mf = e >> 6, l64 = e & 63, row = mf * 16 + (l64 & 15), col = n0 + 16 * f + 4 * (l64 >> 4);
                *(f32x4*)(C.modt + (size_t)row * MODN + col) = sm + *(const f32x4*)(C.b_ada + col);
            }
            __syncthreads();
        }
    }
}

__device__ __forceinline__ void norm_mod_phase(const Ctx& C, const float* xp, const float* xs, const float* g, int sh_off, int sc_off, bf16* O) {
    const int r0 = (int)(((long)C.gw * MR) / C.NGW), r1 = (int)(((long)(C.gw + 1) * MR) / C.NGW);
    if (r0 >= r1) return;
    f32x4 gs[8], sh[8], v[8], vn[8];
    int cur_m = -1;
#pragma unroll
    for (int j = 0; j < 8; ++j) { const float* xr = r0 < MP ? xp + (size_t)r0 * D_MODEL : xs + (size_t)(r0 - MP) * D_MODEL; v[j] = *(const f32x4*)(xr + 256 * j + 4 * C.lane); }
    for (int row = r0; row < r1; ++row) {
        if (row + 1 < r1) { const float* xr = row + 1 < MP ? xp + (size_t)(row + 1) * D_MODEL : xs + (size_t)(row + 1 - MP) * D_MODEL;
#pragma unroll
            for (int j = 0; j < 8; ++j) vn[j] = *(const f32x4*)(xr + 256 * j + 4 * C.lane); }
        const int m = pg8::mod_row(row);
        if (m != cur_m) { cur_m = m; const float* mr = C.modt + (size_t)m * MODN;
#pragma unroll
            for (int j = 0; j < 8; ++j) { const int col = 256 * j + 4 * C.lane; gs[j] = *(const f32x4*)(g + col) * (1.0f + *(const f32x4*)(mr + sc_off + col)); sh[j] = *(const f32x4*)(mr + sh_off + col); } }
        float ss = 0.f;
#pragma unroll
        for (int j = 0; j < 8; ++j) ss += (v[j][0] * v[j][0] + v[j][1] * v[j][1]) + (v[j][2] * v[j][2] + v[j][3] * v[j][3]);
        const float rstd = 1.0f / sqrtf(wave_sum(ss) * (1.0f / D_MODEL) + EPS);
#pragma unroll
        for (int j = 0; j < 8; ++j) { const int col = 256 * j + 4 * C.lane;
            const f32x4 o = v[j] * rstd * gs[j] + sh[j];
            v2u w; w.x = pk2(o[0], o[1]); w.y = pk2(o[2], o[3]);
            *(v2u*)(O + (size_t)row * D_MODEL + col) = w; }
#pragma unroll
        for (int j = 0; j < 8; ++j) v[j] = vn[j];
    }
}
__device__ __forceinline__ void final_norm_phase(const Ctx& C) {
    const int r0 = (int)(((long)C.gw * MR) / C.NGW), r1 = (int)(((long)(C.gw + 1) * MR) / C.NGW);
    if (r0 >= r1) return;
    f32x4 gf[8], v[8], vn[8];
#pragma unroll
    for (int j = 0; j < 8; ++j) { gf[j] = *(const f32x4*)(C.g_fin + 256 * j + 4 * C.lane); v[j] = *(const f32x4*)(C.out + (size_t)r0 * D_MODEL + 256 * j + 4 * C.lane); }
    for (int row = r0; row < r1; ++row) {
        float* xr = C.out + (size_t)row * D_MODEL;
        if (row + 1 < r1) {
#pragma unroll
            for (int j = 0; j < 8; ++j) vn[j] = *(const f32x4*)(xr + D_MODEL + 256 * j + 4 * C.lane); }
        float ss = 0.f;
#pragma unroll
        for (int j = 0; j < 8; ++j) ss += (v[j][0] * v[j][0] + v[j][1] * v[j][1]) + (v[j][2] * v[j][2] + v[j][3] * v[j][3]);
        const float rstd = 1.0f / sqrtf(wave_sum(ss) * (1.0f / D_MODEL) + EPS);
#pragma unroll
        for (int j = 0; j < 8; ++j) *(f32x4*)(xr + 256 * j + 4 * C.lane) = v[j] * rstd * gf[j];
#pragma unroll
        for (int j = 0; j < 8; ++j) v[j] = vn[j];
    }
}

__device__ __forceinline__ f32x16 zero16() { return f32x16{}; }

constexpr int TROW = 272;
constexpr int TILE256 = 256 * TROW, TILE128 = 128 * TROW;
static_assert(TILE256 + NWAVES * 8704 <= LDSCTL_OFF && 4 * TILE128 <= LDSCTL_OFF, "scan LDS map");

__device__ __forceinline__ void new_conv_prompt(const Ctx& C) {
    const int nthr = C.G * NWAVES * 64;
    for (int idx = C.vcu * (NWAVES * 64) + C.tid; idx < NB * 3 * W_LRU; idx += nthr) {
        const int ch = idx & (W_LRU - 1), k = (idx >> 10) % 3, b = idx / (3 * W_LRU);
        C.out[O_CP + idx] = bf2f(C.P[(size_t)(b * SEQ + SEQ - 3 + k) * NPROJ + ch]);
    }
}

template <bool APPLY>
__device__ __forceinline__ void s5_block(const Ctx& C, int go, int q) {
    const int lane = C.lane, c31 = lane & 31, kh = lane >> 5, w = C.wave, g = go * 8 + w;
    const int asel = (c31 >> 2) & 1, atok = (c31 & 3) + 4 * (c31 >> 3);
    const int b = q >> 3, cX = 2 * (q & 7), myc = cX + kh;
    const int rowX = b * SEQ + cX * S5_TC;
    LAS unsigned char* tile = C.lds;
    {
        const int rr = C.tid >> 4, cc = (C.tid & 15) * 8;
        v4u tmp[8];
#pragma unroll
        for (int i = 0; i < 8; ++i) tmp[i] = *(const v4u*)(C.P + (size_t)(rowX + i * 32 + rr) * NPROJ + W_LRU + go * 128 + cc);
#pragma unroll
        for (int i = 0; i < 8; ++i) *(LAS v4u*)(tile + (i * 32 + rr) * TROW + cc * 2) = tmp[i];
    }
    bf16x8 bb[2][2]; float ar[2], ai[2], hr[2], hi[2];
#pragma unroll
    for (int ph = 0; ph < 2; ++ph) { const int idx = g * NST + ph * 32 + c31;
        ar[ph] = C.abr[idx]; ai[ph] = C.abi[idx]; hr[ph] = 0.f; hi[ph] = 0.f;
        const f32x4* sr = (const f32x4*)(C.bbr + (size_t)idx * 16 + 8 * kh); const f32x4* si = (const f32x4*)(C.bbi + (size_t)idx * 16 + 8 * kh);
        bb[0][ph] = pack8(sr[0], sr[1]); bb[1][ph] = pack8(si[0], si[1]); }
    bf16x8 cb[8];
    float dsk = 0.f;
    if (APPLY) {
#pragma unroll
        for (int ph = 0; ph < 2; ++ph) { float pr = ar[ph], pi = ai[ph];
#pragma unroll
            for (int s = 0; s < 7; ++s) { const float nr = pr * pr - pi * pi, ni = 2.0f * pr * pi; pr = nr; pi = ni; }
            const size_t sidx = (size_t)g * NST + ph * 32 + c31; float Hr = 0.f, Hi = 0.f;
#pragma unroll
            for (int j = 0; j < S5_NCH - 1; ++j) { const float sr = C.ssr[(size_t)(b * S5_NCH + j) * 4096 + sidx], si = C.ssi[(size_t)(b * S5_NCH + j) * 4096 + sidx];
                const float nr = pr * Hr - pi * Hi + sr, ni = pr * Hi + pi * Hr + si; if (j < myc) { Hr = nr; Hi = ni; } }
            hr[ph] = Hr; hi[ph] = Hi; }
#pragma unroll
        for (int s = 0; s < 8; ++s) { f32x4 a = (f32x4){0.f, 0.f, 0.f, 0.f}, bq = a;
            if (c31 < 16) { const float* src = (s < 4 ? C.c_re : C.c_im) + (size_t)(g * GSZ + c31) * NST + 16 * (s & 3) + 8 * kh; a = *(const f32x4*)src; bq = *(const f32x4*)(src + 4); if (s >= 4) { a = -a; bq = -bq; } }
            cb[s] = pack8(a, bq); }
        dsk = C.ssm_d[g * GSZ + (c31 & 15)];
    }
    __syncthreads();
    ISTAMP(30);
    LAS bf16* hl = (LAS bf16*)(C.lds + TILE256 + w * 8704);
    const LAS unsigned char* abase = tile + (asel * S5_TC + atok) * TROW + (16 * w + 8 * kh) * 2;
    LAS bf16* ubase = (LAS bf16*)(tile + (kh * S5_TC) * TROW) + 16 * w + (c31 & 15);
    for (int st = 0; st < S5_TC / 16; ++st) {
        const bf16x8 af = *(const LAS bf16x8*)(abase + st * 16 * TROW);
        const f32x16 z = zero16();
        f32x16 re0 = __builtin_amdgcn_mfma_f32_32x32x16_bf16(af, bb[0][0], z, 0, 0, 0), re1 = __builtin_amdgcn_mfma_f32_32x32x16_bf16(af, bb[0][1], z, 0, 0, 0);
        f32x16 im0 = __builtin_amdgcn_mfma_f32_32x32x16_bf16(af, bb[1][0], z, 0, 0, 0), im1 = __builtin_amdgcn_mfma_f32_32x32x16_bf16(af, bb[1][1], z, 0, 0, 0);
#pragma unroll
        for (int r = 0; r < 16; ++r) {
            { const float nr = ar[0] * hr[0] - ai[0] * hi[0] + re0[r], ni = ar[0] * hi[0] + ai[0] * hr[0] + im0[r]; hr[0] = nr; hi[0] = ni; re0[r] = nr; im0[r] = ni; }
            { const float nr = ar[1] * hr[1] - ai[1] * hi[1] + re1[r], ni = ar[1] * hi[1] + ai[1] * hr[1] + im1[r]; hr[1] = nr; hi[1] = ni; re1[r] = nr; im1[r] = ni; }
        }
        if (APPLY) {
#pragma unroll
            for (int r = 0; r < 16; ++r) { const int rho = (r & 3) + 4 * kh + 8 * (r >> 2);
                const unsigned wre = pk2(re0[r], re1[r]), wim = pk2(im0[r], im1[r]);
                hl[rho * 136 + c31] = (bf16)wre; hl[rho * 136 + 32 + c31] = (bf16)(wre >> 16);
                hl[rho * 136 + 64 + c31] = (bf16)wim; hl[rho * 136 + 96 + c31] = (bf16)(wim >> 16); }
            f32x16 y = zero16();
#pragma unroll
            for (int s = 0; s < 8; ++s) { const bf16x8 hA = *(const LAS bf16x8*)(hl + c31 * 136 + 16 * s + 8 * kh); y = __builtin_amdgcn_mfma_f32_32x32x16_bf16(hA, cb[s], y, 0, 0, 0); }
            if (c31 < 16) {
#pragma unroll
                for (int r = 0; r < 16; ++r) { LAS bf16* up = ubase + (st * 16 + r) * (TROW / 2);
                    const float u = bf2f(*up); { const float gv = gelu_tanh(y[r] + dsk * u); *up = (bf16)pk2(gv, gv); } } }
        }
    }
#pragma unroll
    for (int ph = 0; ph < 2; ++ph) { const size_t sidx = (size_t)g * NST + ph * 32 + c31;
        if (!APPLY) { C.ssr[(size_t)(b * S5_NCH + myc) * 4096 + sidx] = hr[ph]; C.ssi[(size_t)(b * S5_NCH + myc) * 4096 + sidx] = hi[ph]; }
        else if (myc == S5_NCH - 1) { C.out[O_RP + (size_t)b * 4096 + sidx] = hr[ph]; C.out[O_IP + (size_t)b * 4096 + sidx] = hi[ph]; } }
    __syncthreads();
    ISTAMP(31);
    if (APPLY) {
        const int rr = C.tid >> 4, cc = (C.tid & 15) * 8;
#pragma unroll
        for (int i = 0; i < 8; ++i) *(v4u*)(C.GY + (size_t)(rowX + i * 32 + rr) * W_SSM + go * 128 + cc) = *(const LAS v4u*)(tile + (i * 32 + rr) * TROW + cc * 2);
        __syncthreads();
    }
}

struct LruRegs { unsigned pk[LR_TC]; float hend, aend; };
__device__ __forceinline__ void lru_local(const Ctx& C, int U, LruRegs& R) {
    const int lane = C.lane, c31 = lane & 31, kh = lane >> 5, sub = C.wave >> 2, jt = C.wave & 3;
    const int asel = (c31 >> 2) & 1, atok = (c31 & 3) + 4 * (c31 >> 3);
    const int cmb = 2 * U + sub, hd = cmb & 7, q = cmb >> 3;
    const int b = q >> 4, cX = 2 * (q & 15), myc = cX + kh;
    const int rowX = b * SEQ + cX * LR_TC;
    const int ch = hd * HDIM + jt * 32 + c31;
    LAS unsigned char* tin = C.lds + sub * TILE128;
    {
        const int tt = C.tid & 255, rg = tt >> 4, cg = tt & 15, c0 = hd * HDIM + cg * 8;
        const int r0 = rg * 8, row0 = rowX + r0, t0 = row0 & (SEQ - 1);
        v4u u[11];
#pragma unroll
        for (int i = 0; i < 11; ++i) { const int dt = i - 3; u[i] = (v4u){0u, 0u, 0u, 0u}; if (t0 + dt >= 0) u[i] = *(const v4u*)(C.P + (size_t)(row0 + dt) * NPROJ + c0); }
        f32x4 cw0[4], cw1[4];
#pragma unroll
        for (int k = 0; k < 4; ++k) { cw0[k] = *(const f32x4*)(C.conv_w + k * W_LRU + c0); cw1[k] = *(const f32x4*)(C.conv_w + k * W_LRU + c0 + 4); }
        const f32x4 cb0 = *(const f32x4*)(C.conv_b + c0), cb1 = *(const f32x4*)(C.conv_b + c0 + 4);
#pragma unroll
        for (int i = 0; i < 8; ++i) { f32x4 a0 = cb0, a1 = cb1;
#pragma unroll
            for (int k = 0; k < 4; ++k) { const v4u x = u[i + k];
                a0[0] += cw0[k][0] * bflo(x.x); a0[1] += cw0[k][1] * bfhi(x.x); a0[2] += cw0[k][2] * bflo(x.y); a0[3] += cw0[k][3] * bfhi(x.y);
                a1[0] += cw1[k][0] * bflo(x.z); a1[1] += cw1[k][1] * bfhi(x.z); a1[2] += cw1[k][2] * bflo(x.w); a1[3] += cw1[k][3] * bfhi(x.w); }
            v4u o; o.x = pk2(a0[0], a0[1]); o.y = pk2(a0[2], a0[3]); o.z = pk2(a1[0], a1[1]); o.w = pk2(a1[2], a1[3]);
            *(LAS v4u*)(tin + (r0 + i) * TROW + cg * 16) = o; }
    }
    bf16x8 wa[8], wx[8];
#pragma unroll
    for (int s = 0; s < 8; ++s) { float ta[8], tx[8];
#pragma unroll
        for (int j = 0; j < 8; ++j) { const size_t wi = (size_t)(hd * HDIM + 16 * s + 8 * kh + j) * HDIM + jt * 32 + c31; ta[j] = C.w_rga[wi]; tx[j] = C.w_rgx[wi]; }
        wa[s] = pack8((f32x4){ta[0], ta[1], ta[2], ta[3]}, (f32x4){ta[4], ta[5], ta[6], ta[7]}); wx[s] = pack8((f32x4){tx[0], tx[1], tx[2], tx[3]}, (f32x4){tx[4], tx[5], tx[6], tx[7]}); }
    const float ba = C.b_rga[ch], bx = C.b_rgx[ch];
    const float lm = C.lam[ch];
    const float sp8 = 8.0f * (fmaxf(-lm, 0.f) + log1pf(expf(-fabsf(lm))));
    float h = 0.f, aprod = 1.f;
    __syncthreads();
    const LAS unsigned char* abase = tin + (asel * LR_TC + atok) * TROW + 8 * kh * 2;
    const LAS bf16* ucb = (const LAS bf16*)(tin + (kh * LR_TC) * TROW) + jt * 32 + c31;
#pragma unroll
    for (int st = 0; st < LR_TC / 16; ++st) {
        f32x16 pr = zero16(), pi = zero16();
#pragma unroll
        for (int s = 0; s < 8; ++s) { const bf16x8 af = *(const LAS bf16x8*)(abase + st * 16 * TROW + 32 * s);
            pr = __builtin_amdgcn_mfma_f32_32x32x16_bf16(af, wa[s], pr, 0, 0, 0); pi = __builtin_amdgcn_mfma_f32_32x32x16_bf16(af, wx[s], pi, 0, 0, 0); }
#pragma unroll
        for (int r = 0; r < 16; ++r) {
            const float uc = bf2f(ucb[(st * 16 + r) * (TROW / 2)]);
            const float rr = sigm(pr[r] + ba), ii = sigm(pi[r] + bx);
            const float la = -sp8 * rr, a = __builtin_amdgcn_exp2f(1.44269504f * la);
            const float t2 = 2.0f * la;
            float om = -t2 * (1.0f + t2 * (0.5f + t2 * (0.16666667f + t2 * (0.041666668f + t2 * (0.008333334f + t2 * 0.0013888889f)))));
            asm volatile("" : "+v"(om));
            om = t2 > -0.25f ? om : 1.0f - a * a;
            const float mult = __builtin_amdgcn_sqrtf(fmaxf(om, 0.f));
            h = a * h + mult * ii * uc; aprod *= a;
            R.pk[st * 16 + r] = pk2(h, aprod); }
    }
    R.hend = h; R.aend = aprod;
    C.lra[(size_t)(b * LR_NCH + myc) * W_LRU + ch] = aprod; C.lre[(size_t)(b * LR_NCH + myc) * W_LRU + ch] = h;
}
__device__ __forceinline__ void lru_fix(const Ctx& C, int U, const LruRegs& R) {
    const int lane = C.lane, c31 = lane & 31, kh = lane >> 5, sub = C.wave >> 2, jt = C.wave & 3;
    const int cmb = 2 * U + sub, hd = cmb & 7, q = cmb >> 3;
    const int b = q >> 4, cX = 2 * (q & 15), myc = cX + kh;
    const int rowX = b * SEQ + cX * LR_TC;
    const int ch = hd * HDIM + jt * 32 + c31;
    LAS unsigned char* tout = C.lds + 2 * TILE128 + sub * TILE128;
    float H = 0.f;
#pragma unroll
    for (int j = 0; j < LR_NCH - 1; ++j) { const float A = C.lra[(size_t)(b * LR_NCH + j) * W_LRU + ch], E = C.lre[(size_t)(b * LR_NCH + j) * W_LRU + ch]; const float nh = A * H + E; if (j < myc) H = nh; }
    LAS bf16* hob = (LAS bf16*)(tout + (kh * LR_TC) * TROW) + jt * 32 + c31;
#pragma unroll
    for (int t = 0; t < LR_TC; ++t) { const float hv = bflo(R.pk[t]) + bfhi(R.pk[t]) * H; hob[t * (TROW / 2)] = (bf16)pk2(hv, hv); }
    if (myc == LR_NCH - 1) C.out[O_LP + (size_t)b * W_LRU + ch] = R.hend + R.aend * H;
    __syncthreads();
    {
        const int tt = C.tid & 255, rr = tt >> 4, cc = (tt & 15) * 8;
#pragma unroll
        for (int i = 0; i < 8; ++i) *(v4u*)(C.HS + (size_t)(rowX + i * 16 + rr) * W_LRU + hd * HDIM + cc) = *(const LAS v4u*)(tout + (i * 16 + rr) * TROW + cc * 2);
    }
    __syncthreads();
}

__device__ __forceinline__ void lru_sample_block(const Ctx& C, int U) {
    const int lane = C.lane, c31 = lane & 31, kh = lane >> 5, sub = C.wave >> 2, jt = C.wave & 3;
    const int cmb = 2 * U + sub, hd = cmb & 7, sb = cmb >> 3;
    const int ch = hd * HDIM + jt * 32 + c31;
    LAS unsigned char* tin = C.lds + sub * TILE128;
    {
        const int tt = C.tid & 255, rr = tt >> 4, c0 = hd * HDIM + (tt & 15) * 8;
#pragma unroll
        for (int i = 0; i < 2; ++i) { const int rho = i * 16 + rr, sidx = sb * 32 + rho;
            const v4u u = *(const v4u*)(C.P + (size_t)(MP + sidx) * NPROJ + c0);
            const f32x4 u0 = (f32x4){bflo(u.x), bfhi(u.x), bflo(u.y), bfhi(u.y)}, u1 = (f32x4){bflo(u.z), bfhi(u.z), bflo(u.w), bfhi(u.w)};
            f32x4 a0 = *(const f32x4*)(C.conv_b + c0) + *(const f32x4*)(C.conv_w + 3 * W_LRU + c0) * u0, a1 = *(const f32x4*)(C.conv_b + c0 + 4) + *(const f32x4*)(C.conv_w + 3 * W_LRU + c0 + 4) * u1;
            float* nc = C.out + O_CS + (size_t)sidx * 3 * W_LRU + c0;
#pragma unroll
            for (int k = 0; k < 3; ++k) { const f32x4 s0 = *(const f32x4*)(C.st_conv + (size_t)(sidx * 3 + k) * W_LRU + c0), s1 = *(const f32x4*)(C.st_conv + (size_t)(sidx * 3 + k) * W_LRU + c0 + 4);
                a0 += *(const f32x4*)(C.conv_w + k * W_LRU + c0) * s0; a1 += *(const f32x4*)(C.conv_w + k * W_LRU + c0 + 4) * s1;
                if (k > 0) { *(f32x4*)(nc + (k - 1) * W_LRU) = s0; *(f32x4*)(nc + (k - 1) * W_LRU + 4) = s1; } }
            *(f32x4*)(nc + 2 * W_LRU) = u0; *(f32x4*)(nc + 2 * W_LRU + 4) = u1;
            v4u o; o.x = pk2(a0[0], a0[1]); o.y = pk2(a0[2], a0[3]); o.z = pk2(a1[0], a1[1]); o.w = pk2(a1[2], a1[3]);
            *(LAS v4u*)(tin + rho * TROW + (tt & 15) * 16) = o; }
    }
    bf16x8 wa[8], wx[8];
#pragma unroll
    for (int s = 0; s < 8; ++s) { float ta[8], tx[8];
#pragma unroll
        for (int j = 0; j < 8; ++j) { const size_t wi = (size_t)(hd * HDIM + 16 * s + 8 * kh + j) * HDIM + jt * 32 + c31; ta[j] = C.w_rga[wi]; tx[j] = C.w_rgx[wi]; }
        wa[s] = pack8((f32x4){ta[0], ta[1], ta[2], ta[3]}, (f32x4){ta[4], ta[5], ta[6], ta[7]}); wx[s] = pack8((f32x4){tx[0], tx[1], tx[2], tx[3]}, (f32x4){tx[4], tx[5], tx[6], tx[7]}); }
    const float ba = C.b_rga[ch], bx = C.b_rgx[ch];
    const float lm = C.lam[ch];
    const float sp8 = 8.0f * (fmaxf(-lm, 0.f) + log1pf(expf(-fabsf(lm))));
    __syncthreads();
    f32x16 pr = zero16(), pi = zero16();
#pragma unroll
    for (int s = 0; s < 8; ++s) { const bf16x8 af = *(const LAS bf16x8*)(tin + c31 * TROW + 16 * kh + 32 * s);
        pr = __builtin_amdgcn_mfma_f32_32x32x16_bf16(af, wa[s], pr, 0, 0, 0); pi = __builtin_amdgcn_mfma_f32_32x32x16_bf16(af, wx[s], pi, 0, 0, 0); }
#pragma unroll
    for (int r = 0; r < 16; ++r) { const int rho = (r & 3) + 8 * (r >> 2) + 4 * kh, sidx = sb * 32 + rho;
        const float uc = bf2f(*((const LAS bf16*)(tin + rho * TROW) + jt * 32 + c31));
        const float rr = sigm(pr[r] + ba), ii = sigm(pi[r] + bx);
        const float la = -sp8 * rr, a = __builtin_amdgcn_exp2f(1.44269504f * la);
        const float t2 = 2.0f * la;
        const float om = t2 > -0.25f ? -t2 * (1.0f + t2 * (0.5f + t2 * (0.16666667f + t2 * (0.041666668f + t2 * (0.008333334f + t2 * 0.0013888889f))))) : 1.0f - a * a;
        const float h = a * C.st_lru[(size_t)sidx * W_LRU + ch] + sqrtf(fmaxf(om, 0.f)) * ii * uc;
        C.out[O_LS + (size_t)sidx * W_LRU + ch] = h;
        C.HS[(size_t)(MP + sidx) * W_LRU + ch] = (bf16)pk2(h, h); }
    __syncthreads();
}
__device__ __forceinline__ void s5_sample_wave(const Ctx& C, int g, int sb, LAS bf16* hl) {
    const int lane = C.lane, c31 = lane & 31, kh = lane >> 5;
    bf16x8 bb[2][2]; float ar[2], ai[2];
#pragma unroll
    for (int ph = 0; ph < 2; ++ph) { const int idx = g * NST + ph * 32 + c31;
        ar[ph] = C.abr[idx]; ai[ph] = C.abi[idx];
        const f32x4* sr = (const f32x4*)(C.bbr + (size_t)idx * 16 + 8 * kh); const f32x4* si = (const f32x4*)(C.bbi + (size_t)idx * 16 + 8 * kh);
        bb[0][ph] = pack8(sr[0], sr[1]); bb[1][ph] = pack8(si[0], si[1]); }
    bf16x8 cb[8];
#pragma unroll
    for (int s = 0; s < 8; ++s) { f32x4 a = (f32x4){0.f, 0.f, 0.f, 0.f}, bq = a;
        if (c31 < 16) { const float* src = (s < 4 ? C.c_re : C.c_im) + (size_t)(g * GSZ + c31) * NST + 16 * (s & 3) + 8 * kh; a = *(const f32x4*)src; bq = *(const f32x4*)(src + 4); if (s >= 4) { a = -a; bq = -bq; } }
        cb[s] = pack8(a, bq); }
    const float dsk = C.ssm_d[g * GSZ + (c31 & 15)];
    const bf16x8 af = *(const bf16x8*)(C.P + (size_t)(MP + sb * 32 + c31) * NPROJ + W_LRU + g * GSZ + 8 * kh);
    const f32x16 z = zero16();
    f32x16 re0 = __builtin_amdgcn_mfma_f32_32x32x16_bf16(af, bb[0][0], z, 0, 0, 0), re1 = __builtin_amdgcn_mfma_f32_32x32x16_bf16(af, bb[0][1], z, 0, 0, 0);
    f32x16 im0 = __builtin_amdgcn_mfma_f32_32x32x16_bf16(af, bb[1][0], z, 0, 0, 0), im1 = __builtin_amdgcn_mfma_f32_32x32x16_bf16(af, bb[1][1], z, 0, 0, 0);
#pragma unroll
    for (int r = 0; r < 16; ++r) { const int rho = (r & 3) + 8 * (r >> 2) + 4 * kh; const size_t so = (size_t)(sb * 32 + rho) * 4096 + g * NST + c31;
        const float a0r = C.st_re[so], a0i = C.st_im[so], a1r = C.st_re[so + 32], a1i = C.st_im[so + 32];
        const float h0r = ar[0] * a0r - ai[0] * a0i + re0[r], h0i = ar[0] * a0i + ai[0] * a0r + im0[r];
        const float h1r = ar[1] * a1r - ai[1] * a1i + re1[r], h1i = ar[1] * a1i + ai[1] * a1r + im1[r];
        C.out[O_RS + so] = h0r; C.out[O_IS + so] = h0i; C.out[O_RS + so + 32] = h1r; C.out[O_IS + so + 32] = h1i;
        const unsigned wre = pk2(h0r, h1r), wim = pk2(h0i, h1i);
        hl[rho * 136 + c31] = (bf16)wre; hl[rho * 136 + 32 + c31] = (bf16)(wre >> 16);
        hl[rho * 136 + 64 + c31] = (bf16)wim; hl[rho * 136 + 96 + c31] = (bf16)(wim >> 16); }
    f32x16 y = zero16();
#pragma unroll
    for (int s = 0; s < 8; ++s) { const bf16x8 hA = *(const LAS bf16x8*)(hl + c31 * 136 + 16 * s + 8 * kh); y = __builtin_amdgcn_mfma_f32_32x32x16_bf16(hA, cb[s], y, 0, 0, 0); }
    if (c31 < 16) { const int ch = g * GSZ + c31;
#pragma unroll
        for (int r = 0; r < 16; ++r) { const size_t row = (size_t)(MP + sb * 32 + (r & 3) + 8 * (r >> 2) + 4 * kh);
            const float u = bf2f(C.P[row * NPROJ + W_LRU + ch]); const float gv = gelu_tanh(y[r] + dsk * u);
            C.GY[row * W_SSM + ch] = (bf16)pk2(gv, gv); } }
    LDS_WAIT(); asm volatile("" ::: "memory");
}

template <int MF, int NF, int UNR, class Epi>
__device__ __forceinline__ void skinny_gemm(const Ctx& C, const bf16* A, const bf16* Wt, int K, int ncb, const Epi& E) {
    constexpr int RB = MF * 16, NRB = 128 / RB;
    const int ntiles = NRB * ncb, l15 = C.lane & 15, kg = C.lane >> 4, kw = K / NWAVES;
    LAS f32x4* part = (LAS f32x4*)C.lds;
    for (int t = blockIdx.x; t < ntiles; t += C.G) {
        int rb = t % NRB, cb = t / NRB;
        if ((C.G & 7) == 0 && (ncb & 7) == 0) { const int xcd = t & 7, j = t >> 3; rb = j % NRB; cb = xcd * (ncb >> 3) + j / NRB; }
        f32x4 acc[MF][NF];
#pragma unroll
        for (int i = 0; i < MF; ++i)
#pragma unroll
            for (int j = 0; j < NF; ++j) acc[i][j] = (f32x4){0.f, 0.f, 0.f, 0.f};
        const bf16* Ap = A + (size_t)(rb * RB + l15) * K + C.wave * kw + 8 * kg;
        const bf16* Bp[NF];
#pragma unroll
        for (int j = 0; j < NF; ++j) Bp[j] = Wt + (size_t)(E.brow(cb, j) + l15) * K + C.wave * kw + 8 * kg;
        const int nb = (kw / 32) / UNR;
        bf16x8 a0[UNR][MF], b0[UNR][NF], a1[UNR][MF], b1[UNR][NF];
#define SK_LOAD(AA, BB, bi) do { _Pragma("unroll") for (int u_ = 0; u_ < UNR; ++u_) { const int ko_ = ((bi) * UNR + u_) * 32; \
            _Pragma("unroll") for (int i = 0; i < MF; ++i) AA[u_][i] = *(const bf16x8*)(Ap + (size_t)i * 16 * K + ko_); \
            _Pragma("unroll") for (int j = 0; j < NF; ++j) BB[u_][j] = *(const bf16x8*)(Bp[j] + ko_); } } while (0)
#define SK_COMP(AA, BB) do { _Pragma("unroll") for (int u_ = 0; u_ < UNR; ++u_) _Pragma("unroll") for (int i = 0; i < MF; ++i) _Pragma("unroll") for (int j = 0; j < NF; ++j) \
            acc[i][j] = __builtin_amdgcn_mfma_f32_16x16x32_bf16(BB[u_][j], AA[u_][i], acc[i][j], 0, 0, 0); } while (0)
        SK_LOAD(a0, b0, 0);
        __builtin_amdgcn_sched_barrier(0);
        for (int bi = 0; bi < nb; bi += 2) {
            if (bi + 1 < nb) SK_LOAD(a1, b1, bi + 1);
            __builtin_amdgcn_sched_barrier(0);
            SK_COMP(a0, b0);
            __builtin_amdgcn_sched_barrier(0);
            if (bi + 2 < nb) SK_LOAD(a0, b0, bi + 2);
            __builtin_amdgcn_sched_barrier(0);
            if (bi + 1 < nb) SK_COMP(a1, b1);
            __builtin_amdgcn_sched_barrier(0);
        }
#undef SK_LOAD
#undef SK_COMP
        SSTAMP(45);
#pragma unroll
        for (int i = 0; i < MF; ++i)
#pragma unroll
            for (int j = 0; j < NF; ++j) part[((C.wave * MF + i) * NF + j) * 64 + C.lane] = acc[i][j];
        __syncthreads();
        SSTAMP(46);
        for (int q = C.tid; q < MF * 64; q += NWAVES * 64) { const int mf = q >> 6, l64 = q & 63;
            f32x4 v[NF];
#pragma unroll
            for (int j = 0; j < NF; ++j) { f32x4 s = part[((0 * MF + mf) * NF + j) * 64 + l64];
#pragma unroll
                for (int wv = 1; wv < NWAVES; ++wv) s += part[((wv * MF + mf) * NF + j) * 64 + l64];
                v[j] = s; }
            E(rb * RB + mf * 16 + (l64 & 15), cb, l64 >> 4, v); }
        __syncthreads();
    }
}
struct SEpiProj { bf16* P;
    __device__ __forceinline__ int brow(int cb, int nf) const { return cb * 32 + nf * 16; }
    __device__ __forceinline__ void operator()(int r, int cb, int cq, const f32x4 (&v)[2]) const {
#pragma unroll
        for (int nf = 0; nf < 2; ++nf) { const int col = cb * 32 + nf * 16 + 4 * cq; f32x4 x = v[nf];
            if (col >= 2048) {
#pragma unroll
                for (int i = 0; i < 4; ++i) x[i] = sigm(x[i]); }
            v2u w; w.x = pk2(x[0], x[1]); w.y = pk2(x[2], x[3]); *(v2u*)(P + (size_t)(MP + r) * NPROJ + col) = w; } } };
struct SEpiGateA { bf16* T; const bf16* P;
    __device__ __forceinline__ int brow(int cb, int nf) const { return cb * 32 + nf * 16; }
    __device__ __forceinline__ void operator()(int r, int cb, int cq, const f32x4 (&v)[2]) const {
#pragma unroll
        for (int nf = 0; nf < 2; ++nf) { const int col = cb * 32 + nf * 16 + 4 * cq; const f32x4 x = v[nf];
            const v2u g = *(const v2u*)(P + (size_t)(MP + r) * NPROJ + 2048 + col);
            v2u w; w.x = pk2(x[0] * bflo(g.x), x[1] * bfhi(g.x)); w.y = pk2(x[2] * bflo(g.y), x[3] * bfhi(g.y)); *(v2u*)(T + (size_t)(MP + r) * D_MODEL + col) = w; } } };
struct SEpiGlu { bf16* MG; const bf16* T; const bf16* P;
    __device__ __forceinline__ int brow(int cb, int nf) const { const int v0 = cb * 16; return (v0 >> 7) * 256 + (v0 & 127) + nf * 128; }
    __device__ __forceinline__ void operator()(int r, int cb, int cq, const f32x4 (&v)[2]) const {
        const int col = cb * 16 + 4 * cq; const f32x4 a = v[0], g = v[1];
        const v2u t = *(const v2u*)(T + (size_t)(MP + r) * D_MODEL + col), z = *(const v2u*)(P + (size_t)(MP + r) * NPROJ + 4096 + col);
        v2u w; w.x = pk2(bflo(t.x) + bflo(z.x) * (a[0] * sigm(g[0])), bfhi(t.x) + bfhi(z.x) * (a[1] * sigm(g[1])));
        w.y = pk2(bflo(t.y) + bflo(z.y) * (a[2] * sigm(g[2])), bfhi(t.y) + bfhi(z.y) * (a[3] * sigm(g[3])));
        *(v2u*)(MG + (size_t)(MP + r) * D_MODEL + col) = w; } };
struct SEpiRes { const float* xin; float* out; const float* modt; int goff;
    __device__ __forceinline__ int brow(int cb, int nf) const { return cb * 32 + nf * 16; }
    __device__ __forceinline__ void operator()(int r, int cb, int cq, const f32x4 (&v)[2]) const {
#pragma unroll
        for (int nf = 0; nf < 2; ++nf) { const int col = cb * 32 + nf * 16 + 4 * cq;
            const f32x4 g = *(const f32x4*)(modt + (size_t)(4 + r) * MODN + goff + col), xv = *(const f32x4*)(xin + (size_t)r * D_MODEL + col);
            *(f32x4*)(out + (size_t)r * D_MODEL + col) = xv + g * v[nf]; } } };
struct SEpiRelu2 { bf16* O;
    __device__ __forceinline__ int brow(int cb, int nf) const { return cb * 32 + nf * 16; }
    __device__ __forceinline__ void operator()(int r, int cb, int cq, const f32x4 (&v)[2]) const {
#pragma unroll
        for (int nf = 0; nf < 2; ++nf) { const int col = cb * 32 + nf * 16 + 4 * cq; f32x4 x = v[nf];
#pragma unroll
            for (int i = 0; i < 4; ++i) { const float a = fmaxf(x[i], 0.f); x[i] = a * a; }
            v2u w; w.x = pk2(x[0], x[1]); w.y = pk2(x[2], x[3]); *(v2u*)(O + (size_t)(MP + r) * D_FF + col) = w; } } };

enum { PH_P0 = 0, PH_MOD, PH_H1, PH_G1, PH_SA, PH_G3, PH_G4, PH_G5, PH_H2, PH_G6, PH_G7, PH_FIN, N_PHASES };

__global__ void __launch_bounds__(NWAVES * 64, 2) hybrid_fwd(Args args) {
    extern __shared__ __attribute__((aligned(16))) unsigned char lds[];
    Ctx C;
    C.lds = (LAS unsigned char*)lds;
    C.tid = threadIdx.x; C.lane = C.tid & 63; C.wave = __builtin_amdgcn_readfirstlane(C.tid >> 6);
    C.G = gridDim.x; { const int bx = blockIdx.x; C.vcu = (C.G % 8 == 0) ? (bx % 8) * (C.G / 8) + bx / 8 : bx; }
    C.gw = C.vcu * NWAVES + C.wave; C.NGW = C.G * NWAVES;
    C.xp = (const float*)args.in[0]; C.xs = (const float*)args.in[1]; C.st_conv = (const float*)args.in[2]; C.st_lru = (const float*)args.in[3]; C.st_re = (const float*)args.in[4]; C.st_im = (const float*)args.in[5];
    C.c_p = (const float*)args.in[6]; C.c_s = (const float*)args.in[7]; C.w_ada = (const float*)args.in[8]; C.b_ada = (const float*)args.in[9]; C.g1 = (const float*)args.in[10]; C.g2 = (const float*)args.in[11];
    C.w_in = (const float*)args.in[12]; C.conv_w = (const float*)args.in[13]; C.conv_b = (const float*)args.in[14]; C.w_rga = (const float*)args.in[15]; C.b_rga = (const float*)args.in[16]; C.w_rgx = (const float*)args.in[17];
    C.b_rgx = (const float*)args.in[18]; C.lam = (const float*)args.in[19]; C.w_pa = (const float*)args.in[20]; C.a_re = (const float*)args.in[21]; C.a_im = (const float*)args.in[22]; C.log_dt = (const float*)args.in[23];
    C.b_re = (const float*)args.in[24]; C.b_im = (const float*)args.in[25]; C.c_re = (const float*)args.in[26]; C.c_im = (const float*)args.in[27]; C.ssm_d = (const float*)args.in[28]; C.w_glu = (const float*)args.in[29];
    C.w_out = (const float*)args.in[30]; C.w_up = (const float*)args.in[31]; C.w_dn = (const float*)args.in[32]; C.g_fin = (const float*)args.in[33];
    C.out = args.out; C.ws = args.ws;
    unsigned char* ws = args.ws;
    C.modt = (float*)(ws + WS_MOD); C.silu = (bf16*)(ws + WS_TAB + TB_SILU);
    C.abr = (float*)(ws + WS_TAB + TB_ABR); C.abi = (float*)(ws + WS_TAB + TB_ABI); C.bbr = (float*)(ws + WS_TAB + TB_BBR); C.bbi = (float*)(ws + WS_TAB + TB_BBI);
    C.ssr = (float*)(ws + WS_TAB + TB_SSR); C.ssi = (float*)(ws + WS_TAB + TB_SSI); C.lra = (float*)(ws + WS_TAB + TB_LRA); C.lre = (float*)(ws + WS_TAB + TB_LRE);
    C.Win = (bf16*)(ws + WS_WIN); C.Wpa = (bf16*)(ws + WS_WPA); C.Wglu = (bf16*)(ws + WS_WGLU); C.Wout = (bf16*)(ws + WS_WOUT); C.Wup = (bf16*)(ws + WS_WUP); C.Wdn = (bf16*)(ws + WS_WDN);
    C.A = (bf16*)(ws + WS_A); C.P = (bf16*)(ws + WS_PROJ); C.HS = (bf16*)(ws + WS_HSEQ); C.GY = (bf16*)(ws + WS_GY); C.T = (bf16*)(ws + WS_T); C.UC = (bf16*)(ws + WS_UCONV); C.ACT = (bf16*)(ws + WS_ACT);

#if MK_ONE_LAUNCH
    for (int u = C.tid; u < (LDS_BYTES - LDSCTL_OFF) / 4; u += NWAVES * 64) ((LAS unsigned*)(C.lds + LDSCTL_OFF))[u] = 0u;
    __syncthreads();
    XcdBarrier bar = xcd_barrier_post((unsigned*)(ws + WS_CTL) + CW_BAR, (volatile LAS unsigned*)(C.lds + MISC_OFF) + 8);
#define GRID_BAR() xcd_barrier(bar)
#else
#define GRID_BAR() do {} while (0)
#endif
    const int lo = args.ph_lo, hi = args.ph_hi;
#define IN(k) (lo <= (k) && (k) < hi)
#ifdef MK_PROBE
#define STAMP(k) do { if (blockIdx.x == 0 && C.tid == 0) { *(volatile LAS unsigned long long*)(C.lds + LDSCTL_OFF + 512 + 8 * ((k) + 1)) = __builtin_amdgcn_s_memrealtime(); } } while (0)
#else
#define STAMP(k) do {} while (0)
#endif
#define SEAM(k) do { if (IN(k) && IN((k) + 1)) GRID_BAR(); STAMP(k); } while (0)
    LAS unsigned char* wl = C.lds + C.wave * 16384;

    STAMP(-1);
    if (IN(PH_P0)) { p0_phase(C); } SEAM(PH_P0);
    if (IN(PH_MOD)) { mod_phase(C); } SEAM(PH_MOD);
    if (IN(PH_H1)) { norm_mod_phase(C, C.xp, C.xs, C.g1, 0, 2048, C.A); } SEAM(PH_H1);
    if (IN(PH_G1)) {
        pg8::Gemm g{C.A, C.Win, MP, NPROJ, D_MODEL}; pg8::StaticOrder S; S.init(MP, NPROJ, C.G, (int)blockIdx.x);
        pg8::EpiProj E{C.P};
        pg8::gemm_phase<pg8::EpiProj, pg8::StaticOrder, PG8_ALIGN, PG8_SP2>(C.lds, g, S, E);
        skinny_gemm<2, 2, 4>(C, C.A + (size_t)MP * D_MODEL, C.Win, D_MODEL, NPROJ / 32, SEpiProj{C.P});
    } SEAM(PH_G1);
    if (IN(PH_SA)) {
        const int U = blockIdx.x;
        s5_block<false>(C, U & 7, U >> 3);
        for (int u = (int)blockIdx.x - (C.G - 16); u >= 0 && u < 16; u += C.G) lru_sample_block(C, u);
        for (int u = C.gw; u < NGRP * 4; u += C.NGW) s5_sample_wave(C, u & 63, u >> 6, (LAS bf16*)(C.lds + TILE256 + C.wave * 8704));
        new_conv_prompt(C);
        __syncthreads();
        LruRegs R;
        lru_local(C, U, R);
        GRID_BAR();
        lru_fix(C, U, R);
        s5_block<true>(C, U & 7, U >> 3);
    } SEAM(PH_SA);
    if (IN(PH_G3)) {
        pg8::Gemm g{C.HS, C.Wpa, MP, D_MODEL, W_LRU}; pg8::StaticOrder S; S.init(MP, D_MODEL, C.G, (int)blockIdx.x);
        pg8::EpiGateA E{C.T, C.P};
        pg8::gemm_phase<pg8::EpiGateA, pg8::StaticOrder, PG8_ALIGN, PG8_SP2>(C.lds, g, S, E);
        skinny_gemm<2, 2, 4>(C, C.HS + (size_t)MP * W_LRU, C.Wpa, W_LRU, D_MODEL / 32, SEpiGateA{C.T, C.P});
    } SEAM(PH_G3);
    if (IN(PH_G4)) {
        pg8::Gemm g{C.GY, C.Wglu, MP, 2 * D_MODEL, W_SSM}; pg8::StaticOrder S; S.init(MP, 2 * D_MODEL, C.G, (int)blockIdx.x);
        pg8::EpiGlu E{C.A, C.T, C.P};
        pg8::gemm_phase<pg8::EpiGlu, pg8::StaticOrder, PG8_ALIGN, PG8_SP2>(C.lds, g, S, E);
        skinny_gemm<2, 2, 4>(C, C.GY + (size_t)MP * W_SSM, C.Wglu, W_SSM, D_MODEL / 16, SEpiGlu{C.A, C.T, C.P});
    } SEAM(PH_G4);
    if (IN(PH_G5)) {
        pg8::Gemm g{C.A, C.Wout, MP, D_MODEL, D_MODEL}; pg8::StaticOrder S; S.init(MP, D_MODEL, C.G, (int)blockIdx.x);
        pg8::EpiRes E{C.xp, C.xs, C.out, C.modt, 2 * D_MODEL};
        pg8::gemm_phase<pg8::EpiRes, pg8::StaticOrder, PG8_ALIGN, PG8_SP2>(C.lds, g, S, E);
        skinny_gemm<2, 2, 4>(C, C.A + (size_t)MP * D_MODEL, C.Wout, D_MODEL, D_MODEL / 32, SEpiRes{C.xs, C.out + (size_t)MP * D_MODEL, C.modt, 2 * D_MODEL});
    } SEAM(PH_G5);
    if (IN(PH_H2)) { norm_mod_phase(C, C.out, C.out + (size_t)MP * D_MODEL, C.g2, 3 * D_MODEL, 4 * D_MODEL, C.A); } SEAM(PH_H2);
    if (IN(PH_G6)) {
        pg8::Gemm g{C.A, C.Wup, MP, D_FF, D_MODEL}; pg8::StaticOrder S; S.init(MP, D_FF, C.G, (int)blockIdx.x);
        pg8::EpiRelu2 E{C.ACT};
        pg8::gemm_phase<pg8::EpiRelu2, pg8::StaticOrder, PG8_ALIGN, PG8_SP2>(C.lds, g, S, E);
        skinny_gemm<4, 2, 2>(C, C.A + (size_t)MP * D_MODEL, C.Wup, D_MODEL, D_FF / 32, SEpiRelu2{C.ACT});
    } SEAM(PH_G6);
    if (IN(PH_G7)) {
        pg8::Gemm g{C.ACT, C.Wdn, MP, D_MODEL, D_FF}; pg8::StaticOrder S; S.init(MP, D_MODEL, C.G, (int)blockIdx.x);
        pg8::EpiRes E{C.out, C.out + (size_t)MP * D_MODEL, C.out, C.modt, 5 * D_MODEL};
        pg8::gemm_phase<pg8::EpiRes, pg8::StaticOrder, PG8_ALIGN, PG8_SP2>(C.lds, g, S, E);
        STAMP(42);
        skinny_gemm<2, 2, 4>(C, C.ACT + (size_t)MP * D_FF, C.Wdn, D_FF, D_MODEL / 32, SEpiRes{C.out + (size_t)MP * D_MODEL, C.out + (size_t)MP * D_MODEL, C.modt, 5 * D_MODEL});
        STAMP(43);
    } SEAM(PH_G7);
    if (IN(PH_FIN)) { final_norm_phase(C); }
#ifdef MK_PROBE
    STAMP(PH_FIN);
    if (blockIdx.x == 0 && C.tid == 0) {
        volatile LAS unsigned long long* ts = (volatile LAS unsigned long long*)(C.lds + LDSCTL_OFF + 512);
        const unsigned long long delay = (ts[MK_PROBE_A_HI + 1] - ts[MK_PROBE_A_LO]) * (unsigned long long)MK_PROBE_MUL;
        const unsigned long long t0 = __builtin_amdgcn_s_memrealtime();
        while (__builtin_amdgcn_s_memrealtime() - t0 < delay) __builtin_amdgcn_s_sleep(8);
    }
#endif
#undef IN
#undef SEAM
}

extern "C" void kernel_launch(void* const* d_in, const int* in_sizes, int n_in, void* d_out, int out_size, void* d_ws, size_t ws_size, hipStream_t stream) {
    static int grid = 0;
    if (grid == 0) {
        if (n_in != 34 || in_sizes[0] != MP * D_MODEL || (size_t)out_size != O_END || ws_size < WS_END) {
            fprintf(stderr, "kernel_launch: built for 34 inputs, out %zu floats, >= %zu bytes of workspace; got n_in %d, in0 %d, out %d, ws %zu; nothing launched\n", (size_t)O_END, (size_t)WS_END, n_in, n_in > 0 ? in_sizes[0] : -1, out_size, ws_size); grid = -1; return; }
        int dev = 0, cus = 0, per_cu = 0;
        if (hipGetDevice(&dev) != hipSuccess || hipDeviceGetAttribute(&cus, hipDeviceAttributeMultiprocessorCount, dev) != hipSuccess) { fprintf(stderr, "kernel_launch: device query failed\n"); grid = -1; return; }
        if (hipFuncSetAttribute((const void*)hybrid_fwd, hipFuncAttributeMaxDynamicSharedMemorySize, LDS_BYTES) != hipSuccess) { fprintf(stderr, "kernel_launch: hipFuncSetAttribute failed\n"); grid = -1; return; }
        if (hipOccupancyMaxActiveBlocksPerMultiprocessor(&per_cu, (const void*)hybrid_fwd, NWAVES * 64, LDS_BYTES) != hipSuccess || per_cu < 1) { fprintf(stderr, "kernel_launch: occupancy query says %d workgroups per CU\n", per_cu); per_cu = 1; }
        (void)hipGetLastError();
        if (cus != 256) { fprintf(stderr, "kernel_launch: built for a 256-CU device (got %d); nothing launched\n", cus); grid = -1; return; }
        grid = cus;
    }
    if (grid < 0) return;
    if (hipMemsetAsync((char*)d_ws + WS_CTL, 0, CTL_ZERO_BYTES, stream) != hipSuccess) { fprintf(stderr, "kernel_launch: memset failed\n"); return; }
    Args a{};
    for (int i = 0; i < 34; ++i) a.in[i] = d_in[i];
    a.out = (float*)d_out; a.ws = (unsigned char*)d_ws;
#if MK_ONE_LAUNCH
    a.ph_lo = 0; a.ph_hi = N_PHASES;
    hipLaunchKernelGGL(hybrid_fwd, dim3(grid), dim3(NWAVES * 64), LDS_BYTES, stream, a);
#else
    for (int p = 0; p < N_PHASES; ++p) { a.ph_lo = p; a.ph_hi = p + 1; hipLaunchKernelGGL(hybrid_fwd, dim3(grid), dim3(NWAVES * 64), LDS_BYTES, stream, a); }
#endif
    const hipError_t le = hipPeekAtLastError();
    if (le != hipSuccess) fprintf(stderr, "kernel_launch: launch failed: %s\n", hipGetErrorName(le));
}
```
